# Optimizing an MI355X kernel written in HIP

```python
import math
import jax
import jax.numpy as jnp
from jax import lax
import numpy as np

D_MODEL = 2048
BATCH = 16
SEQ = 256
DEPTH = 4
DEC_BATCH = 8
DEC_SEQ = 2048
PAST_LEN = 256

GRID_W = 64
N_MIXERS = 4
EPS = 1e-6
NEG_INF = -1e30
ROPE_BASE = 10000.0
Q_BLOCK = 128

MLA_HEADS = 16
MLA_Q_RANK = 512
MLA_KV_RANK = 512
MLA_NOPE = 128
MLA_ROPE = 64
MLA_V = 128

S5_GROUP = 16
S5_GROUPS = D_MODEL // S5_GROUP
S5_STATE = 64
S5_DT_MIN = 1e-3
S5_DT_MAX = 1e-1

HY_ORDER = 2
HY_BANDS = 8
HY_EMB = 2 * HY_BANDS + 1
HY_HIDDEN = 64
HY_DECAY_TARGET = 1e-2
HY_FAST_PCT = 0.3
HY_SLOW_PCT = 1.5
HY_MIN_DECAY = math.log(1.0 / HY_DECAY_TARGET) / HY_SLOW_PCT
HY_MAX_DECAY = math.log(1.0 / HY_DECAY_TARGET) / HY_FAST_PCT

SWA_HEADS = 16
SWA_KV_HEADS = 4
SWA_GROUP = SWA_HEADS // SWA_KV_HEADS
SWA_HEAD_DIM = D_MODEL // SWA_HEADS
SWA_WINDOW = 128
SWA_BLOCK = 128

PEER_HEADS = 8
PEER_N_KEYS = 128
PEER_EXPERTS = PEER_N_KEYS * PEER_N_KEYS
PEER_KEY_DIM = 256
PEER_TOPK = 16
PEER_CHUNK = 128

F32 = jnp.float32

kernel_name = 'hybrid_diffusion_mla_s5_hyena_swa_peer'


def _layers_using(kind):
    return len(range(kind, DEPTH, N_MIXERS))


def _rmsnorm(x, g):
    xf = x.astype(F32)
    y = xf * lax.rsqrt(jnp.mean(xf * xf, axis=-1, keepdims=True) + EPS)
    return (y * g.astype(F32)).astype(x.dtype)


def _axial_rope_tables(n_tokens, rot_dim):
    rows = n_tokens // GRID_W
    row = jnp.repeat(jnp.arange(rows, dtype=F32), GRID_W)
    col = jnp.tile(jnp.arange(GRID_W, dtype=F32), rows)
    axis_dim = rot_dim // 2
    inv = ROPE_BASE ** (-jnp.arange(0, axis_dim, 2, dtype=F32) / axis_dim)
    ang_r = row[:, None] * inv[None, :]
    ang_c = col[:, None] * inv[None, :]
    return (jnp.cos(ang_r), jnp.sin(ang_r), jnp.cos(ang_c), jnp.sin(ang_c))


def _rotate(x, cos, sin):
    x1, x2 = jnp.split(x, 2, axis=-1)
    c = cos[None, :, None, :]
    s = sin[None, :, None, :]
    return jnp.concatenate([x1 * c - x2 * s, x1 * s + x2 * c], axis=-1)


def _apply_axial_rope(x, tables):
    cr, sr, cc, sc = tables
    xf = x.astype(F32)
    a = x.shape[-1] // 2
    out = jnp.concatenate([_rotate(xf[..., :a], cr, sr), _rotate(xf[..., a:], cc, sc)], axis=-1)
    return out.astype(x.dtype)


def _blocked_attention(q, k, v, scale, sink=None):
    B, Lq, KV, G, dk = q.shape
    nb = Lq // Q_BLOCK
    qb = jnp.moveaxis(q.reshape(B, nb, Q_BLOCK, KV, G, dk), 1, 0)

    def one_block(qblk):
        s = jnp.einsum('bqngd,bknd->bngqk', qblk, k).astype(F32) * scale
        if sink is not None:
            s_sink = jnp.broadcast_to(sink.astype(F32).reshape(1, KV, G, 1, 1), s.shape[:-1] + (1,))
            s = jnp.concatenate([s, s_sink], axis=-1)
        p = jax.nn.softmax(s, axis=-1)
        if sink is not None:
            p = p[..., :-1]
        return jnp.einsum('bngqk,bknd->bqngd', p.astype(v.dtype), v)

    out = lax.map(one_block, qb)
    return jnp.moveaxis(out, 0, 1).reshape(B, Lq, -1)


def _mla_project(h, p, tables):
    B, L, _ = h.shape
    down = h @ p['w_down']
    cq = _rmsnorm(down[..., :MLA_Q_RANK], p['g_q'])
    ckv = _rmsnorm(down[..., MLA_Q_RANK:MLA_Q_RANK + MLA_KV_RANK], p['g_kv'])
    kpe = down[..., MLA_Q_RANK + MLA_KV_RANK:][:, :, None, :]
    q = (cq @ p['w_uq']).reshape(B, L, MLA_HEADS, MLA_NOPE + MLA_ROPE)
    if tables is not None:
        q = jnp.concatenate([q[..., :MLA_NOPE], _apply_axial_rope(q[..., MLA_NOPE:], tables)], axis=-1)
        kpe = _apply_axial_rope(kpe, tables)
    return q, ckv, kpe[:, :, 0, :]


def _mla_attend(q, ckv, kpe, p):
    B, Lk, _ = ckv.shape
    kv = (ckv @ p['w_ukv']).reshape(B, Lk, MLA_HEADS, MLA_NOPE + MLA_V)
    k = jnp.concatenate([kv[..., :MLA_NOPE], jnp.broadcast_to(kpe[:, :, None, :], (B, Lk, MLA_HEADS, MLA_ROPE))], axis=-1)
    v = kv[..., MLA_NOPE:]
    o = _blocked_attention(q[:, :, :, None, :], k, v, (MLA_NOPE + MLA_ROPE) ** -0.5)
    return o @ p['w_o']


def _ssm_combine(left, right):
    a_l, b_l = left
    a_r, b_r = right
    return a_l * a_r, a_r * b_l + b_r


def _s5_mixer(h, p, init_re=None, init_im=None):
    B, L, _ = h.shape
    u = (h @ p['w_in']).astype(F32)
    u_c = u.reshape(B, L, S5_GROUPS, S5_GROUP).astype(jnp.complex64)
    y = p['d'].astype(F32) * u
    finals = []
    for d in range(2):
        lam = lax.complex(p['lam_re'][d].astype(F32), p['lam_im'][d].astype(F32))
        dt = jnp.exp(p['log_dt'][d].astype(F32))[:, None]
        a_bar = jnp.exp(lam * dt)
        b_mat = lax.complex(p['b_re'][d].astype(F32), p['b_im'][d].astype(F32))
        b_bar = ((a_bar - 1.0) / lam)[..., None] * b_mat
        c_mat = lax.complex(p['c_re'][d].astype(F32), p['c_im'][d].astype(F32))
        bu = jnp.einsum('gpc,blgc->blgp', b_bar, u_c)
        if init_re is not None:
            h0 = lax.complex(init_re[:, d].astype(F32), init_im[:, d].astype(F32))
            first = L - 1 if d == 1 else 0
            bu = bu.at[:, first].add(a_bar[None] * h0)
        a_seq = jnp.broadcast_to(a_bar, (1, L) + a_bar.shape)
        _, states = lax.associative_scan(_ssm_combine, (a_seq, bu), axis=1, reverse=(d == 1))
        y = y + jnp.real(jnp.einsum('gcp,blgp->blgc', c_mat, states)).reshape(B, L, D_MODEL)
        finals.append(states[:, 0] if d == 1 else states[:, -1])
    z = jax.nn.gelu(y).astype(h.dtype)
    out = (z * jax.nn.sigmoid(z @ p['w_gate'])) @ p['w_out']
    return out, finals


def _hyena_filter_spectra(L, p):
    t = jnp.arange(L, dtype=F32) / L
    bands = jnp.arange(1, HY_BANDS + 1, dtype=F32)
    ang = 2.0 * math.pi * t[:, None] * bands[None, :]
    feats = jnp.concatenate([t[:, None], jnp.sin(ang), jnp.cos(ang)], axis=-1)
    freq = p['f_freq'].astype(F32)
    z = jnp.sin(freq[0] * (feats @ p['f_w1'].astype(F32) + p['f_b1'].astype(F32)))
    z = jnp.sin(freq[1] * (z @ p['f_w2'].astype(F32) + p['f_b2'].astype(F32)))
    filt = (z @ p['f_w3'].astype(F32)).reshape(L, 2, HY_ORDER, D_MODEL)
    filt = filt * jnp.exp(-t[:, None, None, None] * jnp.exp(p['log_decay'].astype(F32))[None])
    fwd = filt[:, 0]
    bwd = filt[1:, 1]
    two_sided = jnp.concatenate([fwd, jnp.zeros((1, HY_ORDER, D_MODEL), F32), bwd[::-1]], axis=0)
    return jnp.fft.rfft(two_sided, axis=0)


def _fft_long_conv(u, k_f, bias):
    L = u.shape[1]
    u_f = jnp.fft.rfft(u, n=2 * L, axis=1)
    y = jnp.fft.irfft(u_f * k_f[None], n=2 * L, axis=1)[:, :L]
    return y + u * bias


def _hyena_mixer(h, p):
    z = h @ p['w_in'] + p['b_in']
    zp = jnp.pad(z, ((0, 0), (1, 1), (0, 0)))
    w = p['short_w']
    z = zp[:, :-2] * w[0] + zp[:, 1:-1] * w[1] + zp[:, 2:] * w[2] + p['short_b']
    x1, x2, v = jnp.split(z.astype(F32), 3, axis=-1)
    k_f = _hyena_filter_spectra(h.shape[1], p)
    bias = p['bias'].astype(F32)
    v = x1 * _fft_long_conv(v, k_f[:, 0], bias[0])
    v = x2 * _fft_long_conv(v, k_f[:, 1], bias[1])
    return v.astype(h.dtype) @ p['w_out']


def _swa_project(h, p, tables):
    B, L, _ = h.shape
    nq = SWA_HEADS * SWA_HEAD_DIM
    nk = SWA_KV_HEADS * SWA_HEAD_DIM
    qkv = h @ p['w_qkv']
    q = qkv[..., :nq].reshape(B, L, SWA_HEADS, SWA_HEAD_DIM)
    k = qkv[..., nq:nq + nk].reshape(B, L, SWA_KV_HEADS, SWA_HEAD_DIM)
    v = qkv[..., nq + nk:].reshape(B, L, SWA_KV_HEADS, SWA_HEAD_DIM)
    if tables is not None:
        q = _apply_axial_rope(q, tables)
        k = _apply_axial_rope(k, tables)
    return q.reshape(B, L, SWA_KV_HEADS, SWA_GROUP, SWA_HEAD_DIM), k, v


def _banded_attention(q, k, v, k_ctx, v_ctx, sink, scale):
    B, L, KV, G, d = q.shape
    nb = L // SWA_BLOCK
    qb = q.reshape(B, nb, SWA_BLOCK, KV, G, d)

    def neighbourhood(t):
        tp = jnp.pad(t, ((0, 0), (SWA_BLOCK, SWA_BLOCK), (0, 0), (0, 0))).reshape(B, nb + 2, SWA_BLOCK, KV, d)
        return jnp.concatenate([tp[:, :-2], tp[:, 1:-1], tp[:, 2:]], axis=2)

    kb = neighbourhood(k)
    vb = neighbourhood(v)
    qpos = jnp.arange(L).reshape(nb, SWA_BLOCK)
    kpos = (jnp.arange(nb)[:, None] - 1) * SWA_BLOCK + jnp.arange(3 * SWA_BLOCK)[None, :]
    valid = ((jnp.abs(qpos[:, :, None] - kpos[:, None, :]) <= SWA_WINDOW)
             & (kpos[:, None, :] >= 0) & (kpos[:, None, :] < L))
    s_loc = jnp.einsum('bnqhgd,bnkhd->bnhgqk', qb, kb).astype(F32) * scale
    s_loc = jnp.where(valid[None, :, None, None], s_loc, NEG_INF)
    s_ctx = jnp.einsum('bnqhgd,bkhd->bnhgqk', qb, k_ctx).astype(F32) * scale
    s_sink = jnp.broadcast_to(sink.astype(F32).reshape(1, 1, KV, G, 1, 1), s_loc.shape[:-1] + (1,))
    p = jax.nn.softmax(jnp.concatenate([s_loc, s_ctx, s_sink], axis=-1), axis=-1)
    n_loc = 3 * SWA_BLOCK
    n_ctx = k_ctx.shape[1]
    o = (jnp.einsum('bnhgqk,bnkhd->bnqhgd', p[..., :n_loc].astype(v.dtype), vb)
         + jnp.einsum('bnhgqk,bkhd->bnqhgd', p[..., n_loc:n_loc + n_ctx].astype(v.dtype), v_ctx))
    return o.reshape(B, L, KV * G * d)


def _peer(x, p):
    B, L, D = x.shape
    T = B * L
    xf = x.reshape(T, D)
    q = (xf @ p['w_q']).reshape(T, PEER_HEADS, 2, PEER_KEY_DIM // 2)
    s = jnp.einsum('thpk,hpnk->thpn', q, p['keys']).astype(F32)
    sv, si = lax.top_k(s, PEER_TOPK)
    cand_s = (sv[:, :, 0, :, None] + sv[:, :, 1, None, :]).reshape(T, PEER_HEADS, PEER_TOPK * PEER_TOPK)
    cand_i = (si[:, :, 0, :, None] * PEER_N_KEYS + si[:, :, 1, None, :]).reshape(T, PEER_HEADS, PEER_TOPK * PEER_TOPK)
    top_s, top_pos = lax.top_k(cand_s, PEER_TOPK)
    eid = jnp.take_along_axis(cand_i, top_pos, axis=-1).reshape(T, PEER_HEADS * PEER_TOPK)
    gate = jax.nn.softmax(top_s, axis=-1).reshape(T, PEER_HEADS * PEER_TOPK)
    n_chunks = T // PEER_CHUNK
    u_tab = p['u']
    v_tab = p['v']

    def chunk(args):
        xc, ec, gc = args
        a = jnp.einsum('cd,ced->ce', xc, u_tab[ec]).astype(F32)
        w = (jax.nn.gelu(a) * gc).astype(xc.dtype)
        return jnp.einsum('ce,ced->cd', w, v_tab[ec])

    out = lax.map(chunk, (xf.reshape(n_chunks, PEER_CHUNK, D),
                          eid.reshape(n_chunks, PEER_CHUNK, -1),
                          gate.reshape(n_chunks, PEER_CHUNK, -1)))
    return out.reshape(B, L, D)


def _trunk(x, cond, W, cache=None):
    L = x.shape[1]
    latent = cache is not None
    rope_mla = _axial_rope_tables(L, MLA_ROPE) if latent else None
    rope_swa = _axial_rope_tables(L, SWA_HEAD_DIM) if latent else None
    new = {'mla_ckv': [], 'mla_kpe': [], 's5_re': [], 's5_im': [], 'swa_k': [], 'swa_v': []}
    cond_act = jax.nn.silu(cond)
    for i in range(DEPTH):
        kind, j = i % N_MIXERS, i // N_MIXERS
        mod = (cond_act @ W['mod_w'][i] + W['mod_b'][i])[:, None, :]
        sh1, sc1, g1, sh2, sc2, g2 = jnp.split(mod, 6, axis=-1)
        h = _rmsnorm(x, W['norm1_g'][i]) * (1.0 + sc1) + sh1
        if kind == 0:
            p = {name: arr[j] for name, arr in W['mla'].items()}
            q, ckv, kpe = _mla_project(h, p, rope_mla)
            if latent:
                ckv = jnp.concatenate([ckv, cache['mla_ckv'][:, j]], axis=1)
                kpe = jnp.concatenate([kpe, cache['mla_kpe'][:, j]], axis=1)
            else:
                new['mla_ckv'].append(ckv)
                new['mla_kpe'].append(kpe)
            y = _mla_attend(q, ckv, kpe, p)
        elif kind == 1:
            p = {name: arr[j] for name, arr in W['s5'].items()}
            if latent:
                y, _ = _s5_mixer(h, p, cache['s5_re'][:, j], cache['s5_im'][:, j])
            else:
                y, finals = _s5_mixer(h, p)
                fin = jnp.stack(finals, axis=1)
                new['s5_re'].append(jnp.real(fin))
                new['s5_im'].append(jnp.imag(fin))
        elif kind == 2:
            p = {name: arr[j] for name, arr in W['hy'].items()}
            y = _hyena_mixer(h, p)
        else:
            p = {name: arr[j] for name, arr in W['swa'].items()}
            q, k, v = _swa_project(h, p, rope_swa)
            scale = SWA_HEAD_DIM ** -0.5
            if latent:
                o = _banded_attention(q, k, v, cache['swa_k'][:, j], cache['swa_v'][:, j], p['sink'], scale)
            else:
                o = _blocked_attention(q, k, v, scale, p['sink'])
                new['swa_k'].append(k)
                new['swa_v'].append(v)
            y = o @ p['w_o']
        x = x + g1 * y
        h = _rmsnorm(x, W['norm2_g'][i]) * (1.0 + sc2) + sh2
        x = x + g2 * _peer(h, {name: arr[i] for name, arr in W['peer'].items()})
    return _rmsnorm(x, W['final_g']), new


def setup_inputs(seed: int = 0):
    key = jax.random.key(seed)
    keys = iter(jax.random.split(key, 64))

    def nrm(shape, scale):
        return jax.random.normal(next(keys), shape, F32) * scale

    D = D_MODEL
    n_mla, n_s5, n_hy, n_swa = [_layers_using(kind) for kind in range(N_MIXERS)]
    G, P = S5_GROUPS, S5_STATE
    return {
        'x_prompt': nrm((BATCH, SEQ, D), 1.0),
        'x_sample': nrm((DEC_BATCH, DEC_SEQ, D), 1.0),
        'c': nrm((DEC_BATCH, D), 1.0),
        'cache_mla_ckv': nrm((DEC_BATCH, n_mla, PAST_LEN, MLA_KV_RANK), 1.0),
        'cache_mla_kpe': nrm((DEC_BATCH, n_mla, PAST_LEN, MLA_ROPE), 1.0),
        'state_s5_re': nrm((DEC_BATCH, n_s5, 2, G, P), 0.1),
        'state_s5_im': nrm((DEC_BATCH, n_s5, 2, G, P), 0.1),
        'cache_swa_k': nrm((DEC_BATCH, n_swa, PAST_LEN, SWA_KV_HEADS, SWA_HEAD_DIM), 1.0),
        'cache_swa_v': nrm((DEC_BATCH, n_swa, PAST_LEN, SWA_KV_HEADS, SWA_HEAD_DIM), 1.0),
        'c_ctx': nrm((D,), 1.0),
        'mod_w': nrm((DEPTH, D, 6 * D), 0.5 * D ** -0.5),
        'mod_b': nrm((DEPTH, 6 * D), 0.02),
        'norm1_g': 1.0 + nrm((DEPTH, D), 0.02),
        'norm2_g': 1.0 + nrm((DEPTH, D), 0.02),
        'final_g': 1.0 + nrm((D,), 0.02),
        'mla_w_down': nrm((n_mla, D, MLA_Q_RANK + MLA_KV_RANK + MLA_ROPE), D ** -0.5),
        'mla_g_q': 1.0 + nrm((n_mla, MLA_Q_RANK), 0.02),
        'mla_g_kv': 1.0 + nrm((n_mla, MLA_KV_RANK), 0.02),
        'mla_w_uq': nrm((n_mla, MLA_Q_RANK, MLA_HEADS * (MLA_NOPE + MLA_ROPE)), MLA_Q_RANK ** -0.5),
        'mla_w_ukv': nrm((n_mla, MLA_KV_RANK, MLA_HEADS * (MLA_NOPE + MLA_V)), MLA_KV_RANK ** -0.5),
        'mla_w_o': nrm((n_mla, MLA_HEADS * MLA_V, D), (MLA_HEADS * MLA_V) ** -0.5),
        's5_w_in': nrm((n_s5, D, D), D ** -0.5),
        's5_lam_re': -0.5 + nrm((n_s5, 2, G, P), 0.01),
        's5_lam_im': math.pi * jnp.arange(P, dtype=F32) + nrm((n_s5, 2, G, P), 0.01),
        's5_log_dt': jax.random.uniform(next(keys), (n_s5, 2, G), F32, math.log(S5_DT_MIN), math.log(S5_DT_MAX)),
        's5_b_re': nrm((n_s5, 2, G, P, S5_GROUP), (2 * S5_GROUP) ** -0.5),
        's5_b_im': nrm((n_s5, 2, G, P, S5_GROUP), (2 * S5_GROUP) ** -0.5),
        's5_c_re': nrm((n_s5, 2, G, S5_GROUP, P), P ** -0.5),
        's5_c_im': nrm((n_s5, 2, G, S5_GROUP, P), P ** -0.5),
        's5_d': nrm((n_s5, D), 0.5),
        's5_w_gate': nrm((n_s5, D, D), D ** -0.5),
        's5_w_out': nrm((n_s5, D, D), D ** -0.5),
        'hy_w_in': nrm((n_hy, D, 3 * D), D ** -0.5),
        'hy_b_in': nrm((n_hy, 3 * D), 0.02),
        'hy_short_w': nrm((n_hy, 3, 3 * D), 3 ** -0.5),
        'hy_short_b': nrm((n_hy, 3 * D), 0.02),
        'hy_f_w1': nrm((n_hy, HY_EMB, HY_HIDDEN), HY_EMB ** -0.5),
        'hy_f_b1': nrm((n_hy, HY_HIDDEN), 0.5),
        'hy_f_freq': 1.0 + nrm((n_hy, 2, HY_HIDDEN), 0.1),
        'hy_f_w2': nrm((n_hy, HY_HIDDEN, HY_HIDDEN), HY_HIDDEN ** -0.5),
        'hy_f_b2': nrm((n_hy, HY_HIDDEN), 0.5),
        'hy_f_w3': nrm((n_hy, HY_HIDDEN, 2 * HY_ORDER * D), 0.005),
        'hy_log_decay': jnp.log(jnp.linspace(HY_MIN_DECAY, HY_MAX_DECAY, D, dtype=F32)) + nrm((n_hy, 2, HY_ORDER, D), 0.01),
        'hy_bias': nrm((n_hy, HY_ORDER, D), 1.0),
        'hy_w_out': nrm((n_hy, D, D), D ** -0.5),
        'swa_w_qkv': nrm((n_swa, D, (SWA_HEADS + 2 * SWA_KV_HEADS) * SWA_HEAD_DIM), D ** -0.5),
        'swa_w_o': nrm((n_swa, SWA_HEADS * SWA_HEAD_DIM, D), (SWA_HEADS * SWA_HEAD_DIM) ** -0.5),
        'swa_sink': nrm((n_swa, SWA_HEADS), 0.5),
        'peer_w_q': nrm((DEPTH, D, PEER_HEADS * PEER_KEY_DIM), D ** -0.5),
        'peer_keys': nrm((DEPTH, PEER_HEADS, 2, PEER_N_KEYS, PEER_KEY_DIM // 2), (PEER_KEY_DIM // 2) ** -0.5),
        'peer_u': nrm((DEPTH, PEER_EXPERTS, D), D ** -0.5),
        'peer_v': nrm((DEPTH, PEER_EXPERTS, D), PEER_HEADS ** -0.5),
    }


def reference(x_prompt, x_sample, c, cache_mla_ckv, cache_mla_kpe, state_s5_re, state_s5_im,
              cache_swa_k, cache_swa_v, c_ctx, mod_w, mod_b, norm1_g, norm2_g, final_g,
              mla_w_down, mla_g_q, mla_g_kv, mla_w_uq, mla_w_ukv, mla_w_o,
              s5_w_in, s5_lam_re, s5_lam_im, s5_log_dt, s5_b_re, s5_b_im, s5_c_re, s5_c_im,
              s5_d, s5_w_gate, s5_w_out,
              hy_w_in, hy_b_in, hy_short_w, hy_short_b, hy_f_w1, hy_f_b1, hy_f_freq, hy_f_w2,
              hy_f_b2, hy_f_w3, hy_log_decay, hy_bias, hy_w_out,
              swa_w_qkv, swa_w_o, swa_sink,
              peer_w_q, peer_keys, peer_u, peer_v):
    W = {
        'mod_w': mod_w, 'mod_b': mod_b, 'norm1_g': norm1_g, 'norm2_g': norm2_g, 'final_g': final_g,
        'mla': {'w_down': mla_w_down, 'g_q': mla_g_q, 'g_kv': mla_g_kv, 'w_uq': mla_w_uq,
                'w_ukv': mla_w_ukv, 'w_o': mla_w_o},
        's5': {'w_in': s5_w_in, 'lam_re': s5_lam_re, 'lam_im': s5_lam_im, 'log_dt': s5_log_dt,
               'b_re': s5_b_re, 'b_im': s5_b_im, 'c_re': s5_c_re, 'c_im': s5_c_im, 'd': s5_d,
               'w_gate': s5_w_gate, 'w_out': s5_w_out},
        'hy': {'w_in': hy_w_in, 'b_in': hy_b_in, 'short_w': hy_short_w, 'short_b': hy_short_b,
               'f_w1': hy_f_w1, 'f_b1': hy_f_b1, 'f_freq': hy_f_freq, 'f_w2': hy_f_w2, 'f_b2': hy_f_b2,
               'f_w3': hy_f_w3, 'log_decay': hy_log_decay, 'bias': hy_bias, 'w_out': hy_w_out},
        'swa': {'w_qkv': swa_w_qkv, 'w_o': swa_w_o, 'sink': swa_sink},
        'peer': {'w_q': peer_w_q, 'keys': peer_keys, 'u': peer_u, 'v': peer_v},
    }
    y_prompt, st = _trunk(x_prompt, c_ctx[None, :], W, None)
    new_mla_ckv = jnp.stack(st['mla_ckv'], axis=1)
    new_mla_kpe = jnp.stack(st['mla_kpe'], axis=1)
    new_s5_re = jnp.stack(st['s5_re'], axis=1)
    new_s5_im = jnp.stack(st['s5_im'], axis=1)
    new_swa_k = jnp.stack(st['swa_k'], axis=1)
    new_swa_v = jnp.stack(st['swa_v'], axis=1)
    cache = {'mla_ckv': cache_mla_ckv, 'mla_kpe': cache_mla_kpe, 's5_re': state_s5_re,
             's5_im': state_s5_im, 'swa_k': cache_swa_k, 'swa_v': cache_swa_v}
    y_sample, _ = _trunk(x_sample, c, W, cache)
    return (y_prompt, y_sample, new_mla_ckv, new_mla_kpe, new_s5_re, new_s5_im, new_swa_k, new_swa_v)
```

```cpp
#include <hip/hip_runtime.h>
#include <cstdio>
#include <cstdint>
#define MK_PER_PHASE 0
namespace pg8 {
#define PG8_LAS __attribute__((address_space(3)))
typedef unsigned short bf16_t;
typedef short bf16x8 __attribute__((ext_vector_type(8)));
typedef float f32x4 __attribute__((ext_vector_type(4)));
typedef unsigned u32x4 __attribute__((ext_vector_type(4)));
constexpr int BM = 256, BK = 64, HALF = 128, HTB = HALF * BK * 2  , STAGE_BYTES = 8 * HTB, NXCD = 8, WGM = 8;

__host__ __device__ __forceinline__ int lds_byte(int r, int c) { const int st = (r >> 4) * 2 + (c >> 5), rr = r & 15, cc = c & 31, ob = rr * 64 + cc * 2; return st * 1024 + (ob ^ (((ob >> 9) & 1) << 5)); }
__host__ __device__ __forceinline__ void stage_rc(int b, int& R, int& C) { const int st = b / 1024, sb = b % 1024, swz = sb ^ (((sb >> 9) & 1) << 5); R = (st >> 1) * 16 + swz / 64; C = (st & 1) * 32 + (swz % 64) / 2; }
__host__ __device__ __forceinline__ int perm32(int rho) { const int n = rho >> 4, i = rho & 15; return 8 * (i >> 2) + 4 * n + (i & 3); }

struct Unit { int pm, pn, arow, half; };
struct Gemm { const bf16_t* A; const bf16_t* Bt; int M, N, K; };

struct StaticOrder {
    int nM, nN, nwg, G, c;
    __host__ __device__ void init(int M, int N, int G_, int c_) { nM = M / BM; nN = N / BM; nwg = nM * nN; G = G_; c = c_; }
    __host__ __device__ int remap(int wgid) const { const int q = nwg / NXCD, r = nwg % NXCD, xcd = wgid % NXCD, off = wgid / NXCD; return (xcd < r ? xcd * (q + 1) : r * (q + 1) + (xcd - r) * q) + off; }
    __host__ __device__ void decode(int wgid, Unit& u) const {
        const int nig = WGM * nN, gid = wgid / nig, fm = gid * WGM, gsz = (nM - fm) < WGM ? (nM - fm) : WGM;
        u.pm = fm + ((wgid % nig) % gsz); u.pn = (wgid % nig) / gsz; u.arow = u.pm * BM; u.half = 0;
    }
    __host__ __device__ bool next(int i, Unit& u) const {
        const long L = (long)i * G + c; if (L >= nwg) return false;
        decode(remap((int)L), u); return true;
    }
    __device__ __forceinline__ void a_ready(const Unit&) const {}
    __device__ __forceinline__ void done(const Unit&) const {}
};
struct TailHalfOrder {
    StaticOrder so; int nfull, nh, G, c;
    __host__ __device__ void init(int M, int N, int nh_, int G_, int c_) { so.init(M, N, G_, c_); nh = nh_; nfull = so.nwg - nh_; G = G_; c = c_; }
    __host__ __device__ bool next(int i, Unit& u) const {
        const long L = (long)i * G + c;
        if (L < nfull) { so.decode(so.remap((int)L), u); return true; }
        const long h = L - nfull; if (h >= 2 * nh) return false;
        const int x = (int)(h % NXCD), r = (int)(h / NXCD), q = so.nwg / NXCD;
        so.decode(x * q + (q - nh / NXCD) + (r >> 1), u); u.arow += (r & 1) * HALF; u.half = 1; return true;
    }
    __device__ __forceinline__ void a_ready(const Unit&) const {}
    __device__ __forceinline__ void done(const Unit&) const {}
};
struct HalfOrder {
    StaticOrder so; int nN, nhalf, G, c;
    __host__ __device__ void init(int Mfull, int M, int N, int G_, int c_) { so.init(Mfull, N, G_, c_); nN = N / BM; nhalf = ((M - Mfull) / HALF) * nN; G = G_; c = c_; }
    __host__ __device__ bool next(int i, Unit& u) const {
        if (so.next(i, u)) return true;
        const long L = (long)i * G + c - so.nwg; if (L < 0 || L >= nhalf) return false;
        const int hm = (int)(L / nN); u.pn = (int)(L % nN); u.pm = so.nM + (hm >> 1); u.arow = so.nM * BM + hm * HALF; u.half = 1; return true;
    }
    __device__ __forceinline__ void a_ready(const Unit&) const {}
    __device__ __forceinline__ void done(const Unit&) const {}
};
typedef int i32x4 __attribute__((ext_vector_type(4)));
template <bool I8> __device__ __forceinline__ f32x4 pg8_mma(bf16x8 a, bf16x8 b, f32x4 c) { return __builtin_amdgcn_mfma_f32_16x16x32_bf16(a, b, c, 0, 0, 0); }
template <bool I8> __device__ __forceinline__ i32x4 pg8_mma(bf16x8 a, bf16x8 b, i32x4 c) { return __builtin_amdgcn_mfma_i32_16x16x64_i8(__builtin_bit_cast(i32x4, a), __builtin_bit_cast(i32x4, b), c, 0, 0, 0); }
template <bool I8> struct AccSel { typedef f32x4 type; };
template <> struct AccSel<true> { typedef i32x4 type; };
template <class Epi, class Sched, bool ALIGN_EPI = false, bool SP2 = false, bool I8 = false>
__device__ __forceinline__ void gemm_phase(PG8_LAS unsigned char* lds, const Gemm g, const Sched& S, const Epi& E) {
    const int tid = threadIdx.x, wid = __builtin_amdgcn_readfirstlane(tid >> 6), lane = tid & 63, wr = wid >> 2, wc = wid & 3, fr = lane & 15, fq = lane >> 4;
    const int K = g.K, nt = K / BK;
    unsigned voffA[2], voffB[2];
#pragma unroll
    for (int i = 0; i < 2; ++i) { int R, C; stage_rc(tid * 16 + i * 8192, R, C); const int Rb = Epi::PERM ? ((R & ~31) + perm32(R & 31)) : R;
        voffA[i] = (unsigned)(R * K + C) * 2u; voffB[i] = (unsigned)(Rb * K + C) * 2u; }
    const size_t kstep = (size_t)(BK * 2);
    const size_t hstep = (size_t)HALF * K * 2;
    const size_t tstep = 2 * hstep;
    const unsigned ldsw = (unsigned)wid * 1024u;
    const int aoff = lds_byte(wr * 64 + fr, fq * 8), boff = lds_byte(wc * 32 + fr, fq * 8);
#define PG8_SA(b, h) (((b) * 2 + (h)) * HTB)
#define PG8_SB(b, h) ((4 + (b) * 2 + (h)) * HTB)
#define PG8_STAGE(bufoff, gbase, voff) do { _Pragma("unroll") for (int _i = 0; _i < 2; ++_i) \
        __builtin_amdgcn_global_load_lds((const unsigned*)((const char*)(gbase) + (voff)[_i]), (PG8_LAS unsigned*)(lds + (bufoff) + ldsw + _i * 8192), 16, 0, 0); } while (0)
#define PG8_LDA(dst, b, h) do { _Pragma("unroll") for (int m = 0; m < 4; ++m) _Pragma("unroll") for (int k = 0; k < 2; ++k) dst[m][k] = *(const PG8_LAS bf16x8*)(lds + PG8_SA(b, h) + aoff + m * 2048 + k * 1024); } while (0)
#define PG8_LDB(dst, b, h) do { _Pragma("unroll") for (int n = 0; n < 2; ++n) _Pragma("unroll") for (int k = 0; k < 2; ++k) dst[n][k] = *(const PG8_LAS bf16x8*)(lds + PG8_SB(b, h) + boff + n * 2048 + k * 1024); } while (0)
#define PG8_MMA(ai, bj, At, Bt) do { __builtin_amdgcn_s_setprio(1); _Pragma("unroll") for (int m = 0; m < 4; ++m) _Pragma("unroll") for (int n = 0; n < 2; ++n) _Pragma("unroll") for (int k = 0; k < 2; ++k) \
        acc[ai][bj][m][n] = pg8_mma<I8>(Bt[n][k], At[m][k], acc[ai][bj][m][n]); __builtin_amdgcn_s_setprio(0); } while (0)
#define PG8_WAIT_V(n) asm volatile("s_waitcnt vmcnt(" #n ")" ::: "memory")
#define PG8_WAIT_L(n) asm volatile("s_waitcnt lgkmcnt(" #n ")" ::: "memory")
#define PG8_BAR __builtin_amdgcn_s_barrier()
#define PG8_SCHED __builtin_amdgcn_sched_barrier(0)
    Unit cur, nxt; int ui = 0;
    if (!S.next(0, cur)) return;
    typedef typename AccSel<I8>::type acc_t;
    acc_t acc[2][2][4][2];
#pragma unroll
    for (int a = 0; a < 2; ++a)
#pragma unroll
        for (int b = 0; b < 2; ++b)
#pragma unroll
            for (int m = 0; m < 4; ++m)
#pragma unroll
                for (int n = 0; n < 2; ++n) acc[a][b][m][n] = (acc_t){0, 0, 0, 0};
    bf16x8 At[4][2], B0[2][2], B1[2][2];
    const char* cA = (const char*)g.A + (size_t)cur.arow * K * 2; const char* cB = (const char*)g.Bt + (size_t)cur.pn * tstep;
    size_t hsA_c = cur.half ? 0 : hstep;
    S.a_ready(cur);
    if constexpr (SP2) {
        PG8_STAGE(PG8_SB(0, 0), cB, voffB); PG8_STAGE(PG8_SB(0, 1), cB + hstep, voffB); PG8_STAGE(PG8_SA(0, 0), cA, voffA); PG8_STAGE(PG8_SA(0, 1), cA + hsA_c, voffA);
        if (wr == 1) PG8_BAR;
        PG8_WAIT_V(2); PG8_BAR;
        PG8_STAGE(PG8_SB(1, 0), cB + kstep, voffB); PG8_STAGE(PG8_SA(1, 0), cA + kstep, voffA); PG8_STAGE(PG8_SB(1, 1), cB + hstep + kstep, voffB);
        PG8_WAIT_V(6); PG8_BAR;
    } else {
        PG8_STAGE(PG8_SB(0, 0), cB, voffB); PG8_STAGE(PG8_SA(0, 0), cA, voffA); PG8_STAGE(PG8_SB(0, 1), cB + hstep, voffB); PG8_STAGE(PG8_SA(0, 1), cA + hstep, voffA);
        if (wr == 1) PG8_BAR;
        PG8_WAIT_V(4); PG8_BAR;
        PG8_STAGE(PG8_SB(1, 0), cB + kstep, voffB); PG8_STAGE(PG8_SA(1, 0), cA + kstep, voffA); PG8_STAGE(PG8_SB(1, 1), cB + hstep + kstep, voffB);
        PG8_WAIT_V(6); PG8_BAR;
    }
    for (;;) {
        const bool has_next = S.next(ui + 1, nxt);
        const char* nA = has_next ? (const char*)g.A + (size_t)nxt.arow * K * 2 : cA; const size_t hsA_n = has_next ? (nxt.half ? 0 : hstep) : hsA_c; const bool full = !cur.half; const char* nB = has_next ? (const char*)g.Bt + (size_t)nxt.pn * tstep : cB;
        for (int t = 0; t < nt; t += 2) {
            const bool last = (t == nt - 2);
            const char* a1 = cA + (size_t)(t + 1) * kstep;
            const char* a2 = last ? nA : cA + (size_t)(t + 2) * kstep; const char* b2 = last ? nB : cB + (size_t)(t + 2) * kstep;
            const char* a3 = a2 + kstep; const char* b3 = b2 + kstep;
            if (last && has_next) S.a_ready(nxt);
            if constexpr (SP2) {
            PG8_LDB(B0, 0, 0); PG8_LDB(B1, 0, 1); PG8_SCHED; PG8_LDA(At, 0, 0); PG8_STAGE(PG8_SA(1, 1), a1 + hsA_c, voffA);
            PG8_WAIT_V(8); PG8_WAIT_L(0); PG8_BAR; PG8_MMA(0, 0, At, B0); PG8_MMA(0, 1, At, B1); PG8_BAR; PG8_SCHED;
            if (full) PG8_LDA(At, 0, 1); PG8_STAGE(PG8_SB(0, 0), b2, voffB); PG8_STAGE(PG8_SB(0, 1), b2 + hstep, voffB); PG8_STAGE(PG8_SA(0, 0), a2, voffA);
            PG8_WAIT_V(8); PG8_WAIT_L(0); PG8_BAR; if (full) { PG8_MMA(1, 0, At, B0); PG8_MMA(1, 1, At, B1); } PG8_BAR; PG8_SCHED;
            PG8_LDB(B0, 1, 0); PG8_LDB(B1, 1, 1); PG8_SCHED; PG8_LDA(At, 1, 0); PG8_STAGE(PG8_SA(0, 1), a2 + (last ? hsA_n : hsA_c), voffA);
            PG8_WAIT_V(8); PG8_WAIT_L(0); PG8_BAR; PG8_MMA(0, 0, At, B0); PG8_MMA(0, 1, At, B1); PG8_BAR; PG8_SCHED;
            if (full) PG8_LDA(At, 1, 1); PG8_STAGE(PG8_SB(1, 0), b3, voffB); PG8_STAGE(PG8_SB(1, 1), b3 + hstep, voffB); PG8_STAGE(PG8_SA(1, 0), a3, voffA);
            PG8_WAIT_V(8); PG8_WAIT_L(0); PG8_BAR; if (full) { PG8_MMA(1, 0, At, B0); PG8_MMA(1, 1, At, B1); } PG8_BAR; PG8_SCHED;
            } else {
            PG8_LDB(B0, 0, 0); PG8_SCHED; PG8_LDA(At, 0, 0); PG8_STAGE(PG8_SA(1, 1), a1 + hstep, voffA);
            PG8_WAIT_L(8); PG8_BAR; PG8_WAIT_L(0); PG8_MMA(0, 0, At, B0); PG8_BAR; PG8_SCHED;
            PG8_LDB(B1, 0, 1); PG8_STAGE(PG8_SB(0, 0), b2, voffB);
            PG8_BAR; PG8_WAIT_L(0); PG8_MMA(0, 1, At, B1); PG8_BAR;
            PG8_LDA(At, 0, 1); PG8_STAGE(PG8_SA(0, 0), a2, voffA);
            PG8_BAR; PG8_WAIT_L(0); PG8_MMA(1, 0, At, B0); PG8_BAR; PG8_SCHED;
            PG8_STAGE(PG8_SB(0, 1), b2 + hstep, voffB);
            PG8_WAIT_V(6); PG8_BAR; PG8_MMA(1, 1, At, B1); PG8_BAR;
            PG8_LDB(B0, 1, 0); PG8_SCHED; PG8_LDA(At, 1, 0); PG8_STAGE(PG8_SA(0, 1), a2 + hstep, voffA);
            PG8_WAIT_L(8); PG8_BAR; PG8_WAIT_L(0); PG8_MMA(0, 0, At, B0); PG8_BAR; PG8_SCHED;
            PG8_LDB(B1, 1, 1); PG8_STAGE(PG8_SB(1, 0), b3, voffB);
            PG8_BAR; PG8_WAIT_L(0); PG8_MMA(0, 1, At, B1); PG8_BAR;
            PG8_LDA(At, 1, 1); PG8_STAGE(PG8_SA(1, 0), a3, voffA);
            PG8_BAR; PG8_WAIT_L(0); PG8_MMA(1, 0, At, B0); PG8_BAR; PG8_SCHED;
            PG8_STAGE(PG8_SB(1, 1), b3 + hstep, voffB);
            PG8_WAIT_V(6); PG8_BAR; PG8_MMA(1, 1, At, B1); PG8_BAR;
            }
        }
        if constexpr (ALIGN_EPI) { if (wr == 0) PG8_BAR; }
        if constexpr (!Epi::AFTER_DRAIN) { E(acc, cur, wr, wc, fr, fq); S.done(cur); }
        if (!has_next) break;
#pragma unroll
        for (int a = 0; a < 2; ++a)
#pragma unroll
            for (int b = 0; b < 2; ++b)
#pragma unroll
                for (int m = 0; m < 4; ++m)
#pragma unroll
                    for (int n = 0; n < 2; ++n) acc[a][b][m][n] = (acc_t){0, 0, 0, 0};
        cur = nxt; cA = nA; cB = nB; hsA_c = hsA_n; ++ui;
        if constexpr (ALIGN_EPI) { if (wr == 1) PG8_BAR; }
    }
    PG8_WAIT_V(0);
    if constexpr (!ALIGN_EPI) { if (wr == 0) PG8_BAR; }
    PG8_BAR;
    if constexpr (Epi::AFTER_DRAIN) { E.fused(acc, cur, wr, wc, fr, fq, lds, wid, lane); S.done(cur); }
#undef PG8_SA
#undef PG8_SB
#undef PG8_STAGE
#undef PG8_LDA
#undef PG8_LDB
#undef PG8_MMA
#undef PG8_WAIT_V
#undef PG8_WAIT_L
#undef PG8_BAR
#undef PG8_SCHED
}
}

#define LDSP __attribute__((address_space(3)))
typedef unsigned short bf16_t;
typedef short bf16x8 __attribute__((ext_vector_type(8)));
typedef float f32x4 __attribute__((ext_vector_type(4)));
typedef float f32x2 __attribute__((ext_vector_type(2)));
typedef unsigned u32x4 __attribute__((ext_vector_type(4)));
typedef unsigned u32x2 __attribute__((ext_vector_type(2)));
typedef __bf16 bf16x2_t __attribute__((ext_vector_type(2)));

constexpr int D = 2048, TC = 4096, TL = 16384, T = TC + TL, NKEY = 22528;
constexpr int NTH = 512;
constexpr int LDS_BYTES = 147456;

constexpr size_t al256(size_t x) { return (x + 255) & ~(size_t)255; }
constexpr size_t MB = 1024 * 1024;
constexpr size_t WS_CTL    = 0;
constexpr size_t WS_MOD    = 65536;
constexpr size_t WS_ROPE   = WS_MOD + al256((size_t)9 * 4 * 12288 * 4);
constexpr size_t WS_WDOWN  = WS_ROPE + 32768;
constexpr size_t WS_WUQ    = WS_WDOWN + (size_t)1280 * 2048 * 2;
constexpr size_t WS_WUK    = WS_WUQ + (size_t)3072 * 512 * 2;
constexpr size_t WS_WUV    = WS_WUK + (size_t)2048 * 512 * 2;
constexpr size_t WS_WOMLA  = WS_WUV + (size_t)2048 * 512 * 2;
constexpr size_t WSZ_SQ    = (size_t)2048 * 2048 * 2;
constexpr size_t WS_S5IN   = WS_WOMLA + WSZ_SQ;
constexpr size_t WS_S5GATE = WS_S5IN + WSZ_SQ;
constexpr size_t WS_S5OUT  = WS_S5GATE + WSZ_SQ;
constexpr size_t WS_HYIN   = WS_S5OUT + WSZ_SQ;
constexpr size_t WS_HYOUT  = WS_HYIN + (size_t)6144 * 2048 * 2;
constexpr size_t WS_SWAQKV = WS_HYOUT + WSZ_SQ;
constexpr size_t WS_SWAO   = WS_SWAQKV + (size_t)3072 * 2048 * 2;
constexpr size_t WS_PEERQ  = WS_SWAO + WSZ_SQ;
constexpr size_t WS_PKEYS  = WS_PEERQ + 4 * WSZ_SQ;
constexpr size_t WS_HYF    = WS_PKEYS + (size_t)4 * 16 * 128 * 128 * 2;
constexpr size_t WS_UT     = WS_HYF + (size_t)2 * 2048 * 512 * 2 + (size_t)2 * 2048 * 4096 * 2;
constexpr size_t WSZ_TAB   = (size_t)4 * 16384 * 2048;
constexpr size_t WS_VTAB   = WS_UT + WSZ_TAB;
constexpr size_t WS_TSC    = WS_VTAB + WSZ_TAB;
constexpr size_t WS_X      = WS_TSC + (size_t)2 * 4 * 16384 * 4;
constexpr size_t WS_H      = WS_X + (size_t)T * D * 4;
constexpr size_t WS_EID    = WS_H + (size_t)T * D * 2;
constexpr size_t WS_GATE   = WS_EID + (size_t)T * 128 * 4;
constexpr size_t WS_SCR    = WS_GATE + (size_t)T * 128 * 4;
constexpr size_t SC_DOWN = 0;
constexpr size_t SC_CQ   = SC_DOWN + (size_t)T * 1280 * 4;
constexpr size_t SC_CKV  = SC_CQ + (size_t)T * 512 * 2;
constexpr size_t SC_KPE  = SC_CKV + (size_t)NKEY * 512 * 2;
constexpr size_t SC_MQ   = SC_KPE + (size_t)NKEY * 64 * 2;
constexpr size_t SC_KN   = SC_MQ + (size_t)T * 3072 * 2;
constexpr size_t SC_MVT  = SC_KN + (size_t)NKEY * 2048 * 2;
constexpr size_t SC_MO   = SC_MVT + (size_t)NKEY * 2048 * 2;
constexpr size_t SC_MLA_END = SC_MO + (size_t)T * D * 2;
constexpr size_t SZ_ACT  = (size_t)T * D * 2;
constexpr size_t SC_U = 0, SC_YF = SZ_ACT, SC_YB = 2 * SZ_ACT, SC_Z = 3 * SZ_ACT, SC_ZZ = 4 * SZ_ACT;
constexpr size_t SC_ZT = 0;
constexpr size_t SC_VOT = SC_ZT + (size_t)6144 * T * 2;
constexpr size_t SC_VO  = SC_VOT + SZ_ACT;
constexpr size_t SC_SQ = 0;
constexpr size_t SC_SK = SZ_ACT;
constexpr size_t SC_SVT = SC_SK + (size_t)NKEY * 512 * 2;
constexpr size_t SC_SO = SC_SVT + (size_t)NKEY * 512 * 2;
constexpr size_t SC_PQ = 0;
constexpr size_t SC_PA = SZ_ACT;
constexpr size_t SC_X8 = 256 * MB;
constexpr size_t SC_SX = 299 * MB;
constexpr size_t SC_ISC = 299 * MB + 131072;
static_assert(SC_PA + (size_t)16 * T * 128 * 4 <= SC_X8 && SC_X8 + (size_t)T * D <= SC_SX, "peer scratch");
constexpr size_t WS_END = WS_SCR + SC_MLA_END;
static_assert(SC_VO + SZ_ACT <= SC_MLA_END && 5 * SZ_ACT <= SC_MLA_END, "scratch");

constexpr size_t OUT_Y = 0;
constexpr size_t OUT_CKV = (size_t)T * D;
constexpr size_t OUT_KPE = OUT_CKV + (size_t)TC * 512;
constexpr size_t OUT_S5RE = OUT_KPE + (size_t)TC * 64;
constexpr size_t OUT_S5IM = OUT_S5RE + (size_t)16 * 2 * 128 * 64;
constexpr size_t OUT_SWAK = OUT_S5IM + (size_t)16 * 2 * 128 * 64;
constexpr size_t OUT_SWAV = OUT_SWAK + (size_t)TC * 512;
constexpr size_t OUT_END = OUT_SWAV + (size_t)TC * 512;

enum { I_XP = 0, I_XS, I_C, I_CCKV, I_CKPE, I_S5RE, I_S5IM, I_CSK, I_CSV, I_CCTX, I_MODW, I_MODB, I_N1G, I_N2G, I_FING,
       I_MWDOWN, I_MGQ, I_MGKV, I_MWUQ, I_MWUKV, I_MWO, I_S5WIN, I_S5LRE, I_S5LIM, I_S5LDT, I_S5BRE, I_S5BIM, I_S5CRE, I_S5CIM, I_S5D, I_S5WG, I_S5WO,
       I_HWIN, I_HBIN, I_HSW, I_HSB, I_HFW1, I_HFB1, I_HFFREQ, I_HFW2, I_HFB2, I_HFW3, I_HLD, I_HBIAS, I_HWOUT, I_SWQKV, I_SWO, I_SSINK,
       I_PWQ, I_PKEYS, I_PU, I_PV, N_IN };

__device__ __forceinline__ unsigned pk_bf16(float lo, float hi) { const f32x2 v = {lo, hi}; return __builtin_bit_cast(unsigned, __builtin_convertvector(v, bf16x2_t)); }
__device__ __forceinline__ bf16_t f2bf(float f) { return (bf16_t)(pk_bf16(f, 0.f) & 0xffffu); }
__device__ __forceinline__ float bf_lo(unsigned w) { return __uint_as_float(w << 16); }
__device__ __forceinline__ float bf_hi(unsigned w) { return __uint_as_float(w & 0xffff0000u); }
__device__ __forceinline__ float bf2f(bf16_t h) { return __uint_as_float((unsigned)h << 16); }
__device__ __forceinline__ float wave_sum(float v) { v += __shfl_xor(v, 32); v += __shfl_xor(v, 16); v += __shfl_xor(v, 8); v += __shfl_xor(v, 4); v += __shfl_xor(v, 2); v += __shfl_xor(v, 1); return v; }
__device__ __forceinline__ float fexp2(float x) { return __builtin_amdgcn_exp2f(x); }
__device__ __forceinline__ float gelu_tanh(float a) { const float u = 1.5957691216057308f * (a + 0.044715f * a * a * a); return a / (1.f + __expf(-u)); }
__device__ __forceinline__ int keyrow_of(int row) { return row < TC ? row : TC + ((row - TC) >> 11) * 2304 + ((row - TC) & 2047); }
__device__ __forceinline__ int cond_of(int row) { return row < TC ? 0 : 1 + ((row - TC) >> 11); }
__device__ __forceinline__ bf16x8 as_bf16x8(u32x4 v) { return __builtin_bit_cast(bf16x8, v); }
template <int CTRL> __device__ __forceinline__ int dpp_i(int x) { return __builtin_amdgcn_update_dpp(0, x, CTRL, 0xf, 0xf, true); }
template <int CTRL> __device__ __forceinline__ float dpp_f(float x) { return __int_as_float(__builtin_amdgcn_update_dpp(0, __float_as_int(x), CTRL, 0xf, 0xf, true)); }
__device__ __forceinline__ float xsum32(float a, float b) { const auto r = __builtin_amdgcn_permlane32_swap(__float_as_uint(a), __float_as_uint(b), false, false); return __uint_as_float(r[0]) + __uint_as_float(r[1]); }
__device__ __forceinline__ float xsum16(float a, float b) { const auto r = __builtin_amdgcn_permlane16_swap(__float_as_uint(a), __float_as_uint(b), false, false); return __uint_as_float(r[0]) + __uint_as_float(r[1]); }
typedef _Float16 h2_t __attribute__((ext_vector_type(2)));
__device__ __forceinline__ h2_t xsum32h(h2_t a, h2_t b) { const auto r = __builtin_amdgcn_permlane32_swap(__builtin_bit_cast(unsigned, a), __builtin_bit_cast(unsigned, b), false, false); unsigned r0 = r[0], r1 = r[1]; asm volatile("" : "+v"(r0), "+v"(r1)); return __builtin_bit_cast(h2_t, r0) + __builtin_bit_cast(h2_t, r1); }
__device__ __forceinline__ h2_t xsum16h(h2_t a, h2_t b) { const auto r = __builtin_amdgcn_permlane16_swap(__builtin_bit_cast(unsigned, a), __builtin_bit_cast(unsigned, b), false, false); unsigned r0 = r[0], r1 = r[1]; asm volatile("" : "+v"(r0), "+v"(r1)); return __builtin_bit_cast(h2_t, r0) + __builtin_bit_cast(h2_t, r1); }
__device__ __forceinline__ float xmax_16_32(float x) {
    auto s = __builtin_amdgcn_permlane16_swap(__float_as_uint(x), __float_as_uint(x), false, false); x = fmaxf(__uint_as_float(s[0]), __uint_as_float(s[1]));
    auto t = __builtin_amdgcn_permlane32_swap(__float_as_uint(x), __float_as_uint(x), false, false); return fmaxf(__uint_as_float(t[0]), __uint_as_float(t[1])); }
#define WAVE_SYNC() do { asm volatile("s_waitcnt lgkmcnt(0)" ::: "memory"); __builtin_amdgcn_wave_barrier(); } while (0)

namespace pg8 {
template <class F> struct EpiFn {
    static constexpr bool PERM = false, AFTER_DRAIN = false;
    F f;
    template <class AccT>
    __device__ __forceinline__ void operator()(const AccT (&acc)[2][2][4][2], const Unit& u, int wr, int wc, int fr, int fq) const {
        const int row0 = u.arow + wr * 64 + fr, col0 = u.pn * BM + wc * 32 + 4 * fq;
#pragma unroll
        for (int ai = 0; ai < 2; ++ai) {
            if (ai == 1 && u.half) break;
#pragma unroll
            for (int m = 0; m < 4; ++m) {
                const int row = row0 + ai * HALF + m * 16;
#pragma unroll
                for (int bj = 0; bj < 2; ++bj)
#pragma unroll
                    for (int n = 0; n < 2; ++n) f(row, col0 + bj * HALF + n * 16, __builtin_convertvector(acc[ai][bj][m][n], f32x4));
            }
        }
    }
};
template <class F> struct EpiFn8 {
    static constexpr bool PERM = true, AFTER_DRAIN = false;
    F f;
    template <class AccT>
    __device__ __forceinline__ void operator()(const AccT (&acc)[2][2][4][2], const Unit& u, int wr, int wc, int fr, int fq) const {
        const int row0 = u.arow + wr * 64 + fr, col0 = u.pn * BM + wc * 32 + 8 * fq;
#pragma unroll
        for (int ai = 0; ai < 2; ++ai) {
            if (ai == 1 && u.half) break;
#pragma unroll
            for (int m = 0; m < 4; ++m) {
                const int row = row0 + ai * HALF + m * 16;
#pragma unroll
                for (int bj = 0; bj < 2; ++bj)
                    f(row, col0 + bj * HALF, __builtin_convertvector(acc[ai][bj][m][0], f32x4), __builtin_convertvector(acc[ai][bj][m][1], f32x4));
            }
        }
    }
};
template <class F, bool W8 = F::W8> struct EpiSelT { using type = EpiFn<F>; };
template <class F> struct EpiSelT<F, true> { using type = EpiFn8<F>; };
template <class F> using EpiSel = typename EpiSelT<F>::type;
}

__device__ __forceinline__ u32x4 pk8_bf16(const f32x4& a, const f32x4& b) { u32x4 w; w.x = pk_bf16(a[0], a[1]); w.y = pk_bf16(a[2], a[3]); w.z = pk_bf16(b[0], b[1]); w.w = pk_bf16(b[2], b[3]); return w; }
struct FStoreF32 { static constexpr bool W8 = false; float* C; int ldc;
    __device__ __forceinline__ void operator()(int row, int col, f32x4 v) const { *(f32x4*)(C + (size_t)row * ldc + col) = v; } };
struct FStoreBf16 { static constexpr bool W8 = true; bf16_t* O; int ldc;
    __device__ __forceinline__ void operator()(int row, int col, f32x4 v, f32x4 v2) const { *(u32x4*)(O + (size_t)row * ldc + col) = pk8_bf16(v, v2); } };
struct FStoreBf16RowBias { static constexpr bool W8 = true; bf16_t* O; int ldc; const float* bias;
    __device__ __forceinline__ void operator()(int row, int col, f32x4 v, f32x4 v2) const { const float b = bias[row]; *(u32x4*)(O + (size_t)row * ldc + col) = pk8_bf16(v + b, v2 + b); } };
struct FResidIn { static constexpr bool W8 = true; const float* xc; const float* xl; bf16_t* X; const float* gate;
    __device__ __forceinline__ void operator()(int row, int col, f32x4 v, f32x4 v2) const {
        const float* xr = (row < TC ? xc + (size_t)row * D : xl + (size_t)(row - TC) * D) + col; const float* gp = gate + (size_t)cond_of(row) * 4 * 12288 + col;
        *(u32x4*)(X + (size_t)row * D + col) = pk8_bf16(*(const f32x4*)xr + *(const f32x4*)gp * v, *(const f32x4*)(xr + 4) + *(const f32x4*)(gp + 4) * v2); } };
struct FResid { static constexpr bool W8 = true; bf16_t* X; const float* gate;
    __device__ __forceinline__ void operator()(int row, int col, f32x4 v, f32x4 v2) const {
        bf16_t* xp = X + (size_t)row * D + col; const float* gp = gate + (size_t)cond_of(row) * 4 * 12288 + col; const u32x4 x = *(const u32x4*)xp;
        const f32x4 x0 = {bf_lo(x.x), bf_hi(x.x), bf_lo(x.y), bf_hi(x.y)}, x1 = {bf_lo(x.z), bf_hi(x.z), bf_lo(x.w), bf_hi(x.w)};
        *(u32x4*)xp = pk8_bf16(x0 + *(const f32x4*)gp * v, x1 + *(const f32x4*)(gp + 4) * v2); } };
__device__ __forceinline__ void rope8(f32x4& v, f32x4& v2, const float* cs, int soff, int f0) {
    const f32x4 c = *(const f32x4*)(cs + f0), s = *(const f32x4*)(cs + soff + f0);
    const float a0 = v[0], b0 = v[1], a1 = v[2], b1 = v[3], a2 = v2[0], b2 = v2[1], a3 = v2[2], b3 = v2[3];
    v[0] = a0 * c[0] - b0 * s[0]; v[1] = a0 * s[0] + b0 * c[0]; v[2] = a1 * c[1] - b1 * s[1]; v[3] = a1 * s[1] + b1 * c[1];
    v2[0] = a2 * c[2] - b2 * s[2]; v2[1] = a2 * s[2] + b2 * c[2]; v2[2] = a3 * c[3] - b3 * s[3]; v2[3] = a3 * s[3] + b3 * c[3];
}
struct FMlaQ { static constexpr bool W8 = true; bf16_t* Q; const float* rope;
    __device__ __forceinline__ void operator()(int row, int col, f32x4 v, f32x4 v2) const {
        const int r = col % 192;
        if (r >= 128 && row >= TC) {
            const int l = (row - TC) & 2047, p = r - 128, pi = p >> 1, a = pi >> 4, f = pi & 15, pos = a ? (l & 63) : (l >> 6);
            rope8(v, v2, rope + pos * 16, 1024, f);
        }
        *(u32x4*)(Q + (size_t)row * 3072 + col) = pk8_bf16(v, v2); } };
struct FS5Gate { static constexpr bool W8 = true; const bf16_t* Z; bf16_t* ZZ;
    __device__ __forceinline__ void operator()(int row, int col, f32x4 v, f32x4 v2) const {
        const u32x4 z = *(const u32x4*)(Z + (size_t)row * D + col);
        f32x4 o, o2;
        o[0] = bf_lo(z.x) / (1.f + __expf(-v[0])); o[1] = bf_hi(z.x) / (1.f + __expf(-v[1])); o[2] = bf_lo(z.y) / (1.f + __expf(-v[2])); o[3] = bf_hi(z.y) / (1.f + __expf(-v[3]));
        o2[0] = bf_lo(z.z) / (1.f + __expf(-v2[0])); o2[1] = bf_hi(z.z) / (1.f + __expf(-v2[1])); o2[2] = bf_lo(z.w) / (1.f + __expf(-v2[2])); o2[3] = bf_hi(z.w) / (1.f + __expf(-v2[3]));
        *(u32x4*)(ZZ + (size_t)row * D + col) = pk8_bf16(o, o2); } };
struct FSwaQK { static constexpr bool W8 = true; bf16_t* Q; bf16_t* KALL; float* outk; const float* rope;
    __device__ __forceinline__ void operator()(int row, int col, f32x4 v, f32x4 v2) const {
        const int p = col & 127, pi = p >> 1, a = pi >> 5, f = pi & 31;
        if (row >= TC) {
            const int l = (row - TC) & 2047, pos = a ? (l & 63) : (l >> 6);
            rope8(v, v2, rope + pos * 32, 2048, f);
        }
        const u32x4 w = pk8_bf16(v, v2);
        if (col < 2048) *(u32x4*)(Q + (size_t)row * D + col) = w;
        else {
            const int kc = col - 2048;
            *(u32x4*)(KALL + (size_t)keyrow_of(row) * 512 + kc) = w;
            if (row < TC) { float* o = outk + (size_t)row * 512 + (kc & ~127) + 64 * a + f;
                f32x4 e, od; e[0] = v[0]; e[1] = v[2]; e[2] = v2[0]; e[3] = v2[2]; od[0] = v[1]; od[1] = v[3]; od[2] = v2[1]; od[3] = v2[3];
                *(f32x4*)o = e; *(f32x4*)(o + 32) = od; }
        } } };
struct FSwaVT { static constexpr bool W8 = true; bf16_t* VT; float* outv;
    __device__ __forceinline__ void operator()(int row, int col, f32x4 v, f32x4 v2) const {
        *(u32x4*)(VT + (size_t)row * NKEY + keyrow_of(col)) = pk8_bf16(v, v2);
        if (col < TC) { float* o = outv + (size_t)col * 512 + row; o[0] = v[0]; o[512] = v[1]; o[1024] = v[2]; o[1536] = v[3]; o[2048] = v2[0]; o[2560] = v2[1]; o[3072] = v2[2]; o[3584] = v2[3]; } } };

struct FStoreBf16Scaled { static constexpr bool W8 = true; bf16_t* O; int ldc; const float* sa; const float* sb;
    __device__ __forceinline__ void operator()(int row, int col, f32x4 v, f32x4 v2) const { const float a = sa[row]; const f32x4 b = *(const f32x4*)(sb + col), b2 = *(const f32x4*)(sb + col + 4);
        *(u32x4*)(O + (size_t)row * ldc + col) = pk8_bf16(v * a * b, v2 * a * b2); } };
template <class F> __device__ __forceinline__ void run_gemm_i8_tok(LDSP unsigned char* lds, const void* A8, const void* B8, int Kb, const F& f) {
    pg8::Gemm g{(const bf16_t*)A8, (const bf16_t*)B8, T, D, Kb / 2}; pg8::EpiSel<F> E{f};
    pg8::HalfOrder S; S.init(TL, T, D, (int)gridDim.x, (int)blockIdx.x); pg8::gemm_phase<pg8::EpiSel<F>, pg8::HalfOrder, true, true, true>(lds, g, S, E);
}
template <class F> __device__ __forceinline__ void run_gemm_i8(LDSP unsigned char* lds, const void* A8, const void* B8, int M, int N, int Kb, const F& f) {
    pg8::Gemm g{(const bf16_t*)A8, (const bf16_t*)B8, M, N, Kb / 2}; pg8::StaticOrder S; S.init(M, N, (int)gridDim.x, (int)blockIdx.x);
    pg8::EpiSel<F> E{f};
    pg8::gemm_phase<pg8::EpiSel<F>, pg8::StaticOrder, true, true, true>(lds, g, S, E);
}
template <class F> __device__ __forceinline__ void run_gemm_tok(LDSP unsigned char* lds, const bf16_t* A, const bf16_t* Bt, int K, const F& f) {
    pg8::Gemm g{A, Bt, T, D, K}; pg8::EpiSel<F> E{f};
    pg8::HalfOrder S; S.init(TL, T, D, (int)gridDim.x, (int)blockIdx.x); pg8::gemm_phase<pg8::EpiSel<F>, pg8::HalfOrder, true, true>(lds, g, S, E);
}
template <class F> __device__ __forceinline__ void run_gemm_tailhalf(LDSP unsigned char* lds, const bf16_t* A, const bf16_t* Bt, int M, int N, int K, const F& f) {
    const int nwg = (M / pg8::BM) * (N / pg8::BM), G = (int)gridDim.x, rem = nwg % G;
    const int nh = (rem * 2 == G && nwg % 8 == 0 && (G / 2) % 8 == 0) ? G / 2 : 0;
    pg8::Gemm g{A, Bt, M, N, K}; pg8::TailHalfOrder S; S.init(M, N, nh, G, (int)blockIdx.x);
    pg8::EpiSel<F> E{f};
    pg8::gemm_phase<pg8::EpiSel<F>, pg8::TailHalfOrder, true, true>(lds, g, S, E);
}
template <class F> __device__ __forceinline__ void run_gemm(LDSP unsigned char* lds, const bf16_t* A, const bf16_t* Bt, int M, int N, int K, const F& f, int rot = 0) {
    pg8::Gemm g{A, Bt, M, N, K}; pg8::StaticOrder S; S.init(M, N, (int)gridDim.x, (int)((blockIdx.x + gridDim.x - rot) % gridDim.x));
    pg8::EpiSel<F> E{f};
    pg8::gemm_phase<pg8::EpiSel<F>, pg8::StaticOrder, true, true>(lds, g, S, E);
}
#define XB_TMO      128
#define XB_XCNT(j)  (256  + 64 * (j))
#define XB_XSUB(j)  (1280 + 64 * (j))
#define XB_XGEN(j)  (2304 + 64 * (j))
#define XB_TOP      3328
#define XB_TOPGEN   3392
#define XCD_BAR_WORDS 3456
#define XB_SPIN_CAP (1u << 22)
#define LAS __attribute__((address_space(3)))

__device__ __forceinline__ unsigned xb_ld(unsigned* p)              { return __hip_atomic_load(p, __ATOMIC_RELAXED, __HIP_MEMORY_SCOPE_AGENT); }
__device__ __forceinline__ unsigned xb_add(unsigned* p, unsigned v) { return __hip_atomic_fetch_add(p, v, __ATOMIC_RELAXED, __HIP_MEMORY_SCOPE_AGENT); }
__device__ __forceinline__ unsigned xb_xcc_id() { return (unsigned)__builtin_amdgcn_s_getreg((3 << 11) | 20) & 0xFu; }
#define XB_SPIN(cond, bar) do { unsigned _sp = 0; while (cond) { __builtin_amdgcn_s_sleep(1); \
    if ((++_sp & 255u) == 0u) { if (xb_ld(&(bar)[XB_TMO])) break; if (_sp > XB_SPIN_CAP) { atomicAdd(&(bar)[XB_TMO], 1u); break; } } } } while (0)

struct XcdBarrier {
    unsigned* bar; unsigned x;
    volatile LAS unsigned* st;
};

__device__ __forceinline__ XcdBarrier xcd_barrier_post(unsigned* bar, volatile LAS unsigned* st) {
    XcdBarrier b; b.bar = bar; b.x = xb_xcc_id(); b.st = st;
    if (threadIdx.x == 0) (void)xb_add(&bar[XB_XCNT(b.x)], 1u);
    return b;
}
__device__ __forceinline__ void xcd_barrier_complete(unsigned* bar, unsigned x, unsigned& nloc, unsigned& nx) {
    const unsigned G = gridDim.x * gridDim.y * gridDim.z;
    unsigned sum, cnt, mine, sp = 0u;
    for (;;) {
        sum = 0u; cnt = 0u; mine = 0u;
#pragma unroll
        for (unsigned j = 0; j < 16; ++j) { const unsigned c = xb_ld(&bar[XB_XCNT(j)]); sum += c; cnt += (c > 0u) ? 1u : 0u; mine = (j == x) ? c : mine; }
        if (sum == G) break;
        __builtin_amdgcn_s_sleep(1);
        if ((++sp & 255u) == 0u) { if (xb_ld(&bar[XB_TMO])) break; if (sp > XB_SPIN_CAP) { atomicAdd(&bar[XB_TMO], 1u); break; } }
    }
    nloc = mine > 0u ? mine : 1u; nx = cnt > 0u ? cnt : 1u;
}

__device__ __forceinline__ void xcd_barrier(const XcdBarrier& b) {
    asm volatile("s_waitcnt vmcnt(0)" ::: "memory");
    __syncthreads();
    if (threadIdx.x == 0) {
        unsigned* bar = b.bar;
        __builtin_amdgcn_s_waitcnt(0);
        unsigned nloc = b.st[0], nx = b.st[1];
        if (nloc == 0u) { xcd_barrier_complete(bar, b.x, nloc, nx); b.st[0] = nloc; b.st[1] = nx; }
        const unsigned old = xb_add(&bar[XB_XSUB(b.x)], 1u);
        const unsigned gen = old / nloc;
        if (old + 1u == (gen + 1u) * nloc) {
            __builtin_amdgcn_fence(__ATOMIC_RELEASE, "agent");
            asm volatile("s_waitcnt vmcnt(0)" ::: "memory");
            const unsigned og = xb_add(&bar[XB_TOP], 1u);
            const unsigned tg = og / nx;
            if (og + 1u == (tg + 1u) * nx) xb_add(&bar[XB_TOPGEN], 1u);
            else XB_SPIN(xb_ld(&bar[XB_TOPGEN]) == tg, bar);
            __builtin_amdgcn_fence(__ATOMIC_ACQUIRE, "agent");
            xb_add(&bar[XB_XGEN(b.x)], 1u);
            asm volatile("s_waitcnt vmcnt(0)" ::: "memory");
        } else {
            XB_SPIN(xb_ld(&bar[XB_XGEN(b.x)]) == gen, bar);
            __builtin_amdgcn_fence(__ATOMIC_ACQUIRE, "agent");
            asm volatile("s_waitcnt vmcnt(0)" ::: "memory");
        }
    }
    __syncthreads();
}

__device__ __forceinline__ int src_col(int mode, int n) {
    if (mode == 1) { const int h = n / 192, r = n % 192; if (r < 128) return n; const int p = r - 128, pi = p >> 1, a = pi >> 4, f = pi & 15; return h * 192 + 128 + 32 * a + f + 16 * (p & 1); }
    if (mode == 2) return (n >> 7) * 256 + (n & 127);
    if (mode == 3) return (n >> 7) * 256 + 128 + (n & 127);
    if (mode == 4) { if (n >= 2560) return n; const int h = n >> 7, p = n & 127, pi = p >> 1, a = pi >> 5, f = pi & 31; return h * 128 + 64 * a + f + 32 * (p & 1); }
    return n;
}
struct CvtJob { int in_idx; unsigned src_off; size_t dst_off; int K, ldsrc, nvalid, nrows, mode; };
__device__ __forceinline__ void cvt_transpose_all(LDSP float* tile, const float* const* in, unsigned char* ws) {
    const CvtJob jobs[12] = {
        {I_MWDOWN, 0u, WS_WDOWN, 2048, 1088, 1088, 1280, 0}, {I_MWUQ, 0u, WS_WUQ, 512, 3072, 3072, 3072, 1}, {I_MWUKV, 0u, WS_WUK, 512, 4096, 2048, 2048, 2}, {I_MWUKV, 0u, WS_WUV, 512, 4096, 2048, 2048, 3},
        {I_MWO, 0u, WS_WOMLA, 2048, 2048, 2048, 2048, 0}, {I_S5WIN, 0u, WS_S5IN, 2048, 2048, 2048, 2048, 0}, {I_S5WG, 0u, WS_S5GATE, 2048, 2048, 2048, 2048, 0}, {I_S5WO, 0u, WS_S5OUT, 2048, 2048, 2048, 2048, 0},
        {I_HWIN, 0u, WS_HYIN, 2048, 6144, 6144, 6144, 0}, {I_HWOUT, 0u, WS_HYOUT, 2048, 2048, 2048, 2048, 0}, {I_SWQKV, 0u, WS_SWAQKV, 2048, 3072, 3072, 3072, 4}, {I_SWO, 0u, WS_SWAO, 2048, 2048, 2048, 2048, 0} };
    const int tid = threadIdx.x;
    int total = 0;
#pragma unroll
    for (int j = 0; j < 12; ++j) total += (jobs[j].nrows >> 6) * (jobs[j].K >> 6);
    float r[8];
#define CT_DECODE(t_, src_, dst_, K_, n0_, k0_) do { int rem_ = (t_); int ji_ = 0; \
        _Pragma("unroll") for (int j_ = 0; j_ < 11; ++j_) { const int nt_ = (jobs[j_].nrows >> 6) * (jobs[j_].K >> 6); if (ji_ == j_ && rem_ >= nt_) { rem_ -= nt_; ji_ = j_ + 1; } } \
        int in_idx_ = 0, ldsrc_ = 0, nvalid_ = 0, nrows_ = 64, mode_ = 0; unsigned so_ = 0; size_t do_ = 0; K_ = 64; \
        _Pragma("unroll") for (int j_ = 0; j_ < 12; ++j_) if (ji_ == j_) { in_idx_ = jobs[j_].in_idx; so_ = jobs[j_].src_off; do_ = jobs[j_].dst_off; K_ = jobs[j_].K; ldsrc_ = jobs[j_].ldsrc; nvalid_ = jobs[j_].nvalid; nrows_ = jobs[j_].nrows; mode_ = jobs[j_].mode; } \
        const int tn_ = nrows_ >> 6; n0_ = (rem_ % tn_) << 6; k0_ = (rem_ / tn_) << 6; dst_ = (bf16_t*)(ws + do_); \
        const int n_ = n0_ + (tid & 63); const bool valid_ = n_ < nvalid_; const int sc_ = valid_ ? src_col(mode_, n_) : 0; \
        src_ = valid_ ? in[in_idx_] + so_ + (size_t)(k0_ + (tid >> 6)) * ldsrc_ + sc_ : nullptr; ldr_ = ldsrc_; } while (0)
    int t = blockIdx.x;
    const float* src = nullptr; bf16_t* dst = nullptr; int K = 64, n0 = 0, k0 = 0, ldr_ = 0;
    float rb[8]; bf16_t* dstb = nullptr; int Kb = 64, n0b = 0, k0b = 0;
#define CT_LOAD(reg_) do { _Pragma("unroll") for (int i = 0; i < 8; ++i) reg_[i] = src ? src[(size_t)(8 * i) * ldr_] : 0.f; } while (0)
    if (t < total) { CT_DECODE(t, src, dst, K, n0, k0); CT_LOAD(r); }
    if (t + (int)gridDim.x < total) { CT_DECODE(t + (int)gridDim.x, src, dstb, Kb, n0b, k0b); CT_LOAD(rb); }
    for (; t < total; t += gridDim.x) {
#pragma unroll
        for (int i = 0; i < 8; ++i) tile[((tid >> 6) + 8 * i) * 65 + (tid & 63)] = r[i];
        bf16_t* cdst = dst; const int cK = K, cn0 = n0, ck0 = k0;
#pragma unroll
        for (int i = 0; i < 8; ++i) r[i] = rb[i];
        dst = dstb; K = Kb; n0 = n0b; k0 = k0b;
        const int tn = t + 2 * (int)gridDim.x;
        if (tn < total) { CT_DECODE(tn, src, dstb, Kb, n0b, k0b); CT_LOAD(rb); }
        __syncthreads();
        { const int nn = tid >> 3, kq = tid & 7; float v[8];
#pragma unroll
          for (int j = 0; j < 8; ++j) v[j] = tile[(kq * 8 + j) * 65 + nn];
          u32x4 w; w.x = pk_bf16(v[0], v[1]); w.y = pk_bf16(v[2], v[3]); w.z = pk_bf16(v[4], v[5]); w.w = pk_bf16(v[6], v[7]);
          *(u32x4*)(cdst + (size_t)(cn0 + nn) * cK + ck0 + kq * 8) = w; }
        __syncthreads();
    }
#undef CT_LOAD
#undef CT_DECODE
}
__device__ __forceinline__ void cvt_transpose_i8(LDSP unsigned char* lds, const float* __restrict__ src, unsigned char* __restrict__ dst8, float* __restrict__ wscale, int nmat) {
    LDSP float* tile = (LDSP float*)lds; LDSP float* red = tile + 64 * 65; LDSP float* inv = red + 512;
    const int tid = threadIdx.x, nn = tid & 63, kg = tid >> 6;
    for (int strip = blockIdx.x; strip < nmat * 32; strip += gridDim.x) {
        const int mat = strip >> 5, n0 = (strip & 31) * 64;
        const float* sm = src + (size_t)mat * 2048 * 2048 + n0;
        float mx = 0.f;
        for (int i = 0; i < 256; i += 8) {
            float v[8];
#pragma unroll
            for (int u = 0; u < 8; ++u) v[u] = sm[(size_t)(kg + 8 * (i + u)) * 2048 + nn];
#pragma unroll
            for (int u = 0; u < 8; ++u) mx = fmaxf(mx, fabsf(v[u]));
        }
        red[kg * 64 + nn] = mx;
        __syncthreads();
        if (tid < 64) { float m = red[tid];
#pragma unroll
            for (int g = 1; g < 8; ++g) m = fmaxf(m, red[g * 64 + tid]);
            inv[tid] = m > 0.f ? 127.f / m : 1.f; wscale[mat * 2048 + n0 + tid] = m > 0.f ? m / 127.f : 1.f; }
        __syncthreads();
        for (int k0 = 0; k0 < 2048; k0 += 64) {
#pragma unroll
            for (int i = 0; i < 8; ++i) { const int kk = kg + 8 * i; tile[kk * 65 + nn] = sm[(size_t)(k0 + kk) * 2048 + nn]; }
            __syncthreads();
            { const int n2 = tid >> 3, kq = tid & 7; const float s = inv[n2]; int q[8];
#pragma unroll
              for (int j = 0; j < 8; ++j) q[j] = (int)rintf(tile[(kq * 8 + j) * 65 + n2] * s);
              u32x2 w; w.x = (unsigned)(q[0] & 255) | ((unsigned)(q[1] & 255) << 8) | ((unsigned)(q[2] & 255) << 16) | ((unsigned)(q[3] & 255) << 24);
              w.y = (unsigned)(q[4] & 255) | ((unsigned)(q[5] & 255) << 8) | ((unsigned)(q[6] & 255) << 16) | ((unsigned)(q[7] & 255) << 24);
              *(u32x2*)(dst8 + ((size_t)mat * 2048 + n0 + n2) * 2048 + k0 + kq * 8) = w; }
            __syncthreads();
        }
    }
}
__device__ __forceinline__ void cvt_direct(const float* __restrict__ src, bf16_t* __restrict__ dst, size_t n) {
    const size_t ng = n >> 3, stride = (size_t)gridDim.x * NTH;
    for (size_t g = (size_t)blockIdx.x * NTH + threadIdx.x; g < ng; g += stride) {
        const f32x4 a = __builtin_nontemporal_load((const f32x4*)(src + g * 8)), b = __builtin_nontemporal_load((const f32x4*)(src + g * 8 + 4));
        u32x4 w; w.x = pk_bf16(a[0], a[1]); w.y = pk_bf16(a[2], a[3]); w.z = pk_bf16(b[0], b[1]); w.w = pk_bf16(b[2], b[3]);
        *(u32x4*)(dst + g * 8) = w;
    }
}
__device__ __forceinline__ void mod_phase(LDSP unsigned char* lds, const float* __restrict__ c_ctx, const float* __restrict__ c, const float* __restrict__ mod_w, const float* __restrict__ mod_b, float* __restrict__ mod) {
    LDSP float* act = (LDSP float*)lds;
    LDSP f32x4* red = (LDSP f32x4*)(lds + 73728);
    const int tid = threadIdx.x, lane = tid & 63, wave = tid >> 6;
    if ((int)blockIdx.x >= 192) return;
    for (int i = tid; i < 9 * 2048; i += NTH) { const int ci = i >> 11, k = i & 2047; const float x = ci == 0 ? c_ctx[k] : c[(ci - 1) * 2048 + k]; act[i] = x / (1.f + __expf(-x)); }
    __syncthreads();
    for (int item = blockIdx.x; item < 192; item += gridDim.x) {
        const int layer = item / 48, n0 = (item % 48) * 256;
        const float* wp = mod_w + ((size_t)layer * 2048 + wave) * 12288 + n0 + 4 * lane;
        f32x4 acc[9];
#pragma unroll
        for (int ci = 0; ci < 9; ++ci) acc[ci] = (f32x4){0.f, 0.f, 0.f, 0.f};
        for (int kk = 0; kk < 256; kk += 16) {
            f32x4 w[16];
#pragma unroll
            for (int u = 0; u < 16; ++u) w[u] = __builtin_nontemporal_load((const f32x4*)(wp + (size_t)(8 * (kk + u)) * 12288));
#pragma unroll
            for (int u = 0; u < 16; ++u)
#pragma unroll
                for (int ci = 0; ci < 9; ++ci) acc[ci] += act[ci * 2048 + wave + 8 * (kk + u)] * w[u];
        }
#pragma unroll
        for (int half = 4; half >= 1; half >>= 1) {
            if (wave >= half && wave < 2 * half) {
#pragma unroll
                for (int ci = 0; ci < 9; ++ci) red[((wave - half) * 9 + ci) * 64 + lane] = acc[ci]; }
            __syncthreads();
            if (wave < half) {
#pragma unroll
                for (int ci = 0; ci < 9; ++ci) acc[ci] += red[(wave * 9 + ci) * 64 + lane]; }
            __syncthreads();
        }
        if (wave == 0) { const f32x4 bb = *(const f32x4*)(mod_b + layer * 12288 + n0 + 4 * lane);
#pragma unroll
            for (int ci = 0; ci < 9; ++ci) *(f32x4*)(mod + ((size_t)ci * 4 + layer) * 12288 + n0 + 4 * lane) = acc[ci] + bb; }
    }
}
__device__ __forceinline__ void rope_tables(float* rt) {
    const int i = blockIdx.x * NTH + threadIdx.x;
    if (i < 1024) { const int pos = i >> 4, f = i & 15; const float ang = (float)pos * powf(10000.f, -(float)(2 * f) / 32.f); rt[i] = cosf(ang); rt[1024 + i] = sinf(ang); }
    else if (i < 1024 + 2048) { const int j = i - 1024, pos = j >> 5, f = j & 31; const float ang = (float)pos * powf(10000.f, -(float)(2 * f) / 64.f); rt[2048 + j] = cosf(ang); rt[4096 + j] = sinf(ang); }
}
__device__ __forceinline__ void hy_filter_phase(LDSP unsigned char* lds, const float* __restrict__ w1, const float* __restrict__ b1, const float* __restrict__ freq, const float* __restrict__ w2, const float* __restrict__ b2,
                                                const float* __restrict__ w3, const float* __restrict__ log_decay, bf16_t* __restrict__ F) {
    LDSP float* z1 = (LDSP float*)lds; LDSP float* z2 = z1 + 8 * 64;
    const int tid = threadIdx.x;
    for (int u = blockIdx.x; u < 576; u += gridDim.x) {
        const int dirn = u & 1, lc = u >> 1, grp = lc >= 32, L = grp ? 2048 : 256, l0 = (grp ? lc - 32 : lc) * 8;
        bf16_t* Fg = F + (grp ? (size_t)2 * 2048 * 512 : 0);
        const float invL = 1.f / (float)L;
        { const int li = tid >> 6, j = tid & 63, l = l0 + dirn + li; float v = 0.f;
            if (l < L) { const float t = (float)l * invL; float s = b1[j] + t * w1[j];
                for (int k = 1; k <= 8; ++k) { const float ang = 6.283185307179586f * t * (float)k; s += sinf(ang) * w1[k * 64 + j] + cosf(ang) * w1[(8 + k) * 64 + j]; }
                v = sinf(freq[j] * s); }
            z1[tid] = v; }
        __syncthreads();
        { const int li = tid >> 6, j = tid & 63, l = l0 + dirn + li; float v = 0.f;
            if (l < L) { float s = b2[j]; for (int i = 0; i < 64; ++i) s += z1[li * 64 + i] * w2[i * 64 + j]; v = sinf(freq[64 + j] * s); }
            z2[tid] = v; }
        __syncthreads();
        float acc[8][8];
#pragma unroll
        for (int jj = 0; jj < 8; ++jj)
#pragma unroll
            for (int r = 0; r < 8; ++r) acc[jj][r] = 0.f;
        const float* wb = w3 + 4096 * dirn + tid;
        float wa[8], wbn[8];
#pragma unroll
        for (int jj = 0; jj < 8; ++jj) { wa[jj] = wb[512 * jj]; wbn[jj] = wb[8192 + 512 * jj]; }
        for (int i = 0; i < 64; i += 2) {
            float wc[8], wd[8];
#pragma unroll
            for (int jj = 0; jj < 8; ++jj) { wc[jj] = wa[jj]; wd[jj] = wbn[jj]; }
            { const int i2 = i + 2 < 64 ? i + 2 : i, i3 = i + 3 < 64 ? i + 3 : i;
#pragma unroll
              for (int jj = 0; jj < 8; ++jj) { wa[jj] = wb[(size_t)i2 * 8192 + 512 * jj]; wbn[jj] = wb[(size_t)i3 * 8192 + 512 * jj]; } }
            float zr[8], zs[8];
#pragma unroll
            for (int r = 0; r < 8; ++r) { zr[r] = z2[r * 64 + i]; zs[r] = z2[r * 64 + i + 1]; }
#pragma unroll
            for (int jj = 0; jj < 8; ++jj)
#pragma unroll
                for (int r = 0; r < 8; ++r) acc[jj][r] += zr[r] * wc[jj] + zs[r] * wd[jj];
        }
#pragma unroll
        for (int jj = 0; jj < 8; ++jj) {
            const int col = 4096 * dirn + tid + 512 * jj, o = (col >> 11) & 1, d = col & 2047;
            const float dec = __expf(log_decay[(dirn * 2 + o) * 2048 + d]);
            float vals[8];
#pragma unroll
            for (int r = 0; r < 8; ++r) vals[r] = acc[jj][r] * __expf(-((float)(l0 + r + dirn) * invL) * dec);
            bf16_t* dst = Fg + ((size_t)o * 2048 + d) * (size_t)(2 * L);
            u32x4 w;
            if (dirn == 0) { w.x = pk_bf16(vals[7], vals[6]); w.y = pk_bf16(vals[5], vals[4]); w.z = pk_bf16(vals[3], vals[2]); w.w = pk_bf16(vals[1], vals[0]); *(u32x4*)(dst + L - l0 - 8) = w; }
            else { w.x = pk_bf16(vals[0], vals[1]); w.y = pk_bf16(vals[2], vals[3]); w.z = pk_bf16(vals[4], vals[5]); w.w = pk_bf16(vals[6], vals[7]); *(u32x4*)(dst + L + l0) = w; }
        }
        __syncthreads();
    }
}

#define NP_COL(i_) (512 * ((i_) >> 1) + 8 * lane + 4 * ((i_) & 1))
template <bool XBF> __device__ __forceinline__ void np_load(f32x4 (&dst)[8], const float* xc, const float* xl, const bf16_t* X, int row, int lane) {
    if (XBF) { const bf16_t* xr = X + (size_t)row * D;
#pragma unroll
        for (int p = 0; p < 4; ++p) { const u32x4 x = *(const u32x4*)(xr + 512 * p + 8 * lane); dst[2 * p] = (f32x4){bf_lo(x.x), bf_hi(x.x), bf_lo(x.y), bf_hi(x.y)}; dst[2 * p + 1] = (f32x4){bf_lo(x.z), bf_hi(x.z), bf_lo(x.w), bf_hi(x.w)}; }
    } else { const float* xr = row < TC ? xc + (size_t)row * D : xl + (size_t)(row - TC) * D;
#pragma unroll
        for (int i = 0; i < 8; ++i) dst[i] = *(const f32x4*)(xr + NP_COL(i)); }
}
__device__ __forceinline__ void np_raw(u32x4 (&q)[4], const bf16_t* X, int row, int lane) {
#pragma unroll
    for (int p = 0; p < 4; ++p) q[p] = *(const u32x4*)(X + (size_t)row * D + 512 * p + 8 * lane);
}
__device__ __forceinline__ void np_unpack(f32x4 (&dst)[8], const u32x4 (&q)[4]) {
#pragma unroll
    for (int p = 0; p < 4; ++p) { const u32x4 x = q[p]; dst[2 * p] = (f32x4){bf_lo(x.x), bf_hi(x.x), bf_lo(x.y), bf_hi(x.y)}; dst[2 * p + 1] = (f32x4){bf_lo(x.z), bf_hi(x.z), bf_lo(x.w), bf_hi(x.w)}; }
}
template <bool XBF> __device__ __forceinline__ void norm_phase(const float* __restrict__ xc, const float* __restrict__ xl, const bf16_t* __restrict__ X, const float* __restrict__ gain, const float* __restrict__ mp, bf16_t* __restrict__ H, unsigned* __restrict__ X8 = nullptr, float* __restrict__ SX = nullptr) {
    const int lane = threadIdx.x & 63, gw = blockIdx.x * 8 + (threadIdx.x >> 6), nw = gridDim.x * 8, per = (T + nw - 1) / nw;
    const int r0 = gw * per, r1 = r0 + per < T ? r0 + per : T;
    if (r0 >= r1) return;
    f32x4 ca[8], cb[8], v[8], vn[8]; int ccur = -1; u32x4 qn[4];
    if (XBF) np_raw(qn, X, r0, lane); else np_load<false>(vn, xc, xl, X, r0, lane);
    for (int row = r0; row < r1; ++row) {
        if (XBF) np_unpack(v, qn);
        else {
#pragma unroll
            for (int i = 0; i < 8; ++i) v[i] = vn[i]; }
#pragma unroll
        for (int i = 0; i < 8; ++i) asm volatile("" : "+v"(v[i]));
        const int cnd = cond_of(row);
        if (cnd != ccur) { ccur = cnd; const float* m = mp + (size_t)cnd * 4 * 12288;
#pragma unroll
            for (int i = 0; i < 8; ++i) { const int col = NP_COL(i); ca[i] = *(const f32x4*)(gain + col) * (*(const f32x4*)(m + 2048 + col) + 1.f); cb[i] = *(const f32x4*)(m + col); }
#pragma unroll
            for (int i = 0; i < 8; ++i) asm volatile("" : "+v"(ca[i]), "+v"(cb[i]));
        }
        if (row + 1 < r1) { if (XBF) np_raw(qn, X, row + 1, lane); else np_load<false>(vn, xc, xl, X, row + 1, lane); }
        float ss = 0.f;
#pragma unroll
        for (int i = 0; i < 8; ++i) ss += v[i][0] * v[i][0] + v[i][1] * v[i][1] + v[i][2] * v[i][2] + v[i][3] * v[i][3];
        ss = wave_sum(ss);
        const float rstd = rsqrtf(ss * (1.f / 2048.f) + 1e-6f);
        float amax = 0.f;
#pragma unroll
        for (int i = 0; i < 8; ++i) { const f32x4 y = v[i] * rstd * ca[i] + cb[i]; v[i] = y;
            amax = fmaxf(amax, fmaxf(fmaxf(fabsf(y[0]), fabsf(y[1])), fmaxf(fabsf(y[2]), fabsf(y[3])))); }
        if (H) {
#pragma unroll
            for (int p = 0; p < 4; ++p) *(u32x4*)(H + (size_t)row * D + 512 * p + 8 * lane) = pk8_bf16(v[2 * p], v[2 * p + 1]); }
        if (X8) {
            amax = fmaxf(amax, __shfl_xor(amax, 32)); amax = fmaxf(amax, __shfl_xor(amax, 16)); amax = fmaxf(amax, __shfl_xor(amax, 8)); amax = fmaxf(amax, __shfl_xor(amax, 4)); amax = fmaxf(amax, __shfl_xor(amax, 2)); amax = fmaxf(amax, __shfl_xor(amax, 1));
            const float qs = amax > 0.f ? 127.f / amax : 1.f;
#pragma unroll
            for (int p = 0; p < 4; ++p) { u32x2 w;
#pragma unroll
                for (int h = 0; h < 2; ++h) { const f32x4 y = v[2 * p + h]; const int q0 = (int)rintf(y[0] * qs), q1 = (int)rintf(y[1] * qs), q2 = (int)rintf(y[2] * qs), q3 = (int)rintf(y[3] * qs);
                    w[h] = (unsigned)(q0 & 255) | ((unsigned)(q1 & 255) << 8) | ((unsigned)(q2 & 255) << 16) | ((unsigned)(q3 & 255) << 24); }
                *(u32x2*)(X8 + (size_t)row * 512 + 128 * p + 2 * lane) = w; }
            if (lane == 0) SX[row] = amax > 0.f ? amax / 127.f : 1.f;
        }
    }
}
__device__ __forceinline__ void final_norm_phase(const bf16_t* __restrict__ X, const float* __restrict__ gain, float* __restrict__ out) {
    const int lane = threadIdx.x & 63, gw = blockIdx.x * 8 + (threadIdx.x >> 6), nw = gridDim.x * 8, per = (T + nw - 1) / nw;
    const int r0 = gw * per, r1 = r0 + per < T ? r0 + per : T;
    if (r0 >= r1) return;
    f32x4 g[8], v[8]; u32x4 qn[4];
#pragma unroll
    for (int i = 0; i < 8; ++i) g[i] = *(const f32x4*)(gain + NP_COL(i));
    np_raw(qn, X, r0, lane);
    for (int row = r0; row < r1; ++row) {
        np_unpack(v, qn); if (row + 1 < r1) np_raw(qn, X, row + 1, lane);
        float ss = 0.f;
#pragma unroll
        for (int i = 0; i < 8; ++i) ss += v[i][0] * v[i][0] + v[i][1] * v[i][1] + v[i][2] * v[i][2] + v[i][3] * v[i][3];
        ss = wave_sum(ss);
        const float rstd = rsqrtf(ss * (1.f / 2048.f) + 1e-6f);
#pragma unroll
        for (int i = 0; i < 8; ++i) *(f32x4*)(out + (size_t)row * D + NP_COL(i)) = v[i] * rstd * g[i];
    }
}
#undef NP_COL

__device__ __forceinline__ void mla_rows_phase(const bf16_t* __restrict__ DOWN, const float* __restrict__ g_q, const float* __restrict__ g_kv, const float* __restrict__ cache_ckv, const float* __restrict__ cache_kpe,
                                               const float* __restrict__ rope, bf16_t* __restrict__ CQ, bf16_t* __restrict__ CKV, bf16_t* __restrict__ KPE, float* __restrict__ out_ckv, float* __restrict__ out_kpe) {
    const int lane = threadIdx.x & 63, gw = blockIdx.x * 8 + (threadIdx.x >> 6), nw = gridDim.x * 8;
    const int ra = lane >> 5, ri = lane & 31, rf = ri & 15, rx2 = ri >> 4, rp = 2 * (16 * ra + rf) + rx2;
    for (int r = gw; r < T + 2048; r += nw) {
        if (r < T) {
            const int row = r, krow = keyrow_of(row);
            const bf16_t* dr = DOWN + (size_t)row * 1280;
#define MR_LD4(p_) ({ const u32x2 t_ = *(const u32x2*)(p_); (f32x4){bf_lo(t_.x), bf_hi(t_.x), bf_lo(t_.y), bf_hi(t_.y)}; })
            {
                const f32x4 a0 = MR_LD4(dr + 4 * lane), a1 = MR_LD4(dr + 256 + 4 * lane);
                float ss = a0[0] * a0[0] + a0[1] * a0[1] + a0[2] * a0[2] + a0[3] * a0[3] + a1[0] * a1[0] + a1[1] * a1[1] + a1[2] * a1[2] + a1[3] * a1[3];
                ss = wave_sum(ss); const float rstd = rsqrtf(ss * (1.f / 512.f) + 1e-6f);
                const f32x4 g0 = *(const f32x4*)(g_q + 4 * lane), g1 = *(const f32x4*)(g_q + 256 + 4 * lane);
                const f32x4 y0 = a0 * rstd * g0, y1 = a1 * rstd * g1;
                u32x2 w; w.x = pk_bf16(y0[0], y0[1]); w.y = pk_bf16(y0[2], y0[3]); *(u32x2*)(CQ + (size_t)row * 512 + 4 * lane) = w;
                w.x = pk_bf16(y1[0], y1[1]); w.y = pk_bf16(y1[2], y1[3]); *(u32x2*)(CQ + (size_t)row * 512 + 256 + 4 * lane) = w;
            }
            {
                const f32x4 a0 = MR_LD4(dr + 512 + 4 * lane), a1 = MR_LD4(dr + 768 + 4 * lane);
                float ss = a0[0] * a0[0] + a0[1] * a0[1] + a0[2] * a0[2] + a0[3] * a0[3] + a1[0] * a1[0] + a1[1] * a1[1] + a1[2] * a1[2] + a1[3] * a1[3];
                ss = wave_sum(ss); const float rstd = rsqrtf(ss * (1.f / 512.f) + 1e-6f);
                const f32x4 g0 = *(const f32x4*)(g_kv + 4 * lane), g1 = *(const f32x4*)(g_kv + 256 + 4 * lane);
                const f32x4 y0 = a0 * rstd * g0, y1 = a1 * rstd * g1;
                u32x2 w; w.x = pk_bf16(y0[0], y0[1]); w.y = pk_bf16(y0[2], y0[3]); *(u32x2*)(CKV + (size_t)krow * 512 + 4 * lane) = w;
                w.x = pk_bf16(y1[0], y1[1]); w.y = pk_bf16(y1[2], y1[3]); *(u32x2*)(CKV + (size_t)krow * 512 + 256 + 4 * lane) = w;
                if (row < TC) { *(f32x4*)(out_ckv + (size_t)row * 512 + 4 * lane) = y0; *(f32x4*)(out_ckv + (size_t)row * 512 + 256 + 4 * lane) = y1; }
            }
            {
                const float v = __uint_as_float((unsigned)dr[1024 + lane] << 16);
#undef MR_LD4
                if (row < TC) { out_kpe[(size_t)row * 64 + lane] = v; KPE[(size_t)krow * 64 + rp] = f2bf(v); }
                else {
                    const int l = (row - TC) & 2047, pos = ra ? (l & 63) : (l >> 6);
                    const float c = rope[pos * 16 + rf], s = rope[1024 + pos * 16 + rf];
                    const float other = __shfl_xor(v, 16);
                    const float x1 = rx2 ? other : v, x2 = rx2 ? v : other;
                    KPE[(size_t)krow * 64 + rp] = f2bf(rx2 ? (x1 * s + x2 * c) : (x1 * c - x2 * s));
                }
            }
        } else {
            const int cr = r - T, b = cr >> 8, pos = cr & 255, krow = TC + b * 2304 + 2048 + pos;
            const float* src = cache_ckv + (size_t)cr * 512;
            const f32x4 a0 = *(const f32x4*)(src + 4 * lane), a1 = *(const f32x4*)(src + 256 + 4 * lane);
            u32x2 w; w.x = pk_bf16(a0[0], a0[1]); w.y = pk_bf16(a0[2], a0[3]); *(u32x2*)(CKV + (size_t)krow * 512 + 4 * lane) = w;
            w.x = pk_bf16(a1[0], a1[1]); w.y = pk_bf16(a1[2], a1[3]); *(u32x2*)(CKV + (size_t)krow * 512 + 256 + 4 * lane) = w;
            KPE[(size_t)krow * 64 + rp] = f2bf(cache_kpe[(size_t)cr * 64 + lane]);
        }
    }
}

template <int DK2>
__device__ __forceinline__ void attn_unit(LDSP unsigned char* lds,
        const bf16_t* __restrict__ Qp, int q_ld, int qrow0, const bf16_t* __restrict__ K1p, int k1_ld, const bf16_t* __restrict__ K2p, int k2_ld,
        const bf16_t* __restrict__ VTp, int vt_ld, bf16_t* __restrict__ Op, int o_ld, float scale_log2, bool has_sink, float sink_log2,
        int kb0, int nt0, int kb1, int nt1, bool band, int qpos0, int kpos0) {
    constexpr int DK = 128 + DK2, NDS = DK / 32, KROW = DK * 2 + 16, VROW = 144, KT_BYTES = 64 * KROW, VT_BYTES = 128 * VROW;
    const int tid = threadIdx.x, lane = tid & 63, wave = tid >> 6, fr = lane & 15, fq = lane >> 4;
    bf16x8 Qf[2][NDS];
#pragma unroll
    for (int qs = 0; qs < 2; ++qs)
#pragma unroll
        for (int ds = 0; ds < NDS; ++ds) Qf[qs][ds] = *(const bf16x8*)(Qp + (size_t)(qrow0 + 32 * wave + 16 * qs + fr) * q_ld + 32 * ds + 8 * fq);
    f32x4 O[2][8];
#pragma unroll
    for (int qs = 0; qs < 2; ++qs)
#pragma unroll
        for (int n = 0; n < 8; ++n) O[qs][n] = (f32x4){0.f, 0.f, 0.f, 0.f};
    float mrow[2] = {-1e30f, -1e30f}, lrow[2] = {0.f, 0.f};
    const int nt = nt0 + nt1;
    u32x4 rs[3];
    rs[2] = (u32x4){0u, 0u, 0u, 0u};
#define ATT_KB(t_) ((t_) < nt0 ? kb0 + 64 * (t_) : kb1 + 64 * ((t_) - nt0))
#define ATT_LOADK(t_) do { const int kb_ = ATT_KB(t_); \
        _Pragma("unroll") for (int i_ = 0; i_ < 2; ++i_) { const int c_ = tid + 512 * i_; rs[i_] = *(const u32x4*)(K1p + (size_t)(kb_ + (c_ >> 4)) * k1_ld + (c_ & 15) * 8); } \
        if (DK2) rs[2] = *(const u32x4*)(K2p + (size_t)(kb_ + (tid >> 3)) * k2_ld + (tid & 7) * 8); } while (0)
#define ATT_STOREK(b_) do { LDSP unsigned char* Kb_ = lds + (b_) * KT_BYTES; \
        _Pragma("unroll") for (int i_ = 0; i_ < 2; ++i_) { const int c_ = tid + 512 * i_; *(LDSP u32x4*)(Kb_ + (c_ >> 4) * KROW + (c_ & 15) * 16) = rs[i_]; } \
        if (DK2) *(LDSP u32x4*)(Kb_ + (tid >> 3) * KROW + 256 + (tid & 7) * 16) = rs[2]; } while (0)
#define ATT_LOADV(t_) do { const int kb_ = ATT_KB(t_); \
        _Pragma("unroll") for (int i_ = 0; i_ < 2; ++i_) { const int c_ = tid + 512 * i_; rs[i_] = *(const u32x4*)(VTp + (size_t)(c_ >> 3) * vt_ld + kb_ + (c_ & 7) * 8); } } while (0)
#define ATT_STOREV(b_) do { LDSP unsigned char* Vb_ = lds + 2 * KT_BYTES + (b_) * VT_BYTES; \
        _Pragma("unroll") for (int i_ = 0; i_ < 2; ++i_) { const int c_ = tid + 512 * i_; *(LDSP u32x4*)(Vb_ + (c_ >> 3) * VROW + (c_ & 7) * 16) = rs[i_]; } } while (0)
    ATT_LOADK(0); ATT_STOREK(0); ATT_LOADV(0); ATT_STOREV(0);
    __syncthreads();
    for (int t = 0; t < nt; ++t) {
        const int b = t & 1;
        if (t + 1 < nt) ATT_LOADK(t + 1);
        LDSP unsigned char* Kb = lds + b * KT_BYTES; LDSP unsigned char* Vb = lds + 2 * KT_BYTES + b * VT_BYTES;
        f32x4 S[2][4];
#pragma unroll
        for (int qs = 0; qs < 2; ++qs)
#pragma unroll
            for (int kt = 0; kt < 4; ++kt) S[qs][kt] = (f32x4){0.f, 0.f, 0.f, 0.f};
#pragma unroll
        for (int ds = 0; ds < NDS; ++ds)
#pragma unroll
            for (int kt = 0; kt < 4; ++kt) {
                const bf16x8 kf = *(const LDSP bf16x8*)(Kb + (16 * kt + fr) * KROW + (32 * ds + 8 * fq) * 2);
                S[0][kt] = __builtin_amdgcn_mfma_f32_16x16x32_bf16(kf, Qf[0][ds], S[0][kt], 0, 0, 0);
                S[1][kt] = __builtin_amdgcn_mfma_f32_16x16x32_bf16(kf, Qf[1][ds], S[1][kt], 0, 0, 0);
            }
        if (t + 1 < nt) { ATT_STOREK(b ^ 1); ATT_LOADV(t + 1); }
        bf16x8 Pf[2][2];
        const bool do_mask = band && t < nt0;
#pragma unroll
        for (int qs = 0; qs < 2; ++qs) {
            float sv[16]; float mx = -INFINITY;
            const int qpos = qpos0 + 32 * wave + 16 * qs + fr;
#pragma unroll
            for (int kt = 0; kt < 4; ++kt)
#pragma unroll
                for (int j = 0; j < 4; ++j) { float x = S[qs][kt][j];
                    if (do_mask) { const int dlt = qpos - (kpos0 + 64 * t + 16 * kt + 4 * fq + j); if (dlt > 128 || dlt < -128) x = -INFINITY; }
                    sv[kt * 4 + j] = x; mx = fmaxf(mx, x); }
            mx = xmax_16_32(mx);
            const float mnew = fmaxf(mrow[qs], mx * scale_log2), alpha = fexp2(mrow[qs] - mnew); mrow[qs] = mnew;
            if (__builtin_amdgcn_ballot_w64(alpha < 1.f) != 0ull) {
#pragma unroll
                for (int n = 0; n < 8; ++n) O[qs][n] *= alpha;
            }
            float ps = 0.f;
#pragma unroll
            for (int i = 0; i < 16; ++i) { sv[i] = fexp2(__builtin_fmaf(sv[i], scale_log2, -mnew)); ps += sv[i]; }
            lrow[qs] = lrow[qs] * alpha + ps;
#pragma unroll
            for (int s = 0; s < 2; ++s) { u32x4 w; w.x = pk_bf16(sv[8 * s + 0], sv[8 * s + 1]); w.y = pk_bf16(sv[8 * s + 2], sv[8 * s + 3]); w.z = pk_bf16(sv[8 * s + 4], sv[8 * s + 5]); w.w = pk_bf16(sv[8 * s + 6], sv[8 * s + 7]); Pf[qs][s] = as_bf16x8(w); }
        }
#pragma unroll
        for (int s = 0; s < 2; ++s)
#pragma unroll
            for (int n = 0; n < 8; ++n) {
                const LDSP unsigned char* vp = Vb + (16 * n + fr) * VROW + (32 * s + 4 * fq) * 2;
                const u32x2 lo = *(const LDSP u32x2*)vp, hi = *(const LDSP u32x2*)(vp + 32);
                const bf16x8 vf = as_bf16x8((u32x4){lo.x, lo.y, hi.x, hi.y});
                O[0][n] = __builtin_amdgcn_mfma_f32_16x16x32_bf16(vf, Pf[0][s], O[0][n], 0, 0, 0);
                O[1][n] = __builtin_amdgcn_mfma_f32_16x16x32_bf16(vf, Pf[1][s], O[1][n], 0, 0, 0);
            }
        if (t + 1 < nt) ATT_STOREV(b ^ 1);
        __syncthreads();
    }
#undef ATT_KB
#undef ATT_LOADK
#undef ATT_STOREK
#undef ATT_LOADV
#undef ATT_STOREV
#pragma unroll
    for (int qs = 0; qs < 2; ++qs) {
        float lt = lrow[qs]; lt += __shfl_xor(lt, 16); lt += __shfl_xor(lt, 32);
        const float mf = has_sink ? fmaxf(mrow[qs], sink_log2) : mrow[qs], a = fexp2(mrow[qs] - mf);
        const float denom = lt * a + (has_sink ? fexp2(sink_log2 - mf) : 0.f), inv = a / denom;
        bf16_t* orow = Op + (size_t)(qrow0 + 32 * wave + 16 * qs + fr) * o_ld + 4 * fq;
#pragma unroll
        for (int n = 0; n < 8; ++n) { const f32x4 o = O[qs][n] * inv; u32x2 w; w.x = pk_bf16(o[0], o[1]); w.y = pk_bf16(o[2], o[3]); *(u32x2*)(orow + 16 * n) = w; }
    }
}

template <int KIND>
__device__ __forceinline__ void attn_phase(LDSP unsigned char* lds, const bf16_t* Q, const bf16_t* K1, const bf16_t* K2, const bf16_t* VT, bf16_t* O, const float* sink) {
    const float LOG2E = 1.4426950408889634f;
    for (int u0 = blockIdx.x; u0 < 1280; u0 += gridDim.x) {
        int u = u0;
        if (gridDim.x == 256 && u0 < 1024) {
            const int j = u0 >> 8, x = u0 & 255, vx = x & 7, r = x >> 3;
            u = ((32 * j + 4 * vx + (r >> 3)) << 3) | (r & 7);
        }
        int b, head, qb, qrow0, kb0, nt0, kb1 = 0, nt1 = 0, qpos0 = 0, kpos0 = 0; bool band = false;
        if (u < 1024) { b = u >> 7; head = (u >> 3) & 15; qb = u & 7; qrow0 = TC + b * 2048 + qb * 256; const int kbase = TC + b * 2304;
            if (KIND == 0) { kb0 = kbase; nt0 = 36; }
            else { const int lo = qb * 256 - 128 < 0 ? 0 : qb * 256 - 128, hi = qb * 256 + 384 > 2048 ? 2048 : qb * 256 + 384; kb0 = kbase + lo; nt0 = (hi - lo) >> 6; kb1 = kbase + 2048; nt1 = 4; band = true; qpos0 = qb * 256; kpos0 = lo; }
        } else { const int v = u - 1024; b = v >> 4; head = v & 15; qb = 0; qrow0 = b * 256; kb0 = b * 256; nt0 = 4; }
        if (KIND == 0)
            attn_unit<64>(lds, Q + head * 192, 3072, qrow0, K1 + head * 128, 2048, K2, 64, VT + (size_t)(head * 128) * NKEY, NKEY, O + head * 128, D,
                          0.07216878364870322f * LOG2E, false, 0.f, kb0, nt0, kb1, nt1, false, 0, 0);
        else
            attn_unit<0>(lds, Q + head * 128, D, qrow0, K1 + (head >> 2) * 128, 512, nullptr, 0, VT + (size_t)((head >> 2) * 128) * NKEY, NKEY, O + head * 128, D,
                         0.08838834764831845f * LOG2E, true, sink[head] * LOG2E, kb0, nt0, kb1, nt1, band, qpos0, kpos0);
    }
}

__device__ __forceinline__ void s5_chain(LDSP unsigned char* wl, const bf16_t* __restrict__ U, bf16_t* __restrict__ Y, int rowbase, int L, int b, int g, int dir,
        const float* __restrict__ lam_re, const float* __restrict__ lam_im, const float* __restrict__ log_dt, const float* __restrict__ b_re, const float* __restrict__ b_im,
        const float* __restrict__ c_re, const float* __restrict__ c_im, const float* __restrict__ h0re, const float* __restrict__ h0im, float* __restrict__ fin_re, float* __restrict__ fin_im) {
    const int lane = threadIdx.x & 63, fr = lane & 15, fq = lane >> 4, p = lane;
    const int pg = dir * 128 + g;
    float a_re, a_im, cf_re, cf_im;
    { const float lr = lam_re[pg * 64 + p], li = lam_im[pg * 64 + p], dt = __expf(log_dt[pg]);
      const float ea = __expf(lr * dt); float sn, cs; sincosf(li * dt, &sn, &cs); a_re = ea * cs; a_im = ea * sn;
      const float den = 1.f / (lr * lr + li * li), nr = a_re - 1.f, ni = a_im; cf_re = (nr * lr + ni * li) * den; cf_im = (ni * lr - nr * li) * den; }
    bf16x8 Bf[8];
#pragma unroll
    for (int k = 0; k < 4; ++k) {
        const int pk = 16 * k + fr; const float cr = __shfl(cf_re, pk), cim = __shfl(cf_im, pk);
        u32x4 wre = (u32x4){0u, 0u, 0u, 0u}, wim = (u32x4){0u, 0u, 0u, 0u};
        if (fq < 2) {
            const float* br = b_re + ((size_t)pg * 64 + pk) * 16 + 8 * fq; const float* bi = b_im + ((size_t)pg * 64 + pk) * 16 + 8 * fq;
            const f32x4 r0 = *(const f32x4*)br, r1 = *(const f32x4*)(br + 4), i0 = *(const f32x4*)bi, i1 = *(const f32x4*)(bi + 4);
            const f32x4 xr0 = r0 * cr - i0 * cim, xr1 = r1 * cr - i1 * cim, xi0 = i0 * cr + r0 * cim, xi1 = i1 * cr + r1 * cim;
            wre.x = pk_bf16(xr0[0], xr0[1]); wre.y = pk_bf16(xr0[2], xr0[3]); wre.z = pk_bf16(xr1[0], xr1[1]); wre.w = pk_bf16(xr1[2], xr1[3]);
            wim.x = pk_bf16(xi0[0], xi0[1]); wim.y = pk_bf16(xi0[2], xi0[3]); wim.z = pk_bf16(xi1[0], xi1[1]); wim.w = pk_bf16(xi1[2], xi1[3]);
        }
        Bf[k] = as_bf16x8(wre); Bf[4 + k] = as_bf16x8(wim);
    }
    bf16x8 Cf[4];
#pragma unroll
    for (int ks = 0; ks < 4; ++ks) {
        const float* src = (ks < 2 ? c_re : c_im) + ((size_t)pg * 16 + fr) * 64 + (ks & 1) * 32 + 8 * fq;
        f32x4 v0 = *(const f32x4*)src, v1 = *(const f32x4*)(src + 4);
        if (ks >= 2) { v0 = -v0; v1 = -v1; }
        u32x4 w; w.x = pk_bf16(v0[0], v0[1]); w.y = pk_bf16(v0[2], v0[3]); w.z = pk_bf16(v1[0], v1[1]); w.w = pk_bf16(v1[2], v1[3]); Cf[ks] = as_bf16x8(w);
    }
    float h_re = 0.f, h_im = 0.f;
    if (h0re) { const size_t hi = (((size_t)b * 2 + dir) * 128 + g) * 64 + p; h_re = h0re[hi]; h_im = h0im[hi]; }
    LDSP float* BUl = (LDSP float*)wl;
    LDSP unsigned char* Hl = wl + 16 * 132 * 4;
    const int nch = L >> 4;
    const bf16_t* ubase = U + (size_t)rowbase * D + 16 * g + 8 * fq;
    u32x4 uf = (u32x4){0u, 0u, 0u, 0u};
    if (fq < 2) { const int tt = dir ? L - 1 - fr : fr; uf = *(const u32x4*)(ubase + (size_t)tt * D); }
    for (int ci = 0; ci < nch; ++ci) {
        u32x4 ufn = (u32x4){0u, 0u, 0u, 0u};
        if (fq < 2 && ci + 1 < nch) { const int r = 16 * (ci + 1) + fr, tt = dir ? L - 1 - r : r; ufn = *(const u32x4*)(ubase + (size_t)tt * D); }
        const bf16x8 ua = as_bf16x8(uf);
#pragma unroll
        for (int nt = 0; nt < 8; ++nt) {
            const f32x4 bu = __builtin_amdgcn_mfma_f32_16x16x32_bf16(ua, Bf[nt], (f32x4){0.f, 0.f, 0.f, 0.f}, 0, 0, 0);
#pragma unroll
            for (int j = 0; j < 4; ++j) BUl[(4 * fq + j) * 132 + 16 * nt + fr] = bu[j];
        }
        WAVE_SYNC();
#pragma unroll
        for (int r = 0; r < 16; ++r) {
            const float br = BUl[r * 132 + p], bi = BUl[r * 132 + 64 + p];
            const float nre = a_re * h_re - a_im * h_im + br, nim = a_re * h_im + a_im * h_re + bi;
            h_re = nre; h_im = nim;
            *(LDSP bf16_t*)(Hl + r * 272 + p * 2) = f2bf(h_re); *(LDSP bf16_t*)(Hl + r * 272 + 128 + p * 2) = f2bf(h_im);
        }
        WAVE_SYNC();
        f32x4 y = (f32x4){0.f, 0.f, 0.f, 0.f};
#pragma unroll
        for (int ks = 0; ks < 4; ++ks) { const bf16x8 hf = *(const LDSP bf16x8*)(Hl + fr * 272 + (32 * ks + 8 * fq) * 2); y = __builtin_amdgcn_mfma_f32_16x16x32_bf16(hf, Cf[ks], y, 0, 0, 0); }
#pragma unroll
        for (int j = 0; j < 4; ++j) { const int r = 16 * ci + 4 * fq + j, tt = dir ? L - 1 - r : r; Y[(size_t)(rowbase + tt) * D + 16 * g + fr] = f2bf(y[j]); }
        WAVE_SYNC();
        uf = ufn;
    }
    if (fin_re) { const size_t fi = (((size_t)b * 2 + dir) * 128 + g) * 64 + p; fin_re[fi] = h_re; fin_im[fi] = h_im; }
}
__device__ __forceinline__ void s5_scan_phase(LDSP unsigned char* lds, const bf16_t* U, bf16_t* YF, bf16_t* YB, const float* const* in, float* out) {
    const int wave = threadIdx.x >> 6, gw = blockIdx.x * 8 + wave, nw = gridDim.x * 8;
    LDSP unsigned char* wl = lds + wave * 12800;
    for (int c = gw; c < 2048; c += nw) {
        const int b = c >> 8, g = (c >> 1) & 127, dir = c & 1;
        s5_chain(wl, U, dir ? YB : YF, TC + b * 2048, 2048, b, g, dir, in[I_S5LRE], in[I_S5LIM], in[I_S5LDT], in[I_S5BRE], in[I_S5BIM], in[I_S5CRE], in[I_S5CIM], in[I_S5RE], in[I_S5IM], nullptr, nullptr);
    }
    for (int c = gw; c < 4096; c += nw) {
        const int b = c >> 8, g = (c >> 1) & 127, dir = c & 1;
        s5_chain(wl, U, dir ? YB : YF, b * 256, 256, b, g, dir, in[I_S5LRE], in[I_S5LIM], in[I_S5LDT], in[I_S5BRE], in[I_S5BIM], in[I_S5CRE], in[I_S5CIM], nullptr, nullptr, out + OUT_S5RE, out + OUT_S5IM);
    }
}
__device__ __forceinline__ void s5_combine_phase(const bf16_t* __restrict__ U, const bf16_t* __restrict__ YF, const bf16_t* __restrict__ YB, const float* __restrict__ dvec, bf16_t* __restrict__ Z) {
    const size_t ng = (size_t)T * D / 8, stride = (size_t)gridDim.x * NTH;
    constexpr int NU = 4;
    size_t gi = (size_t)blockIdx.x * NTH + threadIdx.x;
    const int col = (int)((gi * 8) & 2047); const f32x4 d0 = *(const f32x4*)(dvec + col), d1 = *(const f32x4*)(dvec + col + 4);
#define S5C_ONE(u_, yf_, yb_, g_) do { u32x4 w; \
        w.x = pk_bf16(gelu_tanh(d0[0] * bf_lo(u_.x) + bf_lo(yf_.x) + bf_lo(yb_.x)), gelu_tanh(d0[1] * bf_hi(u_.x) + bf_hi(yf_.x) + bf_hi(yb_.x))); \
        w.y = pk_bf16(gelu_tanh(d0[2] * bf_lo(u_.y) + bf_lo(yf_.y) + bf_lo(yb_.y)), gelu_tanh(d0[3] * bf_hi(u_.y) + bf_hi(yf_.y) + bf_hi(yb_.y))); \
        w.z = pk_bf16(gelu_tanh(d1[0] * bf_lo(u_.z) + bf_lo(yf_.z) + bf_lo(yb_.z)), gelu_tanh(d1[1] * bf_hi(u_.z) + bf_hi(yf_.z) + bf_hi(yb_.z))); \
        w.w = pk_bf16(gelu_tanh(d1[2] * bf_lo(u_.w) + bf_lo(yf_.w) + bf_lo(yb_.w)), gelu_tanh(d1[3] * bf_hi(u_.w) + bf_hi(yf_.w) + bf_hi(yb_.w))); \
        *(u32x4*)(Z + (g_) * 8) = w; } while (0)
    for (; gi + (NU - 1) * stride < ng; gi += NU * stride) {
        u32x4 u[NU], yf[NU], yb[NU];
#pragma unroll
        for (int k = 0; k < NU; ++k) { const size_t g = gi + k * stride; u[k] = *(const u32x4*)(U + g * 8); yf[k] = *(const u32x4*)(YF + g * 8); yb[k] = *(const u32x4*)(YB + g * 8); }
        asm volatile("" ::: "memory"); __builtin_amdgcn_sched_barrier(0);
#pragma unroll
        for (int k = 0; k < NU; ++k) { const size_t g = gi + k * stride; S5C_ONE(u[k], yf[k], yb[k], g); }
    }
    for (; gi < ng; gi += stride) { const u32x4 u = *(const u32x4*)(U + gi * 8), yf = *(const u32x4*)(YF + gi * 8), yb = *(const u32x4*)(YB + gi * 8); S5C_ONE(u, yf, yb, gi); }
#undef S5C_ONE
}

__device__ __forceinline__ u32x4 shl_elems(u32x4 lo, u32x4 hi, int s) {
    const unsigned d[8] = {lo.x, lo.y, lo.z, lo.w, hi.x, hi.y, hi.z, hi.w};
    const int dw = s >> 1; u32x4 r;
    if (s & 1) { r.x = __builtin_amdgcn_alignbyte(d[dw + 1], d[dw], 2); r.y = __builtin_amdgcn_alignbyte(d[dw + 2], d[dw + 1], 2); r.z = __builtin_amdgcn_alignbyte(d[dw + 3], d[dw + 2], 2); r.w = __builtin_amdgcn_alignbyte(d[(dw + 4) & 7], d[dw + 3], 2); }
    else { r.x = d[dw]; r.y = d[dw + 1]; r.z = d[dw + 2]; r.w = d[dw + 3]; }
    return r;
}
template <int NB, int L, bool ROLL, int GW>
__device__ __forceinline__ void hy_conv_unit(LDSP unsigned char* lds0, int d0, int tokbase, const bf16_t* __restrict__ ZT, const bf16_t* __restrict__ Fg,
        const float* __restrict__ short_w, const float* __restrict__ short_b, const float* __restrict__ bias, bf16_t* __restrict__ VOT, int dnext, unsigned& sink) {
    constexpr int VSROW = L * 2 + 16, FCROW = 4 * L + 32, NT = L / 16, TPW = NT / GW, NTHG = 64 * GW, GSZ = 2 * NB * VSROW + 8 * FCROW;
    static_assert(!ROLL || (TPW == 16 && GW == 8), "rolling window is written for 16 tiles per wave");
    static_assert((8 / GW) * GSZ <= LDS_BYTES, "LDS");
    const int tid = threadIdx.x, lane = tid & 63, wv = __builtin_amdgcn_readfirstlane(tid >> 6), grp = GW == 8 ? 0 : wv / GW, wave = GW == 8 ? wv : wv % GW, gtid = tid % NTHG, d = d0 + grp, fr = lane & 15, fq = lane >> 4;
    LDSP unsigned char* lds = lds0 + grp * GSZ;
    LDSP unsigned char* VS = lds; LDSP unsigned char* XS = lds + NB * VSROW; LDSP unsigned char* FC = lds + 2 * NB * VSROW;
#define HY_T0(i_) (ROLL ? 16 * (16 * wave + (i_)) : 16 * (wave + GW * (i_)))
    constexpr int NCH = NB * L / 8 / NTHG;
#define HY_FENCE() do { asm volatile("" ::: "memory"); __builtin_amdgcn_sched_barrier(0); } while (0)
#define HY_PINW(cw_) asm volatile("" : "+v"(cw_[0]), "+v"(cw_[1]), "+v"(cw_[2]), "+v"(cw_[3]))
#define HY_PINF(a_, b_, c_) asm volatile("" : "+v"(a_), "+v"(b_), "+v"(c_))
#define HY_LD(zq_, zl_, zr_, ch_) do { const bf16_t* base_ = ZT + (size_t)(ch_) * T + tokbase; \
        _Pragma("unroll") for (int k_ = 0; k_ < NCH; ++k_) { const int c_ = gtid + k_ * NTHG, b_ = c_ / (L / 8), t8_ = (c_ % (L / 8)) * 8; const bf16_t* src_ = base_ + b_ * L; \
            zq_[k_] = *(const u32x4*)(src_ + t8_); zl_[k_] = src_[t8_ > 0 ? t8_ - 1 : 0]; zr_[k_] = src_[t8_ + 8 < L ? t8_ + 8 : L - 1]; } } while (0)
#define HY_LDW(cw_, ch_) do { const int chv_ = (ch_); cw_[0] = short_w[chv_]; cw_[1] = short_w[6144 + chv_]; cw_[2] = short_w[2 * 6144 + chv_]; cw_[3] = short_b[chv_]; } while (0)
#define HY_ST(dst_, zq_, zl_, zr_, cw_) do { const float w0_ = cw_[0], w1_ = cw_[1], w2_ = cw_[2], sb_ = cw_[3]; \
        _Pragma("unroll") for (int k_ = 0; k_ < NCH; ++k_) { const int c_ = gtid + k_ * NTHG, b_ = c_ / (L / 8), t8_ = (c_ % (L / 8)) * 8; \
            const u32x4 z_ = zq_[k_]; float zz_[10]; zz_[0] = t8_ > 0 ? bf2f(zl_[k_]) : 0.f; zz_[9] = t8_ + 8 < L ? bf2f(zr_[k_]) : 0.f; \
            zz_[1] = bf_lo(z_.x); zz_[2] = bf_hi(z_.x); zz_[3] = bf_lo(z_.y); zz_[4] = bf_hi(z_.y); zz_[5] = bf_lo(z_.z); zz_[6] = bf_hi(z_.z); zz_[7] = bf_lo(z_.w); zz_[8] = bf_hi(z_.w); \
            float o_[8]; _Pragma("unroll") for (int j_ = 0; j_ < 8; ++j_) o_[j_] = w0_ * zz_[j_] + w1_ * zz_[j_ + 1] + w2_ * zz_[j_ + 2] + sb_; \
            u32x4 w_; w_.x = pk_bf16(o_[0], o_[1]); w_.y = pk_bf16(o_[2], o_[3]); w_.z = pk_bf16(o_[4], o_[5]); w_.w = pk_bf16(o_[6], o_[7]); \
            *(LDSP u32x4*)((dst_) + b_ * VSROW + t8_ * 2) = w_; } } while (0)
    constexpr int NQ = 2 * L / 8;
    static_assert(NQ <= NTHG, "filter groups");
#define HY_FLD(cm_, c0_, cp_, o_) do { const bf16_t* Fo_ = Fg + ((size_t)(o_) * 2048 + d) * (size_t)(2 * L); const int q_ = gtid < NQ ? gtid : 0; \
        cm_ = *(const u32x4*)(Fo_ + 8 * (q_ > 0 ? q_ - 1 : 0)); c0_ = *(const u32x4*)(Fo_ + 8 * q_); cp_ = *(const u32x4*)(Fo_ + 8 * (q_ + 1 < NQ ? q_ + 1 : q_)); } while (0)
#define HY_FST(cm_, c0_, cp_) do { if (gtid < NQ) { const int q_ = gtid; const u32x4 z0_ = (u32x4){0u, 0u, 0u, 0u}; const u32x4 cmv_ = q_ > 0 ? cm_ : z0_, cpv_ = q_ + 1 < NQ ? cp_ : z0_; \
            *(LDSP u32x4*)(FC + 0 * FCROW + q_ * 16) = shl_elems(cmv_, c0_, 7); \
            _Pragma("unroll") for (int c_ = 1; c_ < 8; ++c_) *(LDSP u32x4*)(FC + c_ * FCROW + q_ * 16) = shl_elems(c0_, cpv_, c_ - 1); } } while (0)
#define HY_AFRAG(phi_) (*(const LDSP bf16x8*)(FC + cc_ * FCROW + ((8 * fq - 16 * (phi_) - fr + L) - cc_) * 2))
#define HY_CONV(Bsrc_) do { _Pragma("unroll") for (int i_ = 0; i_ < TPW; ++i_) acc[i_] = (f32x4){0.f, 0.f, 0.f, 0.f}; \
        const int bsel_ = fr & (NB - 1), cc_ = (16 - fr) & 7; \
        if constexpr (ROLL) { \
            bf16x8 W_[16]; \
            _Pragma("unroll") for (int j_ = 0; j_ < 16; ++j_) W_[j_] = HY_AFRAG(16 * wave + j_); \
            bf16x8 bfn_ = *(const LDSP bf16x8*)((Bsrc_) + bsel_ * VSROW + (8 * fq) * 2); \
            _Pragma("unroll 1") for (int mb_ = 0; mb_ < L / 32; mb_ += 8) { \
                _Pragma("unroll") for (int mm_ = 0; mm_ < 8; ++mm_) { const int m_ = mb_ + mm_; \
                    const bf16x8 bf_ = bfn_; bfn_ = *(const LDSP bf16x8*)((Bsrc_) + bsel_ * VSROW + (32 * (m_ + 1 < L / 32 ? m_ + 1 : m_) + 8 * fq) * 2); \
                    _Pragma("unroll") for (int jj_ = 2; jj_ < 18; ++jj_) { const int j_ = jj_ & 15; acc[j_] = __builtin_amdgcn_mfma_f32_16x16x32_bf16(W_[(j_ - 2 * mm_) & 15], bf_, acc[j_], 0, 0, 0); }   \
                    if (m_ + 1 < L / 32) { W_[(0 - 2 * (mm_ + 1)) & 15] = HY_AFRAG(16 * wave - 2 * (m_ + 1)); W_[(1 - 2 * (mm_ + 1)) & 15] = HY_AFRAG(16 * wave + 1 - 2 * (m_ + 1)); } } } \
        } else { \
            for (int s0_ = 0; s0_ < L; s0_ += 32) { const bf16x8 bf_ = *(const LDSP bf16x8*)((Bsrc_) + bsel_ * VSROW + (s0_ + 8 * fq) * 2); \
                _Pragma("unroll") for (int i_ = 0; i_ < TPW; ++i_) { const int t0_ = HY_T0(i_), idx_ = 8 * fq - (t0_ - s0_) - fr + L, x0_ = idx_ - cc_; \
                    const bf16x8 af_ = *(const LDSP bf16x8*)(FC + cc_ * FCROW + x0_ * 2); acc[i_] = __builtin_amdgcn_mfma_f32_16x16x32_bf16(af_, bf_, acc[i_], 0, 0, 0); } } } } while (0)
    f32x4 acc[TPW];
#define HY_TOUCH(dst_, ptr_, nlines_, off_) do { const int li_ = tid - (off_); if (li_ >= 0 && li_ < (nlines_)) dst_ = *(const unsigned*)((const char*)(ptr_) + (size_t)li_ * 128); } while (0)
    constexpr bool HY_USE_TOUCH = false;
    unsigned tc0 = 0u, tc1 = 0u, tc2 = 0u;
    { u32x4 za[NCH], zb[NCH], fm, f0, fp; bf16_t zal[NCH], zar[NCH], zbl[NCH], zbr[NCH]; float cwa[4], cwb[4];
      HY_LD(za, zal, zar, 4096 + d); HY_LD(zb, zbl, zbr, d); HY_FLD(fm, f0, fp, 0); HY_LDW(cwa, 4096 + d); HY_LDW(cwb, d); HY_PINW(cwa); HY_PINW(cwb); HY_PINF(fm, f0, fp); HY_FENCE();
      HY_ST(VS, za, zal, zar, cwa); HY_ST(XS, zb, zbl, zbr, cwb); HY_FST(fm, f0, fp); }
    __syncthreads();
    if constexpr (ROLL && HY_USE_TOUCH) { HY_TOUCH(tc0, ZT + (size_t)(2048 + d) * T + tokbase, NB * L * 2 / 128, 0); HY_TOUCH(tc0, Fg + ((size_t)2048 + d) * (size_t)(2 * L), 2 * L * 2 / 128, NB * L * 2 / 128); }
    HY_CONV(VS);
    sink ^= tc0;
    { const float bias0 = bias[d];
      if (fr < NB) {
#pragma unroll
        for (int i = 0; i < TPW; ++i) { const int t0 = HY_T0(i) + 4 * fq;
            const u32x2 vs = *(const LDSP u32x2*)(VS + fr * VSROW + t0 * 2), x1 = *(const LDSP u32x2*)(XS + fr * VSROW + t0 * 2);
            u32x2 w; w.x = pk_bf16(bf_lo(x1.x) * (acc[i][0] + bias0 * bf_lo(vs.x)), bf_hi(x1.x) * (acc[i][1] + bias0 * bf_hi(vs.x)));
            w.y = pk_bf16(bf_lo(x1.y) * (acc[i][2] + bias0 * bf_lo(vs.y)), bf_hi(x1.y) * (acc[i][3] + bias0 * bf_hi(vs.y)));
            *(LDSP u32x2*)(XS + fr * VSROW + t0 * 2) = w; } } }
    __syncthreads();
    { u32x4 za[NCH], fm, f0, fp; bf16_t zal[NCH], zar[NCH]; float cwa[4];
      HY_LD(za, zal, zar, 2048 + d); HY_FLD(fm, f0, fp, 1); HY_LDW(cwa, 2048 + d); HY_PINW(cwa); HY_PINF(fm, f0, fp); HY_FENCE();
      HY_ST(VS, za, zal, zar, cwa); HY_FST(fm, f0, fp); }
    __syncthreads();
    if constexpr (ROLL && HY_USE_TOUCH) { if (dnext >= 0) { HY_TOUCH(tc1, ZT + (size_t)(4096 + dnext) * T + tokbase, NB * L * 2 / 128, 0); HY_TOUCH(tc1, ZT + (size_t)dnext * T + tokbase, NB * L * 2 / 128, NB * L * 2 / 128);
        HY_TOUCH(tc2, Fg + (size_t)dnext * (size_t)(2 * L), 2 * L * 2 / 128, 0); } }
    HY_CONV(XS);
    sink ^= tc1 ^ tc2;
    { const float bias1 = bias[2048 + d];
      if (fr < NB) {
#pragma unroll
        for (int i = 0; i < TPW; ++i) { const int t0 = HY_T0(i) + 4 * fq;
            const u32x2 x2 = *(const LDSP u32x2*)(VS + fr * VSROW + t0 * 2), v1 = *(const LDSP u32x2*)(XS + fr * VSROW + t0 * 2);
            u32x2 w; w.x = pk_bf16(bf_lo(x2.x) * (acc[i][0] + bias1 * bf_lo(v1.x)), bf_hi(x2.x) * (acc[i][1] + bias1 * bf_hi(v1.x)));
            w.y = pk_bf16(bf_lo(x2.y) * (acc[i][2] + bias1 * bf_lo(v1.y)), bf_hi(x2.y) * (acc[i][3] + bias1 * bf_hi(v1.y)));
            *(u32x2*)(VOT + (size_t)d * T + tokbase + fr * L + t0) = w; } } }
    __syncthreads();
#undef HY_TOUCH
#undef HY_LD
#undef HY_LDW
#undef HY_ST
#undef HY_FLD
#undef HY_FST
#undef HY_FENCE
#undef HY_PINW
#undef HY_PINF
#undef HY_CONV
#undef HY_AFRAG
#undef HY_T0
}
__device__ __forceinline__ void hy_conv_phase(LDSP unsigned char* lds, const bf16_t* ZT, const bf16_t* F, const float* short_w, const float* short_b, const float* bias, bf16_t* VOT, unsigned* sinkp) {
    unsigned sink = 0u;
    for (int u = blockIdx.x; u < 2048 + 512; u += gridDim.x) {
        if (u < 2048) hy_conv_unit<8, 2048, true, 8>(lds, u, TC, ZT, F + (size_t)2 * 2048 * 512, short_w, short_b, bias, VOT, u + (int)gridDim.x < 2048 ? u + (int)gridDim.x : -1, sink);
        else hy_conv_unit<16, 256, false, 2>(lds, 4 * (u - 2048), 0, ZT, F, short_w, short_b, bias, VOT, -1, sink);
    }
    if (sink == 0x9e3779b9u) *sinkp = sink;
}
__device__ __forceinline__ void transpose_phase(LDSP unsigned char* lds, const bf16_t* __restrict__ VOT, bf16_t* __restrict__ VO) {
    constexpr int NTB = 8, TSZ = 64 * 66;
    LDSP bf16_t* tiles = (LDSP bf16_t*)lds;
    const int tid = threadIdx.x;
    for (int t0 = blockIdx.x * NTB; t0 < 32 * 320; t0 += gridDim.x * NTB) {
        u32x4 v[NTB];
        { const int r = tid >> 3, part = tid & 7;
#pragma unroll
          for (int i = 0; i < NTB; ++i) { const int t = t0 + i, d0 = (t & 31) * 64, k0 = (t >> 5) * 64; v[i] = *(const u32x4*)(VOT + (size_t)(d0 + r) * T + k0 + part * 8); }
#pragma unroll
          for (int i = 0; i < NTB; ++i) { LDSP bf16_t* dst = tiles + i * TSZ + r * 66 + part * 8;
            dst[0] = (bf16_t)(v[i].x & 0xffff); dst[1] = (bf16_t)(v[i].x >> 16); dst[2] = (bf16_t)(v[i].y & 0xffff); dst[3] = (bf16_t)(v[i].y >> 16);
            dst[4] = (bf16_t)(v[i].z & 0xffff); dst[5] = (bf16_t)(v[i].z >> 16); dst[6] = (bf16_t)(v[i].w & 0xffff); dst[7] = (bf16_t)(v[i].w >> 16); } }
        __syncthreads();
        { const int tok = tid >> 3, part = tid & 7;
#pragma unroll
          for (int i = 0; i < NTB; ++i) { const int t = t0 + i, d0 = (t & 31) * 64, k0 = (t >> 5) * 64; unsigned e[8];
#pragma unroll
            for (int j = 0; j < 8; ++j) e[j] = tiles[i * TSZ + (part * 8 + j) * 66 + tok];
            u32x4 w; w.x = e[0] | (e[1] << 16); w.y = e[2] | (e[3] << 16); w.z = e[4] | (e[5] << 16); w.w = e[6] | (e[7] << 16);
            *(u32x4*)(VO + (size_t)(k0 + tok) * D + d0 + part * 8) = w; } }
        __syncthreads();
    }
}

__device__ __forceinline__ unsigned f2sort(float f) { const unsigned u = __float_as_uint(f); return u ^ ((u >> 31) ? 0xffffffffu : 0x80000000u); }
__device__ __forceinline__ float sort2f(unsigned s) { return __uint_as_float((s & 0x80000000u) ? (s ^ 0x80000000u) : ~s); }
__device__ __forceinline__ unsigned umax4(unsigned v) { const unsigned a = __shfl_xor(v, 16); v = v > a ? v : a; const unsigned b = __shfl_xor(v, 32); return v > b ? v : b; }

template <int N> __device__ __forceinline__ void bitonic_sort_desc(unsigned (&v)[N]) {
#pragma unroll
    for (int k = 2; k <= N; k <<= 1)
#pragma unroll
        for (int j = k >> 1; j > 0; j >>= 1)
#pragma unroll
            for (int i = 0; i < N; ++i) { const int l = i ^ j;
                if (l > i) { const unsigned x = v[i], y = v[l], mx = x > y ? x : y, mn = x > y ? y : x; if ((i & k) == 0) { v[i] = mx; v[l] = mn; } else { v[i] = mn; v[l] = mx; } } }
}
__device__ __forceinline__ void merge_top16(unsigned (&v)[16], int xr) {
    unsigned c[16];
#pragma unroll
    for (int i = 0; i < 16; ++i) { const unsigned p = (unsigned)__shfl_xor((int)v[15 - i], xr); c[i] = v[i] > p ? v[i] : p; }
#pragma unroll
    for (int j = 8; j > 0; j >>= 1)
#pragma unroll
        for (int i = 0; i < 16; ++i) { const int l = i ^ j; if (l > i) { const unsigned x = c[i], y = c[l]; c[i] = x > y ? x : y; c[l] = x > y ? y : x; } }
#pragma unroll
    for (int i = 0; i < 16; ++i) v[i] = c[i];
}
__device__ __forceinline__ void cvt_table_i4(const float* __restrict__ src, unsigned char* __restrict__ dst, float* __restrict__ scale_inv, int row_lo, int nrows);
__device__ __forceinline__ void cvt_table_fp4(const float* __restrict__ src, unsigned char* __restrict__ dst, float* __restrict__ scale_inv, int row_lo, int nrows);
__device__ __forceinline__ void peer_select_phase(LDSP unsigned char* lds, const bf16_t* __restrict__ PQ, const bf16_t* __restrict__ KEYS  , int* __restrict__ EID, float* __restrict__ GATE,
        int next_layer = -1, const float* __restrict__ cu = nullptr, const float* __restrict__ cv = nullptr, unsigned char* __restrict__ tu = nullptr, unsigned char* __restrict__ tv = nullptr, float* __restrict__ tsc = nullptr) {
    constexpr int KR = 272;
    const int tid = threadIdx.x, lane = tid & 63, wave = tid >> 6, fr = lane & 15, fq = lane >> 4;
    const int h = blockIdx.x & 7, rk = blockIdx.x >> 3, nblk = ((int)gridDim.x - h + 7) >> 3, tstride = nblk * 8;
    for (int c = tid; c < 256 * 16; c += NTH) { const int row = c >> 4, part = c & 15; *(LDSP u32x4*)(lds + row * KR + part * 16) = *(const u32x4*)(KEYS + ((size_t)(h * 2) * 128 + row) * 128 + part * 8); }
    __syncthreads();
#define PS_CONVERT() do { if (next_layer >= 0) { cvt_table_i4(cu, tu, tsc, next_layer * 16384, (next_layer + 1) * 16384); cvt_table_fp4(cv, tv, tsc + 4 * 16384, next_layer * 16384, (next_layer + 1) * 16384); } } while (0)
    LDSP int* wsc = (LDSP int*)(lds + 69632 + wave * 2048) + fr * 32;
    int tg = rk * 8 + wave;
    bf16x8 qf[2][4];
    if (tg < T / 16) {
#pragma unroll
        for (int pp = 0; pp < 2; ++pp)
#pragma unroll
            for (int ks = 0; ks < 4; ++ks) qf[pp][ks] = *(const bf16x8*)(PQ + (size_t)(tg * 16 + fr) * D + h * 256 + pp * 128 + 32 * ks + 8 * fq);
    }
    for (; tg < T / 16; tg += tstride) {
        const int tok = tg * 16 + fr;
        f32x4 acc[2][8];
#pragma unroll
        for (int pp = 0; pp < 2; ++pp) {
#pragma unroll
            for (int nt = 0; nt < 8; ++nt) acc[pp][nt] = (f32x4){0.f, 0.f, 0.f, 0.f};
#pragma unroll
            for (int ks = 0; ks < 4; ++ks)
#pragma unroll
                for (int nt = 0; nt < 8; ++nt) { const bf16x8 kf = *(const LDSP bf16x8*)(lds + (pp * 128 + 16 * nt + fr) * KR + (32 * ks + 8 * fq) * 2);
                    acc[pp][nt] = __builtin_amdgcn_mfma_f32_16x16x32_bf16(kf, qf[pp][ks], acc[pp][nt], 0, 0, 0); }
        }
        { const int tgn = tg + tstride < T / 16 ? tg + tstride : tg;
#pragma unroll
          for (int pp = 0; pp < 2; ++pp)
#pragma unroll
              for (int ks = 0; ks < 4; ++ks) qf[pp][ks] = *(const bf16x8*)(PQ + (size_t)(tgn * 16 + fr) * D + h * 256 + pp * 128 + 32 * ks + 8 * fq); }
        unsigned top[2][16];
#pragma unroll
        for (int pp = 0; pp < 2; ++pp) {
            unsigned key[32];
#pragma unroll
            for (int nt = 0; nt < 8; ++nt)
#pragma unroll
                for (int j = 0; j < 4; ++j) key[nt * 4 + j] = (f2sort(acc[pp][nt][j]) & ~127u) | (unsigned)(16 * nt + 4 * fq + j);
            bitonic_sort_desc<32>(key);
#pragma unroll
            for (int i = 0; i < 16; ++i) top[pp][i] = key[i];
            merge_top16(top[pp], 16); merge_top16(top[pp], 32);
        }
        if (fq == 0) {
#pragma unroll
            for (int i = 0; i < 16; ++i) { wsc[i] = (int)(top[0][i] & 127u); wsc[16 + i] = (int)(top[1][i] & 127u); }
        }
        float sA[4];
#pragma unroll
        for (int i = 0; i < 4; ++i) { const unsigned t0 = top[0][4 * i], t1 = top[0][4 * i + 1], t2 = top[0][4 * i + 2], t3 = top[0][4 * i + 3];
            sA[i] = sort2f((fq == 0 ? t0 : fq == 1 ? t1 : fq == 2 ? t2 : t3) & ~127u); }
        unsigned cand[16];
#pragma unroll
        for (int bb = 0; bb < 16; ++bb) cand[bb] = (f2sort(sA[0] + sort2f(top[1][bb] & ~127u)) & ~255u) | (unsigned)(fq << 4) | (unsigned)(15 - bb);
#pragma unroll
        for (int k = 0; k < 5; ++k) {
            const int i = k < 3 ? 1 : k == 3 ? 2 : 3, bb = k < 3 ? k : 0;
            unsigned x = (f2sort(sA[i] + sort2f(top[1][bb] & ~127u)) & ~255u) | (unsigned)((fq + 4 * i) << 4) | (unsigned)(15 - bb);
#pragma unroll
            for (int j = 0; j < 16; ++j) { const unsigned c0 = cand[j], mx = c0 > x ? c0 : x, mn = c0 > x ? x : c0; cand[j] = mx; x = mn; }
        }
        merge_top16(cand, 16); merge_top16(cand, 32);
        WAVE_SYNC();
        float es[16], sum = 0.f; int ids[16];
        const float v0 = sort2f(cand[0] & ~255u);
#pragma unroll
        for (int r = 0; r < 16; ++r) { const unsigned w = cand[r]; es[r] = __expf(sort2f(w & ~255u) - v0); sum += es[r];
            ids[r] = wsc[(w >> 4) & 15u] * 128 + wsc[16 + 15 - (int)(w & 15u)]; }
        const float inv = 1.f / sum;
        if (fq == 0) {
            int* ep = EID + (size_t)tok * 128 + 2 * h; float* gp = GATE + (size_t)tok * 128 + 2 * h;
#pragma unroll
            for (int r = 0; r < 16; ++r) { ep[(r & 7) * 16 + (r >> 3)] = ids[r]; gp[(r & 7) * 16 + (r >> 3)] = es[r] * inv; }
        }
        WAVE_SYNC();
    }
    PS_CONVERT();
#undef PS_CONVERT
}

#define PG_FENCE() do { asm volatile("" ::: "memory"); __builtin_amdgcn_sched_barrier(0); } while (0)
#define PE_ISSUE(buf_, tab_, ev_) do { _Pragma("unroll") for (int li_ = 0; li_ < 16; ++li_) { \
        const unsigned e_ = (unsigned)ev_[li_ >> 2][li_ & 3]; buf_[li_] = *(const u32x4*)((tab_) + (size_t)(e_ * 128u + sub16)); } } while (0)
#define PE_LOADE(ev_, n_) do { const int t_ = PE_TOK(n_); const u32x4* ep_ = (const u32x4*)(EID + (size_t)t_ * 128 + grp * 16); ev_[0] = ep_[0]; ev_[1] = ep_[1]; ev_[2] = ep_[2]; ev_[3] = ep_[3]; } while (0)
#define PE_TOK(n_) (((n_) < ntok ? t0 + (n_) * tstride : t0))

__device__ __forceinline__ void peer_u_phase(const unsigned* __restrict__ X8, const float* __restrict__ SX, const unsigned char* __restrict__ TU, const int* __restrict__ EID, bf16_t* __restrict__ PA) {
    const int lane = threadIdx.x & 63, wave = threadIdx.x >> 6, grp = lane >> 3, sub = lane & 7;
    const int vx = blockIdx.x & 7, rk = blockIdx.x >> 3, nblk = ((int)gridDim.x - vx + 7) >> 3, tstride = nblk * 8, t0 = rk * 8 + wave;
    const int ntok = t0 < T ? (T - t0 + tstride - 1) / tstride : 0, npair = (ntok + 1) >> 1;
    {
        const int s = vx;
        const unsigned char* tab = TU + (size_t)s * 16384 * 128 + 16 * sub;
        const unsigned* xb8 = X8 + 64 * s + 8 * sub;
        bf16_t* pab = PA + (size_t)s * T * 128 + grp * 16;
        u32x4 b0[16], b1[16], xa0, xb0, xa1, xb1, ev[4], evn[4];
        float sx0, sx1;
        int p_[16], xs_;
#define PU_ISSUE_Q(buf_, ev_, q_) do { _Pragma("unroll") for (int li_ = 4 * (q_); li_ < 4 * (q_) + 4; ++li_) { \
        const unsigned e_ = (unsigned)ev_[li_ >> 2][li_ & 3]; buf_[li_] = *(const u32x4*)(tab + (size_t)(e_ * 128u)); } } while (0)
#define PU_ISSUE(buf_, ev_) do { PU_ISSUE_Q(buf_, ev_, 0); PU_ISSUE_Q(buf_, ev_, 1); PU_ISSUE_Q(buf_, ev_, 2); PU_ISSUE_Q(buf_, ev_, 3); } while (0)
#define PU_LOADX(xa_, xb_, sx_, n_) do { const int t_ = PE_TOK(n_); xa_ = *(const u32x4*)(xb8 + (size_t)t_ * 512); xb_ = *(const u32x4*)(xb8 + (size_t)t_ * 512 + 4); sx_ = SX[t_]; } while (0)
#define PU_D4(w_, xlo_, xhi_, a_) do { a_ = __builtin_amdgcn_sdot4((int)((w_) & 0x0f0f0f0fu), (int)(xlo_), a_, false); a_ = __builtin_amdgcn_sdot4((int)(((w_) >> 4) & 0x0f0f0f0fu), (int)(xhi_), a_, false); } while (0)
#define PU_BEGIN(xa_, xb_) do { \
            xs_ = __builtin_amdgcn_sdot4(0x01010101, (int)xa_.x, 0, false); xs_ = __builtin_amdgcn_sdot4(0x01010101, (int)xa_.y, xs_, false); \
            xs_ = __builtin_amdgcn_sdot4(0x01010101, (int)xa_.z, xs_, false); xs_ = __builtin_amdgcn_sdot4(0x01010101, (int)xa_.w, xs_, false); \
            xs_ = __builtin_amdgcn_sdot4(0x01010101, (int)xb_.x, xs_, false); xs_ = __builtin_amdgcn_sdot4(0x01010101, (int)xb_.y, xs_, false); \
            xs_ = __builtin_amdgcn_sdot4(0x01010101, (int)xb_.z, xs_, false); xs_ = __builtin_amdgcn_sdot4(0x01010101, (int)xb_.w, xs_, false); xs_ *= -8; } while (0)
#define PU_ROWS(buf_, xa_, xb_, q_) do { _Pragma("unroll") for (int li_ = 4 * (q_); li_ < 4 * (q_) + 4; ++li_) { const u32x4 q4_ = buf_[li_]; int a_ = xs_; \
                PU_D4(q4_.x, xa_.x, xa_.y, a_); PU_D4(q4_.y, xa_.z, xa_.w, a_); PU_D4(q4_.z, xb_.x, xb_.y, a_); PU_D4(q4_.w, xb_.z, xb_.w, a_); p_[li_] = a_; } } while (0)
#define PU_END(sx_, n_) do { \
            int v8_[8], v4_[4], v2_[2]; \
            _Pragma("unroll") for (int i_ = 0; i_ < 8; ++i_) { const bool up_ = sub & 4; const int keep_ = up_ ? p_[i_ + 8] : p_[i_], send_ = up_ ? p_[i_] : p_[i_ + 8]; v8_[i_] = keep_ + dpp_i<0x141>(send_); } \
            _Pragma("unroll") for (int i_ = 0; i_ < 4; ++i_) { const bool up_ = sub & 2; const int keep_ = up_ ? v8_[i_ + 4] : v8_[i_], send_ = up_ ? v8_[i_] : v8_[i_ + 4]; v4_[i_] = keep_ + dpp_i<0x4E>(send_); } \
            _Pragma("unroll") for (int i_ = 0; i_ < 2; ++i_) { const bool up_ = sub & 1; const int keep_ = up_ ? v4_[i_ + 2] : v4_[i_], send_ = up_ ? v4_[i_] : v4_[i_ + 2]; v2_[i_] = keep_ + dpp_i<0xB1>(send_); } \
            f32x2 r_ = {(float)v2_[0] * sx_, (float)v2_[1] * sx_}; \
            if ((n_) < ntok) { const int lb_ = 2 * (sub & 1) + 4 * ((sub >> 1) & 1) + 8 * ((sub >> 2) & 1); *(unsigned*)(pab + (size_t)(t0 + (n_) * tstride) * 128 + lb_) = pk_bf16(r_.x, r_.y); } \
            asm volatile("" : "+v"(r_) :: "memory"); } while (0)
#define PU_KEEP(dst_, src_) do { dst_[0] = src_[0]; dst_[1] = src_[1]; dst_[2] = src_[2]; dst_[3] = src_[3]; } while (0)
#define PU_STEP(bc_, xac_, xbc_, sxc_, bn_, xan_, xbn_, sxn_, n_) do { \
            PU_BEGIN(xac_, xbc_); \
            PE_LOADE(evn, (n_) + 2); PU_ISSUE_Q(bn_, ev, 0); PG_FENCE(); PU_ROWS(bc_, xac_, xbc_, 0); PG_FENCE(); \
            PU_ISSUE_Q(bn_, ev, 1); PG_FENCE(); PU_ROWS(bc_, xac_, xbc_, 1); PG_FENCE(); \
            PU_ISSUE_Q(bn_, ev, 2); PG_FENCE(); PU_ROWS(bc_, xac_, xbc_, 2); PG_FENCE(); \
            PU_ISSUE_Q(bn_, ev, 3); PU_LOADX(xan_, xbn_, sxn_, (n_) + 1); PG_FENCE(); PU_ROWS(bc_, xac_, xbc_, 3); PU_END(sxc_, n_); PU_KEEP(ev, evn); PG_FENCE(); } while (0)
        if (ntok > 0) {
            PE_LOADE(ev, 0); PU_ISSUE(b0, ev); PU_LOADX(xa0, xb0, sx0, 0); PE_LOADE(ev, 1);
#pragma unroll 1
            for (int pr = 0; pr < npair; ++pr) {
                const int n = 2 * pr;
                PU_STEP(b0, xa0, xb0, sx0, b1, xa1, xb1, sx1, n);
                PU_STEP(b1, xa1, xb1, sx1, b0, xa0, xb0, sx0, n + 1);
            }
        }
#undef PU_STEP
#undef PU_KEEP
#undef PU_END
#undef PU_ROWS
#undef PU_BEGIN
#undef PU_ISSUE_Q
#undef PU_D4
#undef PU_LOADX
#undef PU_ISSUE
    }
}

__device__ __forceinline__ void peer_act_phase(const bf16_t* __restrict__ PA, const int* __restrict__ EID, const float* __restrict__ USC, const float* __restrict__ VSC, float* GATE, float* __restrict__ ISC) {
    const int n4 = T * 128 / 4, stride = gridDim.x * NTH;
    for (int i = blockIdx.x * NTH + threadIdx.x; i < n4; i += stride) {
        f32x4 acc = (f32x4){0.f, 0.f, 0.f, 0.f};
#pragma unroll
        for (int s = 0; s < 8; ++s) { const u32x2 p = *(const u32x2*)(PA + (size_t)s * T * 128 + (size_t)i * 4); acc += (f32x4){bf_lo(p.x), bf_hi(p.x), bf_lo(p.y), bf_hi(p.y)}; }
        const u32x4 e = *(const u32x4*)(EID + (size_t)i * 4); const f32x4 g = *(const f32x4*)(GATE + (size_t)i * 4);
        f32x4 w;
        w[0] = gelu_tanh(acc[0] * USC[e.x]) * g[0] * VSC[e.x]; w[1] = gelu_tanh(acc[1] * USC[e.y]) * g[1] * VSC[e.y];
        w[2] = gelu_tanh(acc[2] * USC[e.z]) * g[2] * VSC[e.z]; w[3] = gelu_tanh(acc[3] * USC[e.w]) * g[3] * VSC[e.w];
        float mx = fmaxf(fmaxf(fabsf(w[0]), fabsf(w[1])), fmaxf(fabsf(w[2]), fabsf(w[3])));
        mx = fmaxf(mx, __shfl_xor(mx, 1)); mx = fmaxf(mx, __shfl_xor(mx, 2)); mx = fmaxf(mx, __shfl_xor(mx, 4)); mx = fmaxf(mx, __shfl_xor(mx, 8)); mx = fmaxf(mx, __shfl_xor(mx, 16));
        const unsigned ex = __float_as_uint(mx) >> 23; const float sc = __uint_as_float((254u - ex) << 23);
        u32x4 o;
#pragma unroll
        for (int j = 0; j < 4; ++j) o[j] = (e[j] & 0xffffu) | ((unsigned)__builtin_bit_cast(unsigned short, (_Float16)(w[j] * sc)) << 16);
        *(u32x4*)(GATE + (size_t)i * 4) = o;
        if ((threadIdx.x & 31) == 0) ISC[i >> 5] = __uint_as_float(ex << 23);
    }
}

__device__ __forceinline__ void peer_v_phase(const unsigned char* __restrict__ TV, const int* __restrict__ EID  , const float* __restrict__ ISC, const float* __restrict__ g2  , const bf16_t* X, bf16_t* Xw) {
    const int lane = threadIdx.x & 63, wave = threadIdx.x >> 6, grp = lane >> 3, sub = lane & 7; const unsigned sub16 = 16u * sub;
    const int vx = blockIdx.x & 7, rk = blockIdx.x >> 3, nblk = ((int)gridDim.x - vx + 7) >> 3, tstride = nblk * 8, t0 = rk * 8 + wave;
    const int ntok = t0 < T ? (T - t0 + tstride - 1) / tstride : 0, npair = (ntok + 1) >> 1;
    {
        const int s = vx;
        const unsigned char* tab = TV + (size_t)s * 16384 * 128;
        const int colb = 256 * s + 32 * sub + 4 * grp;
        u32x4 b0[16], b1[16], ev[4], evn[4];
        u32x4 e0[4], e1[4]; u32x2 xo0, xo1; float is0, is1; f32x4 gg0, gg1;
#define PV_ISSUE_Q(buf_, ev_, q_) do { _Pragma("unroll") for (int li_ = 4 * (q_); li_ < 4 * (q_) + 4; ++li_) { \
            const unsigned e_ = (unsigned)ev_[li_ >> 2][li_ & 3] & 0xffffu; buf_[li_] = *(const u32x4*)(tab + (size_t)(e_ * 128u + sub16)); } } while (0)
#define PV_KEEP(keep_, ev_) do { keep_[0] = ev_[0]; keep_[1] = ev_[1]; keep_[2] = ev_[2]; keep_[3] = ev_[3]; } while (0)
#define PV_ISSUE(buf_, keep_, ev_) do { PV_ISSUE_Q(buf_, ev_, 0); PV_ISSUE_Q(buf_, ev_, 1); PV_ISSUE_Q(buf_, ev_, 2); PV_ISSUE_Q(buf_, ev_, 3); PV_KEEP(keep_, ev_); } while (0)
#define PV_LOADX(xo_, is_, gg_, n_) do { const int t_ = PE_TOK(n_); xo_ = *(const u32x2*)(X + (size_t)t_ * D + colb); is_ = ISC[t_]; gg_ = *(const f32x4*)(g2 + (size_t)cond_of(t_) * 4 * 12288 + colb); } while (0)
#define PV_CVT(w_, s_) __builtin_bit_cast(h2_t, __builtin_amdgcn_cvt_scalef32_pk_f16_fp4((w_), 1.0f, s_))
#define PV_DW(w_, o0_, o1_, o2_, o3_) do { o0_ = __builtin_elementwise_fma(PV_CVT(w_, 0), w2_, o0_); o1_ = __builtin_elementwise_fma(PV_CVT(w_, 1), w2_, o1_); \
            o2_ = __builtin_elementwise_fma(PV_CVT(w_, 2), w2_, o2_); o3_ = __builtin_elementwise_fma(PV_CVT(w_, 3), w2_, o3_); } while (0)
        h2_t o_[16];
#define PV_BEGIN() do { _Pragma("unroll") for (int j_ = 0; j_ < 16; ++j_) o_[j_] = (h2_t){(_Float16)0.f, (_Float16)0.f}; } while (0)
#define PV_ROWS(buf_, wv_, q_) do { _Pragma("unroll") for (int li_ = 4 * (q_); li_ < 4 * (q_) + 4; ++li_) { const u32x4 q4_ = buf_[li_]; unsigned ww_ = wv_[li_ >> 2][li_ & 3]; asm volatile("" : "+v"(ww_));   \
                const _Float16 wk_ = __builtin_bit_cast(h2_t, ww_).y; const h2_t w2_ = {wk_, wk_}; \
                PV_DW(q4_.x, o_[0], o_[1], o_[2], o_[3]); PV_DW(q4_.y, o_[4], o_[5], o_[6], o_[7]); PV_DW(q4_.z, o_[8], o_[9], o_[10], o_[11]); PV_DW(q4_.w, o_[12], o_[13], o_[14], o_[15]); } } while (0)
#define PV_END(xo_, isc_, gg_, n_) do { \
            h2_t v8_[8], v4_[4], v2_[2]; \
            _Pragma("unroll") for (int i_ = 0; i_ < 8; ++i_) v8_[i_] = xsum32h(o_[i_], o_[i_ + 8]); \
            _Pragma("unroll") for (int i_ = 0; i_ < 4; ++i_) v4_[i_] = xsum16h(v8_[i_], v8_[i_ + 4]); \
            _Pragma("unroll") for (int i_ = 0; i_ < 2; ++i_) { const bool up_ = grp & 1; const h2_t keep_ = up_ ? v4_[i_ + 2] : v4_[i_], send_ = up_ ? v4_[i_] : v4_[i_ + 2]; \
                v2_[i_] = keep_ + __builtin_bit_cast(h2_t, dpp_i<0x128>(__builtin_bit_cast(int, send_))); } \
            f32x4 r_ = {(float)v2_[0].x, (float)v2_[0].y, (float)v2_[1].x, (float)v2_[1].y}; r_ = r_ * isc_; \
            if ((n_) < ntok) { const int t_ = t0 + (n_) * tstride; const f32x4 g_ = gg_; \
                const f32x4 xf_ = {bf_lo(xo_.x), bf_hi(xo_.x), bf_lo(xo_.y), bf_hi(xo_.y)}; const f32x4 y_ = xf_ + g_ * r_; u32x2 yo_; yo_.x = pk_bf16(y_[0], y_[1]); yo_.y = pk_bf16(y_[2], y_[3]); *(u32x2*)(Xw + (size_t)t_ * D + colb) = yo_; } \
            asm volatile("" : "+v"(r_) :: "memory"); } while (0)
#define PV_STEP(bc_, ec_, xoc_, isc_, ggc_, bn_, en_, xon_, isn_, ggn_, n_) do { \
            PV_BEGIN(); \
            PE_LOADE(evn, (n_) + 2); PV_ISSUE_Q(bn_, ev, 0); PG_FENCE(); PV_ROWS(bc_, ec_, 0); PG_FENCE(); \
            PV_ISSUE_Q(bn_, ev, 1); PG_FENCE(); PV_ROWS(bc_, ec_, 1); PG_FENCE(); \
            PV_ISSUE_Q(bn_, ev, 2); PG_FENCE(); PV_ROWS(bc_, ec_, 2); PG_FENCE(); \
            PV_ISSUE_Q(bn_, ev, 3); PV_KEEP(en_, ev); PV_LOADX(xon_, isn_, ggn_, (n_) + 1); PG_FENCE(); PV_ROWS(bc_, ec_, 3); PV_END(xoc_, isc_, ggc_, n_); PV_KEEP(ev, evn); PG_FENCE(); } while (0)
        if (ntok > 0) {
            PE_LOADE(ev, 0); PV_ISSUE(b0, e0, ev); PV_LOADX(xo0, is0, gg0, 0); PE_LOADE(ev, 1);
#pragma unroll 1
            for (int pr = 0; pr < npair; ++pr) {
                const int n = 2 * pr;
                PV_STEP(b0, e0, xo0, is0, gg0, b1, e1, xo1, is1, gg1, n);
                PV_STEP(b1, e1, xo1, is1, gg1, b0, e0, xo0, is0, gg0, n + 1);
            }
        }
#undef PV_STEP
#undef PV_END
#undef PV_ROWS
#undef PV_BEGIN
#undef PV_KEEP
#undef PV_ISSUE_Q
#undef PV_DW
#undef PV_CVT
#undef PV_LOADX
#undef PV_ISSUE
    }
}
#undef PE_TOK
#undef PE_LOADE
#undef PE_ISSUE


__device__ __forceinline__ void cvt_table_i4(const float* __restrict__ src, unsigned char* __restrict__ dst, float* __restrict__ scale_inv, int row_lo, int nrows  ) {
    const int lane = threadIdx.x & 63, gw = row_lo + blockIdx.x * 8 + (threadIdx.x >> 6), nw = gridDim.x * 8;
    f32x4 vn[8];
    if (gw < nrows) {
#pragma unroll
        for (int q = 0; q < 8; ++q) vn[q] = __builtin_nontemporal_load((const f32x4*)(src + (size_t)gw * 2048 + 256 * q + 4 * lane)); }
    for (int row = gw; row < nrows; row += nw) {
        f32x4 v[8]; float mx = 0.f, ss = 0.f;
#pragma unroll
        for (int q = 0; q < 8; ++q) v[q] = vn[q];
        { const int rn = row + nw < nrows ? row + nw : row;
#pragma unroll
          for (int q = 0; q < 8; ++q) vn[q] = __builtin_nontemporal_load((const f32x4*)(src + (size_t)rn * 2048 + 256 * q + 4 * lane)); }
        asm volatile("" ::: "memory"); __builtin_amdgcn_sched_barrier(0);
#pragma unroll
        for (int q = 0; q < 8; ++q) { mx = fmaxf(mx, fmaxf(fmaxf(fabsf(v[q][0]), fabsf(v[q][1])), fmaxf(fabsf(v[q][2]), fabsf(v[q][3])))); ss += v[q][0] * v[q][0] + v[q][1] * v[q][1] + v[q][2] * v[q][2] + v[q][3] * v[q][3]; }
        mx = fmaxf(mx, __shfl_xor(mx, 32)); mx = fmaxf(mx, __shfl_xor(mx, 16)); mx = fmaxf(mx, __shfl_xor(mx, 8)); mx = fmaxf(mx, __shfl_xor(mx, 4)); mx = fmaxf(mx, __shfl_xor(mx, 2)); mx = fmaxf(mx, __shfl_xor(mx, 1));
        ss = wave_sum(ss);
        float step = fminf(0.36f * sqrtf(ss * (1.f / 2048.f)), mx * (1.f / 7.f)); if (!(step > 0.f)) step = 1.f;
        const float sc = 1.f / step;
        const int layer = row >> 14, e = row & 16383;
#pragma unroll
        for (int q = 0; q < 8; ++q) {
            unsigned nib = 0u;
#pragma unroll
            for (int j = 0; j < 4; ++j) { int qi = (int)rintf(v[q][j] * sc); qi = qi < -7 ? -7 : qi > 7 ? 7 : qi; nib |= (unsigned)(qi + 8) << (8 * j); }
            const unsigned other = (unsigned)__shfl_xor((int)nib, 1);
            if ((lane & 1) == 0) *(unsigned*)(dst + (((size_t)layer * 8 + q) * 16384 + e) * 128 + 4 * (lane >> 1)) = nib | (other << 4); }
        if (lane == 0) scale_inv[row] = step;
    }
}

__device__ __forceinline__ void cvt_table_fp4(const float* __restrict__ src, unsigned char* __restrict__ dst, float* __restrict__ scale_inv, int row_lo, int nrows  ) {
    const int lane = threadIdx.x & 63, gw = row_lo + blockIdx.x * 8 + (threadIdx.x >> 6), nw = gridDim.x * 8;
    f32x4 vn[8];
    if (gw < nrows) {
#pragma unroll
        for (int q = 0; q < 8; ++q) vn[q] = __builtin_nontemporal_load((const f32x4*)(src + (size_t)gw * 2048 + 256 * q + 4 * lane)); }
    for (int row = gw; row < nrows; row += nw) {
        f32x4 v[8]; float mx = 0.f, ss = 0.f;
#pragma unroll
        for (int q = 0; q < 8; ++q) v[q] = vn[q];
        { const int rn = row + nw < nrows ? row + nw : row;
#pragma unroll
          for (int q = 0; q < 8; ++q) vn[q] = __builtin_nontemporal_load((const f32x4*)(src + (size_t)rn * 2048 + 256 * q + 4 * lane)); }
        asm volatile("" ::: "memory"); __builtin_amdgcn_sched_barrier(0);
#pragma unroll
        for (int q = 0; q < 8; ++q) { mx = fmaxf(mx, fmaxf(fmaxf(fabsf(v[q][0]), fabsf(v[q][1])), fmaxf(fabsf(v[q][2]), fabsf(v[q][3])))); ss += v[q][0] * v[q][0] + v[q][1] * v[q][1] + v[q][2] * v[q][2] + v[q][3] * v[q][3]; }
        mx = fmaxf(mx, __shfl_xor(mx, 32)); mx = fmaxf(mx, __shfl_xor(mx, 16)); mx = fmaxf(mx, __shfl_xor(mx, 8)); mx = fmaxf(mx, __shfl_xor(mx, 4)); mx = fmaxf(mx, __shfl_xor(mx, 2)); mx = fmaxf(mx, __shfl_xor(mx, 1));
        ss = wave_sum(ss);
        float unit = fminf(0.48f * sqrtf(ss * (1.f / 2048.f)), mx * (1.f / 6.f)); if (!(unit > 0.f)) unit = 1.f;
        const float sc = 1.f / unit;
        const int layer = row >> 14, e = row & 16383;
#pragma unroll
        for (int q = 0; q < 8; ++q) {
            const float c0 = fminf(fmaxf(v[q][0] * sc, -6.f), 6.f), c1 = fminf(fmaxf(v[q][1] * sc, -6.f), 6.f), c2 = fminf(fmaxf(v[q][2] * sc, -6.f), 6.f), c3 = fminf(fmaxf(v[q][3] * sc, -6.f), 6.f);
            unsigned p = 0u;
            p = __builtin_amdgcn_cvt_scalef32_pk_fp4_f32(p, c0, c1, 1.0f, 0); p = __builtin_amdgcn_cvt_scalef32_pk_fp4_f32(p, c2, c3, 1.0f, 1);
            const unsigned other = (unsigned)__shfl_xor((int)p, 1);
            if ((lane & 1) == 0) *(unsigned*)(dst + (((size_t)layer * 8 + q) * 16384 + e) * 128 + 4 * (lane >> 1)) = (p & 0xffffu) | (other << 16); }
        if (lane == 0) scale_inv[row] = unit;
    }
}

#ifndef MK_PER_PHASE
#define MK_PER_PHASE 0
#endif
constexpr int N_PHASES = 47;
#ifndef DUP
#define DUP 0
#endif
struct Args { const float* in[N_IN]; float* out; unsigned char* ws; int lo, hi; };
static_assert(sizeof(Args) == (N_IN + 2) * 8 + 8, "Args has padding");

template <int LAYER>
__device__ __forceinline__ void peer_phases(int sub, LDSP unsigned char* lds, const Args& a, float* mod) {
    unsigned char* ws = a.ws; unsigned char* scr = ws + WS_SCR;
    bf16_t* X = (bf16_t*)(ws + WS_X); bf16_t* H = (bf16_t*)(ws + WS_H);
    const unsigned char* TU = ws + WS_UT + (size_t)LAYER * 16384 * (D / 2); const unsigned char* TV = ws + WS_VTAB + (size_t)LAYER * 16384 * (D / 2);
    const float* USC = (const float*)(ws + WS_TSC) + LAYER * 16384; const float* VSC = (const float*)(ws + WS_TSC) + (4 + LAYER) * 16384;
    int* EID = (int*)(ws + WS_EID); float* GATE = (float*)(ws + WS_GATE); bf16_t* PA = (bf16_t*)(scr + SC_PA);
    if (sub == 0) norm_phase<true>(nullptr, nullptr, X, a.in[I_N2G] + LAYER * D, mod + LAYER * 12288 + 6144, nullptr, (unsigned*)(scr + SC_X8), (float*)(scr + SC_SX));
    else if (sub == 1) run_gemm_i8_tok(lds, scr + SC_X8, ws + WS_PEERQ + (size_t)LAYER * D * D, 2048,
                                    FStoreBf16Scaled{(bf16_t*)(scr + SC_PQ), D, (const float*)(scr + SC_SX), (const float*)(ws + WS_PEERQ + 4 * (size_t)2048 * 2048) + LAYER * 2048});
    else if (sub == 2) peer_select_phase(lds, (const bf16_t*)(scr + SC_PQ), (const bf16_t*)(ws + WS_PKEYS) + (size_t)LAYER * 16 * 128 * 128, EID, GATE,
                                            LAYER < 3 ? LAYER + 1 : -1, a.in[I_PU], a.in[I_PV], ws + WS_UT, ws + WS_VTAB, (float*)(ws + WS_TSC));
    else if (sub == 3) { if (DUP & 1) peer_u_phase((const unsigned*)(scr + SC_X8), (const float*)(scr + SC_SX), TU, EID, PA); peer_u_phase((const unsigned*)(scr + SC_X8), (const float*)(scr + SC_SX), TU, EID, PA); }
    else if (sub == 4) peer_act_phase(PA, EID, USC, VSC, GATE, (float*)(scr + SC_ISC));
    else { if (DUP & 1) peer_v_phase(TV, (const int*)GATE, (const float*)(scr + SC_ISC), mod + LAYER * 12288 + 10240, X, (bf16_t*)(scr + 300 * MB)); peer_v_phase(TV, (const int*)GATE, (const float*)(scr + SC_ISC), mod + LAYER * 12288 + 10240, X, X); }
}

template <int PH>
__global__ void __launch_bounds__(NTH, 2) mk_fwd(Args a) {
    extern __shared__ __attribute__((aligned(16))) unsigned char lds_raw[];
    LDSP unsigned char* lds = (LDSP unsigned char*)lds_raw;
    unsigned char* ws = a.ws; unsigned char* scr = ws + WS_SCR;
    float* mod = (float*)(ws + WS_MOD); float* rope = (float*)(ws + WS_ROPE);
    bf16_t* X = (bf16_t*)(ws + WS_X); bf16_t* H = (bf16_t*)(ws + WS_H);
    const float* xp = a.in[I_XP]; const float* xs = a.in[I_XS];
    volatile LAS unsigned* xbw = (volatile LAS unsigned*)(lds + LDS_BYTES - 16);
    if (threadIdx.x == 0) { xbw[0] = 0u; xbw[1] = 0u; xbw[2] = 0u; xbw[3] = 0u; }
    __syncthreads();
    XcdBarrier bar; bar.bar = (unsigned*)(ws + WS_CTL); bar.x = 0; bar.st = xbw;
    if (!MK_PER_PHASE) bar = xcd_barrier_post((unsigned*)(ws + WS_CTL), xbw);
    const int lo = a.lo, hi = a.hi;
#ifndef ONLY
#define ONLY -1
#endif
#ifndef STOP_AFTER
#define STOP_AFTER 46
#endif
#define IN(k) ((PH < 0 || PH == (k)) && (ONLY < 0 || ONLY == (k)) && ((k) <= STOP_AFTER || (k) == 46) && lo <= (k) && (k) < hi)
#ifndef SEAMX
#define SEAMX 1
#endif
#define SEAM(k) do { if (!MK_PER_PHASE && IN((k) + 1)) { xcd_barrier(bar); if (SEAMX > 1) xcd_barrier(bar); } } while (0)

    if (IN(0)) {
#ifndef P0REP
#define P0REP 0
#endif
#define P0R(i) for (int rep_ = 0; rep_ < (((P0REP) >> (i)) & 1 ? 2 : 1); ++rep_)
        P0R(0) mod_phase(lds, a.in[I_CCTX], a.in[I_C], a.in[I_MODW], a.in[I_MODB], mod);
        rope_tables(rope);
        P0R(1) hy_filter_phase(lds, a.in[I_HFW1], a.in[I_HFB1], a.in[I_HFFREQ], a.in[I_HFW2], a.in[I_HFB2], a.in[I_HFW3], a.in[I_HLD], (bf16_t*)(ws + WS_HYF));
        P0R(2) cvt_transpose_all((LDSP float*)lds, a.in, ws);
        P0R(3) cvt_transpose_i8(lds, a.in[I_PWQ], ws + WS_PEERQ, (float*)(ws + WS_PEERQ + 4 * (size_t)2048 * 2048), 4);
        cvt_direct(a.in[I_PKEYS], (bf16_t*)(ws + WS_PKEYS), (size_t)4 * 16 * 128 * 128);
        P0R(4) { cvt_table_i4(a.in[I_PU], ws + WS_UT, (float*)(ws + WS_TSC), 0, 16384);
                 cvt_table_fp4(a.in[I_PV], ws + WS_VTAB, (float*)(ws + WS_TSC) + 4 * 16384, 0, 16384); }
        SEAM(0);
    }
    if (IN(1)) { norm_phase<false>(xp, xs, nullptr, a.in[I_N1G], mod, H); SEAM(1); }
    if (IN(2)) { run_gemm(lds, H, (const bf16_t*)(ws + WS_WDOWN), T, 1280, D, FStoreBf16{(bf16_t*)(scr + SC_DOWN), 1280}); SEAM(2); }
    if (IN(3)) { mla_rows_phase((const bf16_t*)(scr + SC_DOWN), a.in[I_MGQ], a.in[I_MGKV], a.in[I_CCKV], a.in[I_CKPE], rope, (bf16_t*)(scr + SC_CQ), (bf16_t*)(scr + SC_CKV), (bf16_t*)(scr + SC_KPE),
                                a.out + OUT_CKV, a.out + OUT_KPE); SEAM(3); }
    if (IN(4)) {
        run_gemm(lds, (const bf16_t*)(scr + SC_CQ), (const bf16_t*)(ws + WS_WUQ), T, 3072, 512, FMlaQ{(bf16_t*)(scr + SC_MQ), rope});
        run_gemm(lds, (const bf16_t*)(scr + SC_CKV), (const bf16_t*)(ws + WS_WUK), NKEY, 2048, 512, FStoreBf16{(bf16_t*)(scr + SC_KN), 2048});
        run_gemm(lds, (const bf16_t*)(ws + WS_WUV), (const bf16_t*)(scr + SC_CKV), 2048, NKEY, 512, FStoreBf16{(bf16_t*)(scr + SC_MVT), NKEY});
        SEAM(4); }
    if (IN(5)) { if (DUP & 4) attn_phase<0>(lds, (const bf16_t*)(scr + SC_MQ), (const bf16_t*)(scr + SC_KN), (const bf16_t*)(scr + SC_KPE), (const bf16_t*)(scr + SC_MVT), (bf16_t*)(scr + SC_MO), nullptr);
        attn_phase<0>(lds, (const bf16_t*)(scr + SC_MQ), (const bf16_t*)(scr + SC_KN), (const bf16_t*)(scr + SC_KPE), (const bf16_t*)(scr + SC_MVT), (bf16_t*)(scr + SC_MO), nullptr); SEAM(5); }
    if (IN(6)) { run_gemm_tok(lds, (const bf16_t*)(scr + SC_MO), (const bf16_t*)(ws + WS_WOMLA), D, FResidIn{xp, xs, X, mod + 0 * 12288 + 4096}); SEAM(6); }
    if (IN(7)) { peer_phases<0>(0, lds, a, mod); SEAM(7); }
    if (IN(8)) { peer_phases<0>(1, lds, a, mod); SEAM(8); }
    if (IN(9)) { peer_phases<0>(2, lds, a, mod); SEAM(9); }
    if (IN(10)) { peer_phases<0>(3, lds, a, mod); SEAM(10); }
    if (IN(11)) { peer_phases<0>(4, lds, a, mod); SEAM(11); }
    if (IN(12)) { peer_phases<0>(5, lds, a, mod); SEAM(12); }
    if (IN(13)) { norm_phase<true>(nullptr, nullptr, X, a.in[I_N1G] + 1 * D, mod + 1 * 12288, H); SEAM(13); }
    if (IN(14)) { run_gemm_tok(lds, H, (const bf16_t*)(ws + WS_S5IN), D, FStoreBf16{(bf16_t*)(scr + SC_U), D}); SEAM(14); }
    if (IN(15)) { if (DUP & 8) s5_scan_phase(lds, (const bf16_t*)(scr + SC_U), (bf16_t*)(scr + SC_YF), (bf16_t*)(scr + SC_YB), a.in, a.out);
        s5_scan_phase(lds, (const bf16_t*)(scr + SC_U), (bf16_t*)(scr + SC_YF), (bf16_t*)(scr + SC_YB), a.in, a.out); SEAM(15); }
    if (IN(16)) { s5_combine_phase((const bf16_t*)(scr + SC_U), (const bf16_t*)(scr + SC_YF), (const bf16_t*)(scr + SC_YB), a.in[I_S5D], (bf16_t*)(scr + SC_Z)); SEAM(16); }
    if (IN(17)) { run_gemm_tok(lds, (const bf16_t*)(scr + SC_Z), (const bf16_t*)(ws + WS_S5GATE), D, FS5Gate{(const bf16_t*)(scr + SC_Z), (bf16_t*)(scr + SC_ZZ)}); SEAM(17); }
    if (IN(18)) { run_gemm_tok(lds, (const bf16_t*)(scr + SC_ZZ), (const bf16_t*)(ws + WS_S5OUT), D, FResid{X, mod + 1 * 12288 + 4096}); SEAM(18); }
    if (IN(19)) { peer_phases<1>(0, lds, a, mod); SEAM(19); }
    if (IN(20)) { peer_phases<1>(1, lds, a, mod); SEAM(20); }
    if (IN(21)) { peer_phases<1>(2, lds, a, mod); SEAM(21); }
    if (IN(22)) { peer_phases<1>(3, lds, a, mod); SEAM(22); }
    if (IN(23)) { peer_phases<1>(4, lds, a, mod); SEAM(23); }
    if (IN(24)) { peer_phases<1>(5, lds, a, mod); SEAM(24); }
    if (IN(25)) { norm_phase<true>(nullptr, nullptr, X, a.in[I_N1G] + 2 * D, mod + 2 * 12288, H); SEAM(25); }
    if (IN(26)) { run_gemm_tailhalf(lds, (const bf16_t*)(ws + WS_HYIN), H, 6144, T, D, FStoreBf16RowBias{(bf16_t*)(scr + SC_ZT), T, a.in[I_HBIN]}); SEAM(26); }
    if (IN(27)) { if (DUP & 16) hy_conv_phase(lds, (const bf16_t*)(scr + SC_ZT), (const bf16_t*)(ws + WS_HYF), a.in[I_HSW], a.in[I_HSB], a.in[I_HBIAS], (bf16_t*)(scr + SC_VOT), (unsigned*)(ws + WS_CTL + 32768));
        hy_conv_phase(lds, (const bf16_t*)(scr + SC_ZT), (const bf16_t*)(ws + WS_HYF), a.in[I_HSW], a.in[I_HSB], a.in[I_HBIAS], (bf16_t*)(scr + SC_VOT), (unsigned*)(ws + WS_CTL + 32768)); SEAM(27); }
    if (IN(28)) { transpose_phase(lds, (const bf16_t*)(scr + SC_VOT), (bf16_t*)(scr + SC_VO)); SEAM(28); }
    if (IN(29)) { run_gemm_tok(lds, (const bf16_t*)(scr + SC_VO), (const bf16_t*)(ws + WS_HYOUT), D, FResid{X, mod + 2 * 12288 + 4096}); SEAM(29); }
    if (IN(30)) { peer_phases<2>(0, lds, a, mod); SEAM(30); }
    if (IN(31)) { peer_phases<2>(1, lds, a, mod); SEAM(31); }
    if (IN(32)) { peer_phases<2>(2, lds, a, mod); SEAM(32); }
    if (IN(33)) { peer_phases<2>(3, lds, a, mod); SEAM(33); }
    if (IN(34)) { peer_phases<2>(4, lds, a, mod); SEAM(34); }
    if (IN(35)) { peer_phases<2>(5, lds, a, mod); SEAM(35); }
    if (IN(36)) {
        norm_phase<true>(nullptr, nullptr, X, a.in[I_N1G] + 3 * D, mod + 3 * 12288, H);
        {
            bf16_t* KALL = (bf16_t*)(scr + SC_SK); bf16_t* VTs = (bf16_t*)(scr + SC_SVT);
            const float* ck = a.in[I_CSK]; const float* cv = a.in[I_CSV];
            for (int i = blockIdx.x * NTH + threadIdx.x; i < 8 * 256 * 512; i += gridDim.x * NTH) {
                const int c = i & 511, pos = (i >> 9) & 255, b = i >> 17, krow = TC + b * 2304 + 2048 + pos;
                { const int hh = c >> 7, p = c & 127, pi = p >> 1, aa = pi >> 5, f = pi & 31, orig = hh * 128 + 64 * aa + f + 32 * (p & 1); KALL[(size_t)krow * 512 + c] = f2bf(ck[(size_t)(b * 256 + pos) * 512 + orig]); }
                VTs[(size_t)c * NKEY + krow] = f2bf(cv[(size_t)(b * 256 + pos) * 512 + c]);
            }
        }
        SEAM(36); }
    if (IN(37)) {
        run_gemm(lds, H, (const bf16_t*)(ws + WS_SWAQKV), T, 2560, D, FSwaQK{(bf16_t*)(scr + SC_SQ), (bf16_t*)(scr + SC_SK), a.out + OUT_SWAK, rope + 2048});
        run_gemm(lds, (const bf16_t*)(ws + WS_SWAQKV) + (size_t)2560 * D, H, 512, T, D, FSwaVT{(bf16_t*)(scr + SC_SVT), a.out + OUT_SWAV}, gridDim.x == 256 ? 32 : 0);
        SEAM(37); }
    if (IN(38)) { if (DUP & 4) attn_phase<1>(lds, (const bf16_t*)(scr + SC_SQ), (const bf16_t*)(scr + SC_SK), nullptr, (const bf16_t*)(scr + SC_SVT), (bf16_t*)(scr + SC_SO), a.in[I_SSINK]);
        attn_phase<1>(lds, (const bf16_t*)(scr + SC_SQ), (const bf16_t*)(scr + SC_SK), nullptr, (const bf16_t*)(scr + SC_SVT), (bf16_t*)(scr + SC_SO), a.in[I_SSINK]); SEAM(38); }
    if (IN(39)) { run_gemm_tok(lds, (const bf16_t*)(scr + SC_SO), (const bf16_t*)(ws + WS_SWAO), D, FResid{X, mod + 3 * 12288 + 4096}); SEAM(39); }
    if (IN(40)) { peer_phases<3>(0, lds, a, mod); SEAM(40); }
    if (IN(41)) { peer_phases<3>(1, lds, a, mod); SEAM(41); }
    if (IN(42)) { peer_phases<3>(2, lds, a, mod); SEAM(42); }
    if (IN(43)) { peer_phases<3>(3, lds, a, mod); SEAM(43); }
    if (IN(44)) { peer_phases<3>(4, lds, a, mod); SEAM(44); }
    if (IN(45)) { peer_phases<3>(5, lds, a, mod); SEAM(45); }
    if (IN(46)) { final_norm_phase(X, a.in[I_FING], a.out + OUT_Y); }
#undef IN
#undef SEAM
}

#ifndef REP_LO
#define REP_LO 0ull
#endif
template <int P> static void launch_phase(const Args& a, int grid, hipStream_t stream) {
    static bool attr = false;
    if (!attr) { (void)hipFuncSetAttribute((const void*)mk_fwd<P>, hipFuncAttributeMaxDynamicSharedMemorySize, LDS_BYTES); attr = true; }
    hipLaunchKernelGGL(mk_fwd<P>, dim3(grid), dim3(NTH), LDS_BYTES, stream, a);
}
#if MK_PER_PHASE
template <int P> static void launch_all(Args a, int grid, hipStream_t stream) {
    if constexpr (P < N_PHASES) {
        a.lo = P; a.hi = P + 1;
        launch_phase<P>(a, grid, stream);
        if ((REP_LO >> P) & 1ull) launch_phase<P>(a, grid, stream);
        launch_all<P + 1>(a, grid, stream);
    }
}
#endif
extern "C" void kernel_launch(void* const* d_in, const int* in_sizes, int n_in, void* d_out, int out_size, void* d_ws, size_t ws_size, hipStream_t stream) {
    static int grid = 0;
    if (grid == 0) {
        if (n_in != N_IN || (size_t)out_size != OUT_END || ws_size < WS_END) { fprintf(stderr, "kernel_launch: unexpected shapes: n_in %d out %d ws %zu (need %zu)\n", n_in, out_size, ws_size, (size_t)WS_END); grid = -1; return; }
        int dev = 0, cus = 0;
        if (hipGetDevice(&dev) != hipSuccess || hipDeviceGetAttribute(&cus, hipDeviceAttributeMultiprocessorCount, dev) != hipSuccess) { grid = -1; return; }
        grid = cus;
    }
    if (grid < 0) return;
    (void)hipMemsetAsync((char*)d_ws + WS_CTL, 0, 65536, stream);
    Args a{};
    for (int i = 0; i < N_IN; ++i) a.in[i] = (const float*)d_in[i];
    a.out = (float*)d_out; a.ws = (unsigned char*)d_ws;
#if MK_PER_PHASE
    launch_all<0>(a, grid, stream);
#else
    a.lo = 0; a.hi = N_PHASES;
    launch_phase<-1>(a, grid, stream);
#endif
    const hipError_t le = hipPeekAtLastError();
    if (le != hipSuccess) fprintf(stderr, "kernel_launch: launch failed: %s\n", hipGetErrorName(le));
}
```

```cpp
#include <hip/hip_runtime.h>
#include <cstdio>
#include <cstdint>
#define MK_PER_PHASE 0
namespace pg8 {
#define PG8_LAS __attribute__((address_space(3)))
typedef unsigned short bf16_t;
typedef short bf16x8 __attribute__((ext_vector_type(8)));
typedef float f32x4 __attribute__((ext_vector_type(4)));
typedef unsigned u32x4 __attribute__((ext_vector_type(4)));
constexpr int BM = 256, BK = 64, HALF = 128, HTB = HALF * BK * 2  , STAGE_BYTES = 8 * HTB, NXCD = 8, WGM = 8;

__host__ __device__ __forceinline__ int lds_byte(int r, int c) { const int st = (r >> 4) * 2 + (c >> 5), rr = r & 15, cc = c & 31, ob = rr * 64 + cc * 2; return st * 1024 + (ob ^ (((ob >> 9) & 1) << 5)); }
__host__ __device__ __forceinline__ void stage_rc(int b, int& R, int& C) { const int st = b / 1024, sb = b % 1024, swz = sb ^ (((sb >> 9) & 1) << 5); R = (st >> 1) * 16 + swz / 64; C = (st & 1) * 32 + (swz % 64) / 2; }
__host__ __device__ __forceinline__ int perm32(int rho) { const int n = rho >> 4, i = rho & 15; return 8 * (i >> 2) + 4 * n + (i & 3); }

struct Unit { int pm, pn, arow, half; };
struct Gemm { const bf16_t* A; const bf16_t* Bt; int M, N, K; };

struct StaticOrder {
    int nM, nN, nwg, G, c;
    __host__ __device__ void init(int M, int N, int G_, int c_) { nM = M / BM; nN = N / BM; nwg = nM * nN; G = G_; c = c_; }
    __host__ __device__ int remap(int wgid) const { const int q = nwg / NXCD, r = nwg % NXCD, xcd = wgid % NXCD, off = wgid / NXCD; return (xcd < r ? xcd * (q + 1) : r * (q + 1) + (xcd - r) * q) + off; }
    __host__ __device__ void decode(int wgid, Unit& u) const {
        const int nig = WGM * nN, gid = wgid / nig, fm = gid * WGM, gsz = (nM - fm) < WGM ? (nM - fm) : WGM;
        u.pm = fm + ((wgid % nig) % gsz); u.pn = (wgid % nig) / gsz; u.arow = u.pm * BM; u.half = 0;
    }
    __host__ __device__ bool next(int i, Unit& u) const {
        const long L = (long)i * G + c; if (L >= nwg) return false;
        decode(remap((int)L), u); return true;
    }
    __device__ __forceinline__ void a_ready(const Unit&) const {}
    __device__ __forceinline__ void done(const Unit&) const {}
};
struct TailHalfOrder {
    StaticOrder so; int nfull, nh, G, c;
    __host__ __device__ void init(int M, int N, int nh_, int G_, int c_) { so.init(M, N, G_, c_); nh = nh_; nfull = so.nwg - nh_; G = G_; c = c_; }
    __host__ __device__ bool next(int i, Unit& u) const {
        const long L = (long)i * G + c;
        if (L < nfull) { so.decode(so.remap((int)L), u); return true; }
        const long h = L - nfull; if (h >= 2 * nh) return false;
        const int x = (int)(h % NXCD), r = (int)(h / NXCD), q = so.nwg / NXCD;
        so.decode(x * q + (q - nh / NXCD) + (r >> 1), u); u.arow += (r & 1) * HALF; u.half = 1; return true;
    }
    __device__ __forceinline__ void a_ready(const Unit&) const {}
    __device__ __forceinline__ void done(const Unit&) const {}
};
struct HalfOrder {
    StaticOrder so; int nN, nhalf, G, c;
    __host__ __device__ void init(int Mfull, int M, int N, int G_, int c_) { so.init(Mfull, N, G_, c_); nN = N / BM; nhalf = ((M - Mfull) / HALF) * nN; G = G_; c = c_; }
    __host__ __device__ bool next(int i, Unit& u) const {
        if (so.next(i, u)) return true;
        const long L = (long)i * G + c - so.nwg; if (L < 0 || L >= nhalf) return false;
        const int hm = (int)(L / nN); u.pn = (int)(L % nN); u.pm = so.nM + (hm >> 1); u.arow = so.nM * BM + hm * HALF; u.half = 1; return true;
    }
    __device__ __forceinline__ void a_ready(const Unit&) const {}
    __device__ __forceinline__ void done(const Unit&) const {}
};
typedef int i32x4 __attribute__((ext_vector_type(4)));
template <bool I8> __device__ __forceinline__ f32x4 pg8_mma(bf16x8 a, bf16x8 b, f32x4 c) { return __builtin_amdgcn_mfma_f32_16x16x32_bf16(a, b, c, 0, 0, 0); }
template <bool I8> __device__ __forceinline__ i32x4 pg8_mma(bf16x8 a, bf16x8 b, i32x4 c) { return __builtin_amdgcn_mfma_i32_16x16x64_i8(__builtin_bit_cast(i32x4, a), __builtin_bit_cast(i32x4, b), c, 0, 0, 0); }
template <bool I8> struct AccSel { typedef f32x4 type; };
template <> struct AccSel<true> { typedef i32x4 type; };
template <class Epi, class Sched, bool ALIGN_EPI = false, bool SP2 = false, bool I8 = false>
__device__ __forceinline__ void gemm_phase(PG8_LAS unsigned char* lds, const Gemm g, const Sched& S, const Epi& E) {
    const int tid = threadIdx.x, wid = __builtin_amdgcn_readfirstlane(tid >> 6), lane = tid & 63, wr = wid >> 2, wc = wid & 3, fr = lane & 15, fq = lane >> 4;
    const int K = g.K, nt = K / BK;
    unsigned voffA[2], voffB[2];
#pragma unroll
    for (int i = 0; i < 2; ++i) { int R, C; stage_rc(tid * 16 + i * 8192, R, C); const int Rb = Epi::PERM ? ((R & ~31) + perm32(R & 31)) : R;
        voffA[i] = (unsigned)(R * K + C) * 2u; voffB[i] = (unsigned)(Rb * K + C) * 2u; }
    const size_t kstep = (size_t)(BK * 2);
    const size_t hstep = (size_t)HALF * K * 2;
    const size_t tstep = 2 * hstep;
    const unsigned ldsw = (unsigned)wid * 1024u;
    const int aoff = lds_byte(wr * 64 + fr, fq * 8), boff = lds_byte(wc * 32 + fr, fq * 8);
#define PG8_SA(b, h) (((b) * 2 + (h)) * HTB)
#define PG8_SB(b, h) ((4 + (b) * 2 + (h)) * HTB)
#define PG8_STAGE(bufoff, gbase, voff) do { _Pragma("unroll") for (int _i = 0; _i < 2; ++_i) \
        __builtin_amdgcn_global_load_lds((const unsigned*)((const char*)(gbase) + (voff)[_i]), (PG8_LAS unsigned*)(lds + (bufoff) + ldsw + _i * 8192), 16, 0, 0); } while (0)
#define PG8_LDA(dst, b, h) do { _Pragma("unroll") for (int m = 0; m < 4; ++m) _Pragma("unroll") for (int k = 0; k < 2; ++k) dst[m][k] = *(const PG8_LAS bf16x8*)(lds + PG8_SA(b, h) + aoff + m * 2048 + k * 1024); } while (0)
#define PG8_LDB(dst, b, h) do { _Pragma("unroll") for (int n = 0; n < 2; ++n) _Pragma("unroll") for (int k = 0; k < 2; ++k) dst[n][k] = *(const PG8_LAS bf16x8*)(lds + PG8_SB(b, h) + boff + n * 2048 + k * 1024); } while (0)
#define PG8_MMA(ai, bj, At, Bt) do { __builtin_amdgcn_s_setprio(1); _Pragma("unroll") for (int m = 0; m < 4; ++m) _Pragma("unroll") for (int n = 0; n < 2; ++n) _Pragma("unroll") for (int k = 0; k < 2; ++k) \
        acc[ai][bj][m][n] = pg8_mma<I8>(Bt[n][k], At[m][k], acc[ai][bj][m][n]); __builtin_amdgcn_s_setprio(0); } while (0)
#define PG8_WAIT_V(n) asm volatile("s_waitcnt vmcnt(" #n ")" ::: "memory")
#define PG8_WAIT_L(n) asm volatile("s_waitcnt lgkmcnt(" #n ")" ::: "memory")
#define PG8_BAR __builtin_amdgcn_s_barrier()
#define PG8_SCHED __builtin_amdgcn_sched_barrier(0)
    Unit cur, nxt; int ui = 0;
    if (!S.next(0, cur)) return;
    typedef typename AccSel<I8>::type acc_t;
    acc_t acc[2][2][4][2];
#pragma unroll
    for (int a = 0; a < 2; ++a)
#pragma unroll
        for (int b = 0; b < 2; ++b)
#pragma unroll
            for (int m = 0; m < 4; ++m)
#pragma unroll
                for (int n = 0; n < 2; ++n) acc[a][b][m][n] = (acc_t){0, 0, 0, 0};
    bf16x8 At[4][2], B0[2][2], B1[2][2];
    const char* cA = (const char*)g.A + (size_t)cur.arow * K * 2; const char* cB = (const char*)g.Bt + (size_t)cur.pn * tstep;
    size_t hsA_c = cur.half ? 0 : hstep;
    S.a_ready(cur);
    if constexpr (SP2) {
        PG8_STAGE(PG8_SB(0, 0), cB, voffB); PG8_STAGE(PG8_SB(0, 1), cB + hstep, voffB); PG8_STAGE(PG8_SA(0, 0), cA, voffA); PG8_STAGE(PG8_SA(0, 1), cA + hsA_c, voffA);
        if (wr == 1) PG8_BAR;
        PG8_WAIT_V(2); PG8_BAR;
        PG8_STAGE(PG8_SB(1, 0), cB + kstep, voffB); PG8_STAGE(PG8_SA(1, 0), cA + kstep, voffA); PG8_STAGE(PG8_SB(1, 1), cB + hstep + kstep, voffB);
        PG8_WAIT_V(6); PG8_BAR;
    } else {
        PG8_STAGE(PG8_SB(0, 0), cB, voffB); PG8_STAGE(PG8_SA(0, 0), cA, voffA); PG8_STAGE(PG8_SB(0, 1), cB + hstep, voffB); PG8_STAGE(PG8_SA(0, 1), cA + hstep, voffA);
        if (wr == 1) PG8_BAR;
        PG8_WAIT_V(4); PG8_BAR;
        PG8_STAGE(PG8_SB(1, 0), cB + kstep, voffB); PG8_STAGE(PG8_SA(1, 0), cA + kstep, voffA); PG8_STAGE(PG8_SB(1, 1), cB + hstep + kstep, voffB);
        PG8_WAIT_V(6); PG8_BAR;
    }
    for (;;) {
        const bool has_next = S.next(ui + 1, nxt);
        const char* nA = has_next ? (const char*)g.A + (size_t)nxt.arow * K * 2 : cA; const size_t hsA_n = has_next ? (nxt.half ? 0 : hstep) : hsA_c; const bool full = !cur.half; const char* nB = has_next ? (const char*)g.Bt + (size_t)nxt.pn * tstep : cB;
        for (int t = 0; t < nt; t += 2) {
            const bool last = (t == nt - 2);
            const char* a1 = cA + (size_t)(t + 1) * kstep;
            const char* a2 = last ? nA : cA + (size_t)(t + 2) * kstep; const char* b2 = last ? nB : cB + (size_t)(t + 2) * kstep;
            const char* a3 = a2 + kstep; const char* b3 = b2 + kstep;
            if (last && has_next) S.a_ready(nxt);
            if constexpr (SP2) {
            PG8_LDB(B0, 0, 0); PG8_LDB(B1, 0, 1); PG8_SCHED; PG8_LDA(At, 0, 0); PG8_STAGE(PG8_SA(1, 1), a1 + hsA_c, voffA);
            PG8_WAIT_V(8); PG8_WAIT_L(0); PG8_BAR; PG8_MMA(0, 0, At, B0); PG8_MMA(0, 1, At, B1); PG8_BAR; PG8_SCHED;
            if (full) PG8_LDA(At, 0, 1); PG8_STAGE(PG8_SB(0, 0), b2, voffB); PG8_STAGE(PG8_SB(0, 1), b2 + hstep, voffB); PG8_STAGE(PG8_SA(0, 0), a2, voffA);
            PG8_WAIT_V(8); PG8_WAIT_L(0); PG8_BAR; if (full) { PG8_MMA(1, 0, At, B0); PG8_MMA(1, 1, At, B1); } PG8_BAR; PG8_SCHED;
            PG8_LDB(B0, 1, 0); PG8_LDB(B1, 1, 1); PG8_SCHED; PG8_LDA(At, 1, 0); PG8_STAGE(PG8_SA(0, 1), a2 + (last ? hsA_n : hsA_c), voffA);
            PG8_WAIT_V(8); PG8_WAIT_L(0); PG8_BAR; PG8_MMA(0, 0, At, B0); PG8_MMA(0, 1, At, B1); PG8_BAR; PG8_SCHED;
            if (full) PG8_LDA(At, 1, 1); PG8_STAGE(PG8_SB(1, 0), b3, voffB); PG8_STAGE(PG8_SB(1, 1), b3 + hstep, voffB); PG8_STAGE(PG8_SA(1, 0), a3, voffA);
            PG8_WAIT_V(8); PG8_WAIT_L(0); PG8_BAR; if (full) { PG8_MMA(1, 0, At, B0); PG8_MMA(1, 1, At, B1); } PG8_BAR; PG8_SCHED;
            } else {
            PG8_LDB(B0, 0, 0); PG8_SCHED; PG8_LDA(At, 0, 0); PG8_STAGE(PG8_SA(1, 1), a1 + hstep, voffA);
            PG8_WAIT_L(8); PG8_BAR; PG8_WAIT_L(0); PG8_MMA(0, 0, At, B0); PG8_BAR; PG8_SCHED;
            PG8_LDB(B1, 0, 1); PG8_STAGE(PG8_SB(0, 0), b2, voffB);
            PG8_BAR; PG8_WAIT_L(0); PG8_MMA(0, 1, At, B1); PG8_BAR;
            PG8_LDA(At, 0, 1); PG8_STAGE(PG8_SA(0, 0), a2, voffA);
            PG8_BAR; PG8_WAIT_L(0); PG8_MMA(1, 0, At, B0); PG8_BAR; PG8_SCHED;
            PG8_STAGE(PG8_SB(0, 1), b2 + hstep, voffB);
            PG8_WAIT_V(6); PG8_BAR; PG8_MMA(1, 1, At, B1); PG8_BAR;
            PG8_LDB(B0, 1, 0); PG8_SCHED; PG8_LDA(At, 1, 0); PG8_STAGE(PG8_SA(0, 1), a2 + hstep, voffA);
            PG8_WAIT_L(8); PG8_BAR; PG8_WAIT_L(0); PG8_MMA(0, 0, At, B0); PG8_BAR; PG8_SCHED;
            PG8_LDB(B1, 1, 1); PG8_STAGE(PG8_SB(1, 0), b3, voffB);
            PG8_BAR; PG8_WAIT_L(0); PG8_MMA(0, 1, At, B1); PG8_BAR;
            PG8_LDA(At, 1, 1); PG8_STAGE(PG8_SA(1, 0), a3, voffA);
            PG8_BAR; PG8_WAIT_L(0); PG8_MMA(1, 0, At, B0); PG8_BAR; PG8_SCHED;
            PG8_STAGE(PG8_SB(1, 1), b3 + hstep, voffB);
            PG8_WAIT_V(6); PG8_BAR; PG8_MMA(1, 1, At, B1); PG8_BAR;
            }
        }
        if constexpr (ALIGN_EPI) { if (wr == 0) PG8_BAR; }
        if constexpr (!Epi::AFTER_DRAIN) { E(acc, cur, wr, wc, fr, fq); S.done(cur); }
        if (!has_next) break;
#pragma unroll
        for (int a = 0; a < 2; ++a)
#pragma unroll
            for (int b = 0; b < 2; ++b)
#pragma unroll
                for (int m = 0; m < 4; ++m)
#pragma unroll
                    for (int n = 0; n < 2; ++n) acc[a][b][m][n] = (acc_t){0, 0, 0, 0};
        cur = nxt; cA = nA; cB = nB; hsA_c = hsA_n; ++ui;
        if constexpr (ALIGN_EPI) { if (wr == 1) PG8_BAR; }
    }
    PG8_WAIT_V(0);
    if constexpr (!ALIGN_EPI) { if (wr == 0) PG8_BAR; }
    PG8_BAR;
    if constexpr (Epi::AFTER_DRAIN) { E.fused(acc, cur, wr, wc, fr, fq, lds, wid, lane); S.done(cur); }
#undef PG8_SA
#undef PG8_SB
#undef PG8_STAGE
#undef PG8_LDA
#undef PG8_LDB
#undef PG8_MMA
#undef PG8_WAIT_V
#undef PG8_WAIT_L
#undef PG8_BAR
#undef PG8_SCHED
}
}

#define LDSP __attribute__((address_space(3)))
typedef unsigned short bf16_t;
typedef short bf16x8 __attribute__((ext_vector_type(8)));
typedef float f32x4 __attribute__((ext_vector_type(4)));
typedef float f32x2 __attribute__((ext_vector_type(2)));
typedef unsigned u32x4 __attribute__((ext_vector_type(4)));
typedef unsigned u32x2 __attribute__((ext_vector_type(2)));
typedef __bf16 bf16x2_t __attribute__((ext_vector_type(2)));

constexpr int D = 2048, TC = 4096, TL = 16384, T = TC + TL, NKEY = 22528;
constexpr int NTH = 512;
constexpr int LDS_BYTES = 147456;

constexpr size_t al256(size_t x) { return (x + 255) & ~(size_t)255; }
constexpr size_t MB = 1024 * 1024;
constexpr size_t WS_CTL    = 0;
constexpr size_t WS_MOD    = 65536;
constexpr size_t WS_ROPE   = WS_MOD + al256((size_t)9 * 4 * 12288 * 4);
constexpr size_t WS_WDOWN  = WS_ROPE + 32768;
constexpr size_t WS_WUQ    = WS_WDOWN + (size_t)1280 * 2048 * 2;
constexpr size_t WS_WUK    = WS_WUQ + (size_t)3072 * 512 * 2;
constexpr size_t WS_WUV    = WS_WUK + (size_t)2048 * 512 * 2;
constexpr size_t WS_WOMLA  = WS_WUV + (size_t)2048 * 512 * 2;
constexpr size_t WSZ_SQ    = (size_t)2048 * 2048 * 2;
constexpr size_t WS_S5IN   = WS_WOMLA + WSZ_SQ;
constexpr size_t WS_S5GATE = WS_S5IN + WSZ_SQ;
constexpr size_t WS_S5OUT  = WS_S5GATE + WSZ_SQ;
constexpr size_t WS_HYIN   = WS_S5OUT + WSZ_SQ;
constexpr size_t WS_HYOUT  = WS_HYIN + (size_t)6144 * 2048 * 2;
constexpr size_t WS_SWAQKV = WS_HYOUT + WSZ_SQ;
constexpr size_t WS_SWAO   = WS_SWAQKV + (size_t)3072 * 2048 * 2;
constexpr size_t WS_PEERQ  = WS_SWAO + WSZ_SQ;
constexpr size_t WS_PKEYS  = WS_PEERQ + 4 * WSZ_SQ;
constexpr size_t WS_HYF    = WS_PKEYS + (size_t)4 * 16 * 128 * 128 * 2;
constexpr size_t WS_UT     = WS_HYF + (size_t)2 * 2048 * 512 * 2 + (size_t)2 * 2048 * 4096 * 2;
constexpr size_t WSZ_TAB   = (size_t)4 * 16384 * 2048;
constexpr size_t WS_VTAB   = WS_UT + WSZ_TAB;
constexpr size_t WS_TSC    = WS_VTAB + WSZ_TAB;
constexpr size_t WS_X      = WS_TSC + (size_t)2 * 4 * 16384 * 4;
constexpr size_t WS_H      = WS_X + (size_t)T * D * 4;
constexpr size_t WS_EID    = WS_H + (size_t)T * D * 2;
constexpr size_t WS_GATE   = WS_EID + (size_t)T * 128 * 4;
constexpr size_t WS_SCR    = WS_GATE + (size_t)T * 128 * 4;
constexpr size_t SC_DOWN = 0;
constexpr size_t SC_CQ   = SC_DOWN + (size_t)T * 1280 * 4;
constexpr size_t SC_CKV  = SC_CQ + (size_t)T * 512 * 2;
constexpr size_t SC_KPE  = SC_CKV + (size_t)NKEY * 512 * 2;
constexpr size_t SC_MQ   = SC_KPE + (size_t)NKEY * 64 * 2;
constexpr size_t SC_KN   = SC_MQ + (size_t)T * 3072 * 2;
constexpr size_t SC_MVT  = SC_KN + (size_t)NKEY * 2048 * 2;
constexpr size_t SC_MO   = SC_MVT + (size_t)NKEY * 2048 * 2;
constexpr size_t SC_MLA_END = SC_MO + (size_t)T * D * 2;
constexpr size_t SZ_ACT  = (size_t)T * D * 2;
constexpr size_t SC_U = 0, SC_YF = SZ_ACT, SC_YB = 2 * SZ_ACT, SC_Z = 3 * SZ_ACT, SC_ZZ = 4 * SZ_ACT;
constexpr size_t SC_ZT = 0;
constexpr size_t SC_VOT = SC_ZT + (size_t)6144 * T * 2;
constexpr size_t SC_VO  = SC_VOT + SZ_ACT;
constexpr size_t SC_SQ = 0;
constexpr size_t SC_SK = SZ_ACT;
constexpr size_t SC_SVT = SC_SK + (size_t)NKEY * 512 * 2;
constexpr size_t SC_SO = SC_SVT + (size_t)NKEY * 512 * 2;
constexpr size_t SC_PQ = 0;
constexpr size_t SC_PA = SZ_ACT;
constexpr size_t SC_X8 = 256 * MB;
constexpr size_t SC_SX = 299 * MB;
constexpr size_t SC_ISC = 299 * MB + 131072;
static_assert(SC_PA + (size_t)16 * T * 128 * 4 <= SC_X8 && SC_X8 + (size_t)T * D <= SC_SX, "peer scratch");
constexpr size_t WS_END = WS_SCR + SC_MLA_END;
static_assert(SC_VO + SZ_ACT <= SC_MLA_END && 5 * SZ_ACT <= SC_MLA_END, "scratch");

constexpr size_t OUT_Y = 0;
constexpr size_t OUT_CKV = (size_t)T * D;
constexpr size_t OUT_KPE = OUT_CKV + (size_t)TC * 512;
constexpr size_t OUT_S5RE = OUT_KPE + (size_t)TC * 64;
constexpr size_t OUT_S5IM = OUT_S5RE + (size_t)16 * 2 * 128 * 64;
constexpr size_t OUT_SWAK = OUT_S5IM + (size_t)16 * 2 * 128 * 64;
constexpr size_t OUT_SWAV = OUT_SWAK + (size_t)TC * 512;
constexpr size_t OUT_END = OUT_SWAV + (size_t)TC * 512;

enum { I_XP = 0, I_XS, I_C, I_CCKV, I_CKPE, I_S5RE, I_S5IM, I_CSK, I_CSV, I_CCTX, I_MODW, I_MODB, I_N1G, I_N2G, I_FING,
       I_MWDOWN, I_MGQ, I_MGKV, I_MWUQ, I_MWUKV, I_MWO, I_S5WIN, I_S5LRE, I_S5LIM, I_S5LDT, I_S5BRE, I_S5BIM, I_S5CRE, I_S5CIM, I_S5D, I_S5WG, I_S5WO,
       I_HWIN, I_HBIN, I_HSW, I_HSB, I_HFW1, I_HFB1, I_HFFREQ, I_HFW2, I_HFB2, I_HFW3, I_HLD, I_HBIAS, I_HWOUT, I_SWQKV, I_SWO, I_SSINK,
       I_PWQ, I_PKEYS, I_PU, I_PV, N_IN };

__device__ __forceinline__ unsigned pk_bf16(float lo, float hi) { const f32x2 v = {lo, hi}; return __builtin_bit_cast(unsigned, __builtin_convertvector(v, bf16x2_t)); }
__device__ __forceinline__ bf16_t f2bf(float f) { return (bf16_t)(pk_bf16(f, 0.f) & 0xffffu); }
__device__ __forceinline__ float bf_lo(unsigned w) { return __uint_as_float(w << 16); }
__device__ __forceinline__ float bf_hi(unsigned w) { return __uint_as_float(w & 0xffff0000u); }
__device__ __forceinline__ float bf2f(bf16_t h) { return __uint_as_float((unsigned)h << 16); }
__device__ __forceinline__ float wave_sum(float v) { v += __shfl_xor(v, 32); v += __shfl_xor(v, 16); v += __shfl_xor(v, 8); v += __shfl_xor(v, 4); v += __shfl_xor(v, 2); v += __shfl_xor(v, 1); return v; }
__device__ __forceinline__ float fexp2(float x) { return __builtin_amdgcn_exp2f(x); }
__device__ __forceinline__ float gelu_tanh(float a) { const float u = 1.5957691216057308f * (a + 0.044715f * a * a * a); return a / (1.f + __expf(-u)); }
__device__ __forceinline__ int keyrow_of(int row) { return row < TC ? row : TC + ((row - TC) >> 11) * 2304 + ((row - TC) & 2047); }
__device__ __forceinline__ int cond_of(int row) { return row < TC ? 0 : 1 + ((row - TC) >> 11); }
__device__ __forceinline__ bf16x8 as_bf16x8(u32x4 v) { return __builtin_bit_cast(bf16x8, v); }
template <int CTRL> __device__ __forceinline__ int dpp_i(int x) { return __builtin_amdgcn_update_dpp(0, x, CTRL, 0xf, 0xf, true); }
template <int CTRL> __device__ __forceinline__ float dpp_f(float x) { return __int_as_float(__builtin_amdgcn_update_dpp(0, __float_as_int(x), CTRL, 0xf, 0xf, true)); }
__device__ __forceinline__ float xsum32(float a, float b) { const auto r = __builtin_amdgcn_permlane32_swap(__float_as_uint(a), __float_as_uint(b), false, false); return __uint_as_float(r[0]) + __uint_as_float(r[1]); }
__device__ __forceinline__ float xsum16(float a, float b) { const auto r = __builtin_amdgcn_permlane16_swap(__float_as_uint(a), __float_as_uint(b), false, false); return __uint_as_float(r[0]) + __uint_as_float(r[1]); }
typedef _Float16 h2_t __attribute__((ext_vector_type(2)));
__device__ __forceinline__ h2_t xsum32h(h2_t a, h2_t b) { const auto r = __builtin_amdgcn_permlane32_swap(__builtin_bit_cast(unsigned, a), __builtin_bit_cast(unsigned, b), false, false); unsigned r0 = r[0], r1 = r[1]; asm volatile("" : "+v"(r0), "+v"(r1)); return __builtin_bit_cast(h2_t, r0) + __builtin_bit_cast(h2_t, r1); }
__device__ __forceinline__ h2_t xsum16h(h2_t a, h2_t b) { const auto r = __builtin_amdgcn_permlane16_swap(__builtin_bit_cast(unsigned, a), __builtin_bit_cast(unsigned, b), false, false); unsigned r0 = r[0], r1 = r[1]; asm volatile("" : "+v"(r0), "+v"(r1)); return __builtin_bit_cast(h2_t, r0) + __builtin_bit_cast(h2_t, r1); }
__device__ __forceinline__ float xmax_16_32(float x) {
    auto s = __builtin_amdgcn_permlane16_swap(__float_as_uint(x), __float_as_uint(x), false, false); x = fmaxf(__uint_as_float(s[0]), __uint_as_float(s[1]));
    auto t = __builtin_amdgcn_permlane32_swap(__float_as_uint(x), __float_as_uint(x), false, false); return fmaxf(__uint_as_float(t[0]), __uint_as_float(t[1])); }
#define WAVE_SYNC() do { asm volatile("s_waitcnt lgkmcnt(0)" ::: "memory"); __builtin_amdgcn_wave_barrier(); } while (0)

namespace pg8 {
template <class F> struct EpiFn {
    static constexpr bool PERM = false, AFTER_DRAIN = false;
    F f;
    template <class AccT>
    __device__ __forceinline__ void operator()(const AccT (&acc)[2][2][4][2], const Unit& u, int wr, int wc, int fr, int fq) const {
        const int row0 = u.arow + wr * 64 + fr, col0 = u.pn * BM + wc * 32 + 4 * fq;
#pragma unroll
        for (int ai = 0; ai < 2; ++ai) {
            if (ai == 1 && u.half) break;
#pragma unroll
            for (int m = 0; m < 4; ++m) {
                const int row = row0 + ai * HALF + m * 16;
#pragma unroll
                for (int bj = 0; bj < 2; ++bj)
#pragma unroll
                    for (int n = 0; n < 2; ++n) f(row, col0 + bj * HALF + n * 16, __builtin_convertvector(acc[ai][bj][m][n], f32x4));
            }
        }
    }
};
template <class F> struct EpiFn8 {
    static constexpr bool PERM = true, AFTER_DRAIN = false;
    F f;
    template <class AccT>
    __device__ __forceinline__ void operator()(const AccT (&acc)[2][2][4][2], const Unit& u, int wr, int wc, int fr, int fq) const {
        const int row0 = u.arow + wr * 64 + fr, col0 = u.pn * BM + wc * 32 + 8 * fq;
#pragma unroll
        for (int ai = 0; ai < 2; ++ai) {
            if (ai == 1 && u.half) break;
#pragma unroll
            for (int m = 0; m < 4; ++m) {
                const int row = row0 + ai * HALF + m * 16;
#pragma unroll
                for (int bj = 0; bj < 2; ++bj)
                    f(row, col0 + bj * HALF, __builtin_convertvector(acc[ai][bj][m][0], f32x4), __builtin_convertvector(acc[ai][bj][m][1], f32x4));
            }
        }
    }
};
template <class F, bool W8 = F::W8> struct EpiSelT { using type = EpiFn<F>; };
template <class F> struct EpiSelT<F, true> { using type = EpiFn8<F>; };
template <class F> using EpiSel = typename EpiSelT<F>::type;
}

__device__ __forceinline__ u32x4 pk8_bf16(const f32x4& a, const f32x4& b) { u32x4 w; w.x = pk_bf16(a[0], a[1]); w.y = pk_bf16(a[2], a[3]); w.z = pk_bf16(b[0], b[1]); w.w = pk_bf16(b[2], b[3]); return w; }
struct FStoreF32 { static constexpr bool W8 = false; float* C; int ldc;
    __device__ __forceinline__ void operator()(int row, int col, f32x4 v) const { *(f32x4*)(C + (size_t)row * ldc + col) = v; } };
struct FStoreBf16 { static constexpr bool W8 = true; bf16_t* O; int ldc;
    __device__ __forceinline__ void operator()(int row, int col, f32x4 v, f32x4 v2) const { *(u32x4*)(O + (size_t)row * ldc + col) = pk8_bf16(v, v2); } };
struct FStoreBf16RowBias { static constexpr bool W8 = true; bf16_t* O; int ldc; const float* bias;
    __device__ __forceinline__ void operator()(int row, int col, f32x4 v, f32x4 v2) const { const float b = bias[row]; *(u32x4*)(O + (size_t)row * ldc + col) = pk8_bf16(v + b, v2 + b); } };
struct FResidIn { static constexpr bool W8 = true; const float* xc; const float* xl; bf16_t* X; const float* gate;
    __device__ __forceinline__ void operator()(int row, int col, f32x4 v, f32x4 v2) const {
        const float* xr = (row < TC ? xc + (size_t)row * D : xl + (size_t)(row - TC) * D) + col; const float* gp = gate + (size_t)cond_of(row) * 4 * 12288 + col;
        *(u32x4*)(X + (size_t)row * D + col) = pk8_bf16(*(const f32x4*)xr + *(const f32x4*)gp * v, *(const f32x4*)(xr + 4) + *(const f32x4*)(gp + 4) * v2); } };
struct FResid { static constexpr bool W8 = true; bf16_t* X; const float* gate;
    __device__ __forceinline__ void operator()(int row, int col, f32x4 v, f32x4 v2) const {
        bf16_t* xp = X + (size_t)row * D + col; const float* gp = gate + (size_t)cond_of(row) * 4 * 12288 + col; const u32x4 x = *(const u32x4*)xp;
        const f32x4 x0 = {bf_lo(x.x), bf_hi(x.x), bf_lo(x.y), bf_hi(x.y)}, x1 = {bf_lo(x.z), bf_hi(x.z), bf_lo(x.w), bf_hi(x.w)};
        *(u32x4*)xp = pk8_bf16(x0 + *(const f32x4*)gp * v, x1 + *(const f32x4*)(gp + 4) * v2); } };
__device__ __forceinline__ void rope8(f32x4& v, f32x4& v2, const float* cs, int soff, int f0) {
    const f32x4 c = *(const f32x4*)(cs + f0), s = *(const f32x4*)(cs + soff + f0);
    const float a0 = v[0], b0 = v[1], a1 = v[2], b1 = v[3], a2 = v2[0], b2 = v2[1], a3 = v2[2], b3 = v2[3];
    v[0] = a0 * c[0] - b0 * s[0]; v[1] = a0 * s[0] + b0 * c[0]; v[2] = a1 * c[1] - b1 * s[1]; v[3] = a1 * s[1] + b1 * c[1];
    v2[0] = a2 * c[2] - b2 * s[2]; v2[1] = a2 * s[2] + b2 * c[2]; v2[2] = a3 * c[3] - b3 * s[3]; v2[3] = a3 * s[3] + b3 * c[3];
}
struct FMlaQ { static constexpr bool W8 = true; bf16_t* Q; const float* rope;
    __device__ __forceinline__ void operator()(int row, int col, f32x4 v, f32x4 v2) const {
        const int r = col % 192;
        if (r >= 128 && row >= TC) {
            const int l = (row - TC) & 2047, p = r - 128, pi = p >> 1, a = pi >> 4, f = pi & 15, pos = a ? (l & 63) : (l >> 6);
            rope8(v, v2, rope + pos * 16, 1024, f);
        }
        *(u32x4*)(Q + (size_t)row * 3072 + col) = pk8_bf16(v, v2); } };
struct FS5Gate { static constexpr bool W8 = true; const bf16_t* Z; bf16_t* ZZ;
    __device__ __forceinline__ void operator()(int row, int col, f32x4 v, f32x4 v2) const {
        const u32x4 z = *(const u32x4*)(Z + (size_t)row * D + col);
        f32x4 o, o2;
        o[0] = bf_lo(z.x) / (1.f + __expf(-v[0])); o[1] = bf_hi(z.x) / (1.f + __expf(-v[1])); o[2] = bf_lo(z.y) / (1.f + __expf(-v[2])); o[3] = bf_hi(z.y) / (1.f + __expf(-v[3]));
        o2[0] = bf_lo(z.z) / (1.f + __expf(-v2[0])); o2[1] = bf_hi(z.z) / (1.f + __expf(-v2[1])); o2[2] = bf_lo(z.w) / (1.f + __expf(-v2[2])); o2[3] = bf_hi(z.w) / (1.f + __expf(-v2[3]));
        *(u32x4*)(ZZ + (size_t)row * D + col) = pk8_bf16(o, o2); } };
struct FSwaQK { static constexpr bool W8 = true; bf16_t* Q; bf16_t* KALL; float* outk; const float* rope;
    __device__ __forceinline__ void operator()(int row, int col, f32x4 v, f32x4 v2) const {
        const int p = col & 127, pi = p >> 1, a = pi >> 5, f = pi & 31;
        if (row >= TC) {
            const int l = (row - TC) & 2047, pos = a ? (l & 63) : (l >> 6);
            rope8(v, v2, rope + pos * 32, 2048, f);
        }
        const u32x4 w = pk8_bf16(v, v2);
        if (col < 2048) *(u32x4*)(Q + (size_t)row * D + col) = w;
        else {
            const int kc = col - 2048;
            *(u32x4*)(KALL + (size_t)keyrow_of(row) * 512 + kc) = w;
            if (row < TC) { float* o = outk + (size_t)row * 512 + (kc & ~127) + 64 * a + f;
                f32x4 e, od; e[0] = v[0]; e[1] = v[2]; e[2] = v2[0]; e[3] = v2[2]; od[0] = v[1]; od[1] = v[3]; od[2] = v2[1]; od[3] = v2[3];
                *(f32x4*)o = e; *(f32x4*)(o + 32) = od; }
        } } };
struct FSwaVT { static constexpr bool W8 = true; bf16_t* VT; float* outv;
    __device__ __forceinline__ void operator()(int row, int col, f32x4 v, f32x4 v2) const {
        *(u32x4*)(VT + (size_t)row * NKEY + keyrow_of(col)) = pk8_bf16(v, v2);
        if (col < TC) { float* o = outv + (size_t)col * 512 + row; o[0] = v[0]; o[512] = v[1]; o[1024] = v[2]; o[1536] = v[3]; o[2048] = v2[0]; o[2560] = v2[1]; o[3072] = v2[2]; o[3584] = v2[3]; } } };

struct FStoreBf16Scaled { static constexpr bool W8 = true; bf16_t* O; int ldc; const float* sa; const float* sb;
    __device__ __forceinline__ void operator()(int row, int col, f32x4 v, f32x4 v2) const { const float a = sa[row]; const f32x4 b = *(const f32x4*)(sb + col), b2 = *(const f32x4*)(sb + col + 4);
        *(u32x4*)(O + (size_t)row * ldc + col) = pk8_bf16(v * a * b, v2 * a * b2); } };
template <class F> __device__ __forceinline__ void run_gemm_i8_tok(LDSP unsigned char* lds, const void* A8, const void* B8, int Kb, const F& f) {
    pg8::Gemm g{(const bf16_t*)A8, (const bf16_t*)B8, T, D, Kb / 2}; pg8::EpiSel<F> E{f};
    pg8::HalfOrder S; S.init(TL, T, D, (int)gridDim.x, (int)blockIdx.x); pg8::gemm_phase<pg8::EpiSel<F>, pg8::HalfOrder, true, true, true>(lds, g, S, E);
}
template <class F> __device__ __forceinline__ void run_gemm_i8(LDSP unsigned char* lds, const void* A8, const void* B8, int M, int N, int Kb, const F& f) {
    pg8::Gemm g{(const bf16_t*)A8, (const bf16_t*)B8, M, N, Kb / 2}; pg8::StaticOrder S; S.init(M, N, (int)gridDim.x, (int)blockIdx.x);
    pg8::EpiSel<F> E{f};
    pg8::gemm_phase<pg8::EpiSel<F>, pg8::StaticOrder, true, true, true>(lds, g, S, E);
}
template <class F> __device__ __forceinline__ void run_gemm_tok(LDSP unsigned char* lds, const bf16_t* A, const bf16_t* Bt, int K, const F& f) {
    pg8::Gemm g{A, Bt, T, D, K}; pg8::EpiSel<F> E{f};
    pg8::HalfOrder S; S.init(TL, T, D, (int)gridDim.x, (int)blockIdx.x); pg8::gemm_phase<pg8::EpiSel<F>, pg8::HalfOrder, true, true>(lds, g, S, E);
}
template <class F> __device__ __forceinline__ void run_gemm_tailhalf(LDSP unsigned char* lds, const bf16_t* A, const bf16_t* Bt, int M, int N, int K, const F& f) {
    const int nwg = (M / pg8::BM) * (N / pg8::BM), G = (int)gridDim.x, rem = nwg % G;
    const int nh = (rem * 2 == G && nwg % 8 == 0 && (G / 2) % 8 == 0) ? G / 2 : 0;
    pg8::Gemm g{A, Bt, M, N, K}; pg8::TailHalfOrder S; S.init(M, N, nh, G, (int)blockIdx.x);
    pg8::EpiSel<F> E{f};
    pg8::gemm_phase<pg8::EpiSel<F>, pg8::TailHalfOrder, true, true>(lds, g, S, E);
}
template <class F> __device__ __forceinline__ void run_gemm(LDSP unsigned char* lds, const bf16_t* A, const bf16_t* Bt, int M, int N, int K, const F& f, int rot = 0) {
    pg8::Gemm g{A, Bt, M, N, K}; pg8::StaticOrder S; S.init(M, N, (int)gridDim.x, (int)((blockIdx.x + gridDim.x - rot) % gridDim.x));
    pg8::EpiSel<F> E{f};
    pg8::gemm_phase<pg8::EpiSel<F>, pg8::StaticOrder, true, true>(lds, g, S, E);
}
#define XB_TMO      128
#define XB_XCNT(j)  (256  + 64 * (j))
#define XB_XSUB(j)  (1280 + 64 * (j))
#define XB_XGEN(j)  (2304 + 64 * (j))
#define XB_TOP      3328
#define XB_TOPGEN   3392
#define XCD_BAR_WORDS 3456
#define XB_SPIN_CAP (1u << 22)
#define LAS __attribute__((address_space(3)))

__device__ __forceinline__ unsigned xb_ld(unsigned* p)              { return __hip_atomic_load(p, __ATOMIC_RELAXED, __HIP_MEMORY_SCOPE_AGENT); }
__device__ __forceinline__ unsigned xb_add(unsigned* p, unsigned v) { return __hip_atomic_fetch_add(p, v, __ATOMIC_RELAXED, __HIP_MEMORY_SCOPE_AGENT); }
__device__ __forceinline__ unsigned xb_xcc_id() { return (unsigned)__builtin_amdgcn_s_getreg((3 << 11) | 20) & 0xFu; }
#define XB_SPIN(cond, bar) do { unsigned _sp = 0; while (cond) { __builtin_amdgcn_s_sleep(1); \
    if ((++_sp & 255u) == 0u) { if (xb_ld(&(bar)[XB_TMO])) break; if (_sp > XB_SPIN_CAP) { atomicAdd(&(bar)[XB_TMO], 1u); break; } } } } while (0)

struct XcdBarrier {
    unsigned* bar; unsigned x;
    volatile LAS unsigned* st;
};

__device__ __forceinline__ XcdBarrier xcd_barrier_post(unsigned* bar, volatile LAS unsigned* st) {
    XcdBarrier b; b.bar = bar; b.x = xb_xcc_id(); b.st = st;
    if (threadIdx.x == 0) (void)xb_add(&bar[XB_XCNT(b.x)], 1u);
    return b;
}
__device__ __forceinline__ void xcd_barrier_complete(unsigned* bar, unsigned x, unsigned& nloc, unsigned& nx) {
    const unsigned G = gridDim.x * gridDim.y * gridDim.z;
    unsigned sum, cnt, mine, sp = 0u;
    for (;;) {
        sum = 0u; cnt = 0u; mine = 0u;
#pragma unroll
        for (unsigned j = 0; j < 16; ++j) { const unsigned c = xb_ld(&bar[XB_XCNT(j)]); sum += c; cnt += (c > 0u) ? 1u : 0u; mine = (j == x) ? c : mine; }
        if (sum == G) break;
        __builtin_amdgcn_s_sleep(1);
        if ((++sp & 255u) == 0u) { if (xb_ld(&bar[XB_TMO])) break; if (sp > XB_SPIN_CAP) { atomicAdd(&bar[XB_TMO], 1u); break; } }
    }
    nloc = mine > 0u ? mine : 1u; nx = cnt > 0u ? cnt : 1u;
}

__device__ __forceinline__ void xcd_barrier(const XcdBarrier& b) {
    asm volatile("s_waitcnt vmcnt(0)" ::: "memory");
    __syncthreads();
    if (threadIdx.x == 0) {
        unsigned* bar = b.bar;
        __builtin_amdgcn_s_waitcnt(0);
        unsigned nloc = b.st[0], nx = b.st[1];
        if (nloc == 0u) { xcd_barrier_complete(bar, b.x, nloc, nx); b.st[0] = nloc; b.st[1] = nx; }
        const unsigned old = xb_add(&bar[XB_XSUB(b.x)], 1u);
        const unsigned gen = old / nloc;
        if (old + 1u == (gen + 1u) * nloc) {
            __builtin_amdgcn_fence(__ATOMIC_RELEASE, "agent");
            asm volatile("s_waitcnt vmcnt(0)" ::: "memory");
            const unsigned og = xb_add(&bar[XB_TOP], 1u);
            const unsigned tg = og / nx;
            if (og + 1u == (tg + 1u) * nx) xb_add(&bar[XB_TOPGEN], 1u);
            else XB_SPIN(xb_ld(&bar[XB_TOPGEN]) == tg, bar);
            __builtin_amdgcn_fence(__ATOMIC_ACQUIRE, "agent");
            xb_add(&bar[XB_XGEN(b.x)], 1u);
            asm volatile("s_waitcnt vmcnt(0)" ::: "memory");
        } else {
            XB_SPIN(xb_ld(&bar[XB_XGEN(b.x)]) == gen, bar);
            __builtin_amdgcn_fence(__ATOMIC_ACQUIRE, "agent");
            asm volatile("s_waitcnt vmcnt(0)" ::: "memory");
        }
    }
    __syncthreads();
}

__device__ __forceinline__ int src_col(int mode, int n) {
    if (mode == 1) { const int h = n / 192, r = n % 192; if (r < 128) return n; const int p = r - 128, pi = p >> 1, a = pi >> 4, f = pi & 15; return h * 192 + 128 + 32 * a + f + 16 * (p & 1); }
    if (mode == 2) return (n >> 7) * 256 + (n & 127);
    if (mode == 3) return (n >> 7) * 256 + 128 + (n & 127);
    if (mode == 4) { if (n >= 2560) return n; const int h = n >> 7, p = n & 127, pi = p >> 1, a = pi >> 5, f = pi & 31; return h * 128 + 64 * a + f + 32 * (p & 1); }
    return n;
}
struct CvtJob { int in_idx; unsigned src_off; size_t dst_off; int K, ldsrc, nvalid, nrows, mode; };
__device__ __forceinline__ void cvt_transpose_all(LDSP float* tile, const float* const* in, unsigned char* ws) {
    const CvtJob jobs[12] = {
        {I_MWDOWN, 0u, WS_WDOWN, 2048, 1088, 1088, 1280, 0}, {I_MWUQ, 0u, WS_WUQ, 512, 3072, 3072, 3072, 1}, {I_MWUKV, 0u, WS_WUK, 512, 4096, 2048, 2048, 2}, {I_MWUKV, 0u, WS_WUV, 512, 4096, 2048, 2048, 3},
        {I_MWO, 0u, WS_WOMLA, 2048, 2048, 2048, 2048, 0}, {I_S5WIN, 0u, WS_S5IN, 2048, 2048, 2048, 2048, 0}, {I_S5WG, 0u, WS_S5GATE, 2048, 2048, 2048, 2048, 0}, {I_S5WO, 0u, WS_S5OUT, 2048, 2048, 2048, 2048, 0},
        {I_HWIN, 0u, WS_HYIN, 2048, 6144, 6144, 6144, 0}, {I_HWOUT, 0u, WS_HYOUT, 2048, 2048, 2048, 2048, 0}, {I_SWQKV, 0u, WS_SWAQKV, 2048, 3072, 3072, 3072, 4}, {I_SWO, 0u, WS_SWAO, 2048, 2048, 2048, 2048, 0} };
    const int tid = threadIdx.x;
    int total = 0;
#pragma unroll
    for (int j = 0; j < 12; ++j) total += (jobs[j].nrows >> 6) * (jobs[j].K >> 6);
    float r[8];
#define CT_DECODE(t_, src_, dst_, K_, n0_, k0_) do { int rem_ = (t_); int ji_ = 0; \
        _Pragma("unroll") for (int j_ = 0; j_ < 11; ++j_) { const int nt_ = (jobs[j_].nrows >> 6) * (jobs[j_].K >> 6); if (ji_ == j_ && rem_ >= nt_) { rem_ -= nt_; ji_ = j_ + 1; } } \
        int in_idx_ = 0, ldsrc_ = 0, nvalid_ = 0, nrows_ = 64, mode_ = 0; unsigned so_ = 0; size_t do_ = 0; K_ = 64; \
        _Pragma("unroll") for (int j_ = 0; j_ < 12; ++j_) if (ji_ == j_) { in_idx_ = jobs[j_].in_idx; so_ = jobs[j_].src_off; do_ = jobs[j_].dst_off; K_ = jobs[j_].K; ldsrc_ = jobs[j_].ldsrc; nvalid_ = jobs[j_].nvalid; nrows_ = jobs[j_].nrows; mode_ = jobs[j_].mode; } \
        const int tn_ = nrows_ >> 6; n0_ = (rem_ % tn_) << 6; k0_ = (rem_ / tn_) << 6; dst_ = (bf16_t*)(ws + do_); \
        const int n_ = n0_ + (tid & 63); const bool valid_ = n_ < nvalid_; const int sc_ = valid_ ? src_col(mode_, n_) : 0; \
        src_ = valid_ ? in[in_idx_] + so_ + (size_t)(k0_ + (tid >> 6)) * ldsrc_ + sc_ : nullptr; ldr_ = ldsrc_; } while (0)
    int t = blockIdx.x;
    const float* src = nullptr; bf16_t* dst = nullptr; int K = 64, n0 = 0, k0 = 0, ldr_ = 0;
    float rb[8]; bf16_t* dstb = nullptr; int Kb = 64, n0b = 0, k0b = 0;
#define CT_LOAD(reg_) do { _Pragma("unroll") for (int i = 0; i < 8; ++i) reg_[i] = src ? src[(size_t)(8 * i) * ldr_] : 0.f; } while (0)
    if (t < total) { CT_DECODE(t, src, dst, K, n0, k0); CT_LOAD(r); }
    if (t + (int)gridDim.x < total) { CT_DECODE(t + (int)gridDim.x, src, dstb, Kb, n0b, k0b); CT_LOAD(rb); }
    for (; t < total; t += gridDim.x) {
#pragma unroll
        for (int i = 0; i < 8; ++i) tile[((tid >> 6) + 8 * i) * 65 + (tid & 63)] = r[i];
        bf16_t* cdst = dst; const int cK = K, cn0 = n0, ck0 = k0;
#pragma unroll
        for (int i = 0; i < 8; ++i) r[i] = rb[i];
        dst = dstb; K = Kb; n0 = n0b; k0 = k0b;
        const int tn = t + 2 * (int)gridDim.x;
        if (tn < total) { CT_DECODE(tn, src, dstb, Kb, n0b, k0b); CT_LOAD(rb); }
        __syncthreads();
        { const int nn = tid >> 3, kq = tid & 7; float v[8];
#pragma unroll
          for (int j = 0; j < 8; ++j) v[j] = tile[(kq * 8 + j) * 65 + nn];
          u32x4 w; w.x = pk_bf16(v[0], v[1]); w.y = pk_bf16(v[2], v[3]); w.z = pk_bf16(v[4], v[5]); w.w = pk_bf16(v[6], v[7]);
          *(u32x4*)(cdst + (size_t)(cn0 + nn) * cK + ck0 + kq * 8) = w; }
        __syncthreads();
    }
#undef CT_LOAD
#undef CT_DECODE
}
__device__ __forceinline__ void cvt_transpose_i8(LDSP unsigned char* lds, const float* __restrict__ src, unsigned char* __restrict__ dst8, float* __restrict__ wscale, int nmat) {
    LDSP float* tile = (LDSP float*)lds; LDSP float* red = tile + 64 * 65; LDSP float* inv = red + 512;
    const int tid = threadIdx.x, nn = tid & 63, kg = tid >> 6;
    for (int strip = blockIdx.x; strip < nmat * 32; strip += gridDim.x) {
        const int mat = strip >> 5, n0 = (strip & 31) * 64;
        const float* sm = src + (size_t)mat * 2048 * 2048 + n0;
        float mx = 0.f;
        for (int i = 0; i < 256; i += 8) {
            float v[8];
#pragma unroll
            for (int u = 0; u < 8; ++u) v[u] = sm[(size_t)(kg + 8 * (i + u)) * 2048 + nn];
#pragma unroll
            for (int u = 0; u < 8; ++u) mx = fmaxf(mx, fabsf(v[u]));
        }
        red[kg * 64 + nn] = mx;
        __syncthreads();
        if (tid < 64) { float m = red[tid];
#pragma unroll
            for (int g = 1; g < 8; ++g) m = fmaxf(m, red[g * 64 + tid]);
            inv[tid] = m > 0.f ? 127.f / m : 1.f; wscale[mat * 2048 + n0 + tid] = m > 0.f ? m / 127.f : 1.f; }
        __syncthreads();
        for (int k0 = 0; k0 < 2048; k0 += 64) {
#pragma unroll
            for (int i = 0; i < 8; ++i) { const int kk = kg + 8 * i; tile[kk * 65 + nn] = sm[(size_t)(k0 + kk) * 2048 + nn]; }
            __syncthreads();
            { const int n2 = tid >> 3, kq = tid & 7; const float s = inv[n2]; int q[8];
#pragma unroll
              for (int j = 0; j < 8; ++j) q[j] = (int)rintf(tile[(kq * 8 + j) * 65 + n2] * s);
              u32x2 w; w.x = (unsigned)(q[0] & 255) | ((unsigned)(q[1] & 255) << 8) | ((unsigned)(q[2] & 255) << 16) | ((unsigned)(q[3] & 255) << 24);
              w.y = (unsigned)(q[4] & 255) | ((unsigned)(q[5] & 255) << 8) | ((unsigned)(q[6] & 255) << 16) | ((unsigned)(q[7] & 255) << 24);
              *(u32x2*)(dst8 + ((size_t)mat * 2048 + n0 + n2) * 2048 + k0 + kq * 8) = w; }
            __syncthreads();
        }
    }
}
__device__ __forceinline__ void cvt_direct(const float* __restrict__ src, bf16_t* __restrict__ dst, size_t n) {
    const size_t ng = n >> 3, stride = (size_t)gridDim.x * NTH;
    for (size_t g = (size_t)blockIdx.x * NTH + threadIdx.x; g < ng; g += stride) {
        const f32x4 a = __builtin_nontemporal_load((const f32x4*)(src + g * 8)), b = __builtin_nontemporal_load((const f32x4*)(src + g * 8 + 4));
        u32x4 w; w.x = pk_bf16(a[0], a[1]); w.y = pk_bf16(a[2], a[3]); w.z = pk_bf16(b[0], b[1]); w.w = pk_bf16(b[2], b[3]);
        *(u32x4*)(dst + g * 8) = w;
    }
}
__device__ __forceinline__ void mod_phase(LDSP unsigned char* lds, const float* __restrict__ c_ctx, const float* __restrict__ c, const float* __restrict__ mod_w, const float* __restrict__ mod_b, float* __restrict__ mod) {
    LDSP float* act = (LDSP float*)lds;
    LDSP f32x4* red = (LDSP f32x4*)(lds + 73728);
    const int tid = threadIdx.x, lane = tid & 63, wave = tid >> 6;
    if ((int)blockIdx.x >= 192) return;
    for (int i = tid; i < 9 * 2048; i += NTH) { const int ci = i >> 11, k = i & 2047; const float x = ci == 0 ? c_ctx[k] : c[(ci - 1) * 2048 + k]; act[i] = x / (1.f + __expf(-x)); }
    __syncthreads();
    for (int item = blockIdx.x; item < 192; item += gridDim.x) {
        const int layer = item / 48, n0 = (item % 48) * 256;
        const float* wp = mod_w + ((size_t)layer * 2048 + wave) * 12288 + n0 + 4 * lane;
        f32x4 acc[9];
#pragma unroll
        for (int ci = 0; ci < 9; ++ci) acc[ci] = (f32x4){0.f, 0.f, 0.f, 0.f};
        for (int kk = 0; kk < 256; kk += 16) {
            f32x4 w[16];
#pragma unroll
            for (int u = 0; u < 16; ++u) w[u] = __builtin_nontemporal_load((const f32x4*)(wp + (size_t)(8 * (kk + u)) * 12288));
#pragma unroll
            for (int u = 0; u < 16; ++u)
#pragma unroll
                for (int ci = 0; ci < 9; ++ci) acc[ci] += act[ci * 2048 + wave + 8 * (kk + u)] * w[u];
        }
#pragma unroll
        for (int half = 4; half >= 1; half >>= 1) {
            if (wave >= half && wave < 2 * half) {
#pragma unroll
                for (int ci = 0; ci < 9; ++ci) red[((wave - half) * 9 + ci) * 64 + lane] = acc[ci]; }
            __syncthreads();
            if (wave < half) {
#pragma unroll
                for (int ci = 0; ci < 9; ++ci) acc[ci] += red[(wave * 9 + ci) * 64 + lane]; }
            __syncthreads();
        }
        if (wave == 0) { const f32x4 bb = *(const f32x4*)(mod_b + layer * 12288 + n0 + 4 * lane);
#pragma unroll
            for (int ci = 0; ci < 9; ++ci) *(f32x4*)(mod + ((size_t)ci * 4 + layer) * 12288 + n0 + 4 * lane) = acc[ci] + bb; }
    }
}
__device__ __forceinline__ void rope_tables(float* rt) {
    const int i = blockIdx.x * NTH + threadIdx.x;
    if (i < 1024) { const int pos = i >> 4, f = i & 15; const float ang = (float)pos * powf(10000.f, -(float)(2 * f) / 32.f); rt[i] = cosf(ang); rt[1024 + i] = sinf(ang); }
    else if (i < 1024 + 2048) { const int j = i - 1024, pos = j >> 5, f = j & 31; const float ang = (float)pos * powf(10000.f, -(float)(2 * f) / 64.f); rt[2048 + j] = cosf(ang); rt[4096 + j] = sinf(ang); }
}
__device__ __forceinline__ void hy_filter_phase(LDSP unsigned char* lds, const float* __restrict__ w1, const float* __restrict__ b1, const float* __restrict__ freq, const float* __restrict__ w2, const float* __restrict__ b2,
                                                const float* __restrict__ w3, const float* __restrict__ log_decay, bf16_t* __restrict__ F) {
    LDSP float* z1 = (LDSP float*)lds; LDSP float* z2 = z1 + 8 * 64;
    const int tid = threadIdx.x;
    for (int u = blockIdx.x; u < 576; u += gridDim.x) {
        const int dirn = u & 1, lc = u >> 1, grp = lc >= 32, L = grp ? 2048 : 256, l0 = (grp ? lc - 32 : lc) * 8;
        bf16_t* Fg = F + (grp ? (size_t)2 * 2048 * 512 : 0);
        const float invL = 1.f / (float)L;
        { const int li = tid >> 6, j = tid & 63, l = l0 + dirn + li; float v = 0.f;
            if (l < L) { const float t = (float)l * invL; float s = b1[j] + t * w1[j];
                for (int k = 1; k <= 8; ++k) { const float ang = 6.283185307179586f * t * (float)k; s += sinf(ang) * w1[k * 64 + j] + cosf(ang) * w1[(8 + k) * 64 + j]; }
                v = sinf(freq[j] * s); }
            z1[tid] = v; }
        __syncthreads();
        { const int li = tid >> 6, j = tid & 63, l = l0 + dirn + li; float v = 0.f;
            if (l < L) { float s = b2[j]; for (int i = 0; i < 64; ++i) s += z1[li * 64 + i] * w2[i * 64 + j]; v = sinf(freq[64 + j] * s); }
            z2[tid] = v; }
        __syncthreads();
        float acc[8][8];
#pragma unroll
        for (int jj = 0; jj < 8; ++jj)
#pragma unroll
            for (int r = 0; r < 8; ++r) acc[jj][r] = 0.f;
        const float* wb = w3 + 4096 * dirn + tid;
        float wa[8], wbn[8];
#pragma unroll
        for (int jj = 0; jj < 8; ++jj) { wa[jj] = wb[512 * jj]; wbn[jj] = wb[8192 + 512 * jj]; }
        for (int i = 0; i < 64; i += 2) {
            float wc[8], wd[8];
#pragma unroll
            for (int jj = 0; jj < 8; ++jj) { wc[jj] = wa[jj]; wd[jj] = wbn[jj]; }
            { const int i2 = i + 2 < 64 ? i + 2 : i, i3 = i + 3 < 64 ? i + 3 : i;
#pragma unroll
              for (int jj = 0; jj < 8; ++jj) { wa[jj] = wb[(size_t)i2 * 8192 + 512 * jj]; wbn[jj] = wb[(size_t)i3 * 8192 + 512 * jj]; } }
            float zr[8], zs[8];
#pragma unroll
            for (int r = 0; r < 8; ++r) { zr[r] = z2[r * 64 + i]; zs[r] = z2[r * 64 + i + 1]; }
#pragma unroll
            for (int jj = 0; jj < 8; ++jj)
#pragma unroll
                for (int r = 0; r < 8; ++r) acc[jj][r] += zr[r] * wc[jj] + zs[r] * wd[jj];
        }
#pragma unroll
        for (int jj = 0; jj < 8; ++jj) {
            const int col = 4096 * dirn + tid + 512 * jj, o = (col >> 11) & 1, d = col & 2047;
            const float dec = __expf(log_decay[(dirn * 2 + o) * 2048 + d]);
            float vals[8];
#pragma unroll
            for (int r = 0; r < 8; ++r) vals[r] = acc[jj][r] * __expf(-((float)(l0 + r + dirn) * invL) * dec);
            bf16_t* dst = Fg + ((size_t)o * 2048 + d) * (size_t)(2 * L);
            u32x4 w;
            if (dirn == 0) { w.x = pk_bf16(vals[7], vals[6]); w.y = pk_bf16(vals[5], vals[4]); w.z = pk_bf16(vals[3], vals[2]); w.w = pk_bf16(vals[1], vals[0]); *(u32x4*)(dst + L - l0 - 8) = w; }
            else { w.x = pk_bf16(vals[0], vals[1]); w.y = pk_bf16(vals[2], vals[3]); w.z = pk_bf16(vals[4], vals[5]); w.w = pk_bf16(vals[6], vals[7]); *(u32x4*)(dst + L + l0) = w; }
        }
        __syncthreads();
    }
}

#define NP_COL(i_) (512 * ((i_) >> 1) + 8 * lane + 4 * ((i_) & 1))
template <bool XBF> __device__ __forceinline__ void np_load(f32x4 (&dst)[8], const float* xc, const float* xl, const bf16_t* X, int row, int lane) {
    if (XBF) { const bf16_t* xr = X + (size_t)row * D;
#pragma unroll
        for (int p = 0; p < 4; ++p) { const u32x4 x = *(const u32x4*)(xr + 512 * p + 8 * lane); dst[2 * p] = (f32x4){bf_lo(x.x), bf_hi(x.x), bf_lo(x.y), bf_hi(x.y)}; dst[2 * p + 1] = (f32x4){bf_lo(x.z), bf_hi(x.z), bf_lo(x.w), bf_hi(x.w)}; }
    } else { const float* xr = row < TC ? xc + (size_t)row * D : xl + (size_t)(row - TC) * D;
#pragma unroll
        for (int i = 0; i < 8; ++i) dst[i] = *(const f32x4*)(xr + NP_COL(i)); }
}
__device__ __forceinline__ void np_raw(u32x4 (&q)[4], const bf16_t* X, int row, int lane) {
#pragma unroll
    for (int p = 0; p < 4; ++p) q[p] = *(const u32x4*)(X + (size_t)row * D + 512 * p + 8 * lane);
}
__device__ __forceinline__ void np_unpack(f32x4 (&dst)[8], const u32x4 (&q)[4]) {
#pragma unroll
    for (int p = 0; p < 4; ++p) { const u32x4 x = q[p]; dst[2 * p] = (f32x4){bf_lo(x.x), bf_hi(x.x), bf_lo(x.y), bf_hi(x.y)}; dst[2 * p + 1] = (f32x4){bf_lo(x.z), bf_hi(x.z), bf_lo(x.w), bf_hi(x.w)}; }
}
template <bool XBF> __device__ __forceinline__ void norm_phase(const float* __restrict__ xc, const float* __restrict__ xl, const bf16_t* __restrict__ X, const float* __restrict__ gain, const float* __restrict__ mp, bf16_t* __restrict__ H, unsigned* __restrict__ X8 = nullptr, float* __restrict__ SX = nullptr) {
    const int lane = threadIdx.x & 63, gw = blockIdx.x * 8 + (threadIdx.x >> 6), nw = gridDim.x * 8, per = (T + nw - 1) / nw;
    const int r0 = gw * per, r1 = r0 + per < T ? r0 + per : T;
    if (r0 >= r1) return;
    f32x4 ca[8], cb[8], v[8], vn[8]; int ccur = -1; u32x4 qn[4];
    if (XBF) np_raw(qn, X, r0, lane); else np_load<false>(vn, xc, xl, X, r0, lane);
    for (int row = r0; row < r1; ++row) {
        if (XBF) np_unpack(v, qn);
        else {
#pragma unroll
            for (int i = 0; i < 8; ++i) v[i] = vn[i]; }
#pragma unroll
        for (int i = 0; i < 8; ++i) asm volatile("" : "+v"(v[i]));
        const int cnd = cond_of(row);
        if (cnd != ccur) { ccur = cnd; const float* m = mp + (size_t)cnd * 4 * 12288;
#pragma unroll
            for (int i = 0; i < 8; ++i) { const int col = NP_COL(i); ca[i] = *(const f32x4*)(gain + col) * (*(const f32x4*)(m + 2048 + col) + 1.f); cb[i] = *(const f32x4*)(m + col); }
#pragma unroll
            for (int i = 0; i < 8; ++i) asm volatile("" : "+v"(ca[i]), "+v"(cb[i]));
        }
        if (row + 1 < r1) { if (XBF) np_raw(qn, X, row + 1, lane); else np_load<false>(vn, xc, xl, X, row + 1, lane); }
        float ss = 0.f;
#pragma unroll
        for (int i = 0; i < 8; ++i) ss += v[i][0] * v[i][0] + v[i][1] * v[i][1] + v[i][2] * v[i][2] + v[i][3] * v[i][3];
        ss = wave_sum(ss);
        const float rstd = rsqrtf(ss * (1.f / 2048.f) + 1e-6f);
        float amax = 0.f;
#pragma unroll
        for (int i = 0; i < 8; ++i) { const f32x4 y = v[i] * rstd * ca[i] + cb[i]; v[i] = y;
            amax = fmaxf(amax, fmaxf(fmaxf(fabsf(y[0]), fabsf(y[1])), fmaxf(fabsf(y[2]), fabsf(y[3])))); }
        if (H) {
#pragma unroll
            for (int p = 0; p < 4; ++p) *(u32x4*)(H + (size_t)row * D + 512 * p + 8 * lane) = pk8_bf16(v[2 * p], v[2 * p + 1]); }
        if (X8) {
            amax = fmaxf(amax, __shfl_xor(amax, 32)); amax = fmaxf(amax, __shfl_xor(amax, 16)); amax = fmaxf(amax, __shfl_xor(amax, 8)); amax = fmaxf(amax, __shfl_xor(amax, 4)); amax = fmaxf(amax, __shfl_xor(amax, 2)); amax = fmaxf(amax, __shfl_xor(amax, 1));
            const float qs = amax > 0.f ? 127.f / amax : 1.f;
#pragma unroll
            for (int p = 0; p < 4; ++p) { u32x2 w;
#pragma unroll
                for (int h = 0; h < 2; ++h) { const f32x4 y = v[2 * p + h]; const int q0 = (int)rintf(y[0] * qs), q1 = (int)rintf(y[1] * qs), q2 = (int)rintf(y[2] * qs), q3 = (int)rintf(y[3] * qs);
                    w[h] = (unsigned)(q0 & 255) | ((unsigned)(q1 & 255) << 8) | ((unsigned)(q2 & 255) << 16) | ((unsigned)(q3 & 255) << 24); }
                *(u32x2*)(X8 + (size_t)row * 512 + 128 * p + 2 * lane) = w; }
            if (lane == 0) SX[row] = amax > 0.f ? amax / 127.f : 1.f;
        }
    }
}
__device__ __forceinline__ void final_norm_phase(const bf16_t* __restrict__ X, const float* __restrict__ gain, float* __restrict__ out) {
    const int lane = threadIdx.x & 63, gw = blockIdx.x * 8 + (threadIdx.x >> 6), nw = gridDim.x * 8, per = (T + nw - 1) / nw;
    const int r0 = gw * per, r1 = r0 + per < T ? r0 + per : T;
    if (r0 >= r1) return;
    f32x4 g[8], v[8]; u32x4 qn[4];
#pragma unroll
    for (int i = 0; i < 8; ++i) g[i] = *(const f32x4*)(gain + NP_COL(i));
    np_raw(qn, X, r0, lane);
    for (int row = r0; row < r1; ++row) {
        np_unpack(v, qn); if (row + 1 < r1) np_raw(qn, X, row + 1, lane);
        float ss = 0.f;
#pragma unroll
        for (int i = 0; i < 8; ++i) ss += v[i][0] * v[i][0] + v[i][1] * v[i][1] + v[i][2] * v[i][2] + v[i][3] * v[i][3];
        ss = wave_sum(ss);
        const float rstd = rsqrtf(ss * (1.f / 2048.f) + 1e-6f);
#pragma unroll
        for (int i = 0; i < 8; ++i) *(f32x4*)(out + (size_t)row * D + NP_COL(i)) = v[i] * rstd * g[i];
    }
}
#undef NP_COL

__device__ __forceinline__ void mla_rows_phase(const bf16_t* __restrict__ DOWN, const float* __restrict__ g_q, const float* __restrict__ g_kv, const float* __restrict__ cache_ckv, const float* __restrict__ cache_kpe,
                                               const float* __restrict__ rope, bf16_t* __restrict__ CQ, bf16_t* __restrict__ CKV, bf16_t* __restrict__ KPE, float* __restrict__ out_ckv, float* __restrict__ out_kpe) {
    const int lane = threadIdx.x & 63, gw = blockIdx.x * 8 + (threadIdx.x >> 6), nw = gridDim.x * 8;
    const int ra = lane >> 5, ri = lane & 31, rf = ri & 15, rx2 = ri >> 4, rp = 2 * (16 * ra + rf) + rx2;
    for (int r = gw; r < T + 2048; r += nw) {
        if (r < T) {
            const int row = r, krow = keyrow_of(row);
            const bf16_t* dr = DOWN + (size_t)row * 1280;
#define MR_LD4(p_) ({ const u32x2 t_ = *(const u32x2*)(p_); (f32x4){bf_lo(t_.x), bf_hi(t_.x), bf_lo(t_.y), bf_hi(t_.y)}; })
            {
                const f32x4 a0 = MR_LD4(dr + 4 * lane), a1 = MR_LD4(dr + 256 + 4 * lane);
                float ss = a0[0] * a0[0] + a0[1] * a0[1] + a0[2] * a0[2] + a0[3] * a0[3] + a1[0] * a1[0] + a1[1] * a1[1] + a1[2] * a1[2] + a1[3] * a1[3];
                ss = wave_sum(ss); const float rstd = rsqrtf(ss * (1.f / 512.f) + 1e-6f);
                const f32x4 g0 = *(const f32x4*)(g_q + 4 * lane), g1 = *(const f32x4*)(g_q + 256 + 4 * lane);
                const f32x4 y0 = a0 * rstd * g0, y1 = a1 * rstd * g1;
                u32x2 w; w.x = pk_bf16(y0[0], y0[1]); w.y = pk_bf16(y0[2], y0[3]); *(u32x2*)(CQ + (size_t)row * 512 + 4 * lane) = w;
                w.x = pk_bf16(y1[0], y1[1]); w.y = pk_bf16(y1[2], y1[3]); *(u32x2*)(CQ + (size_t)row * 512 + 256 + 4 * lane) = w;
            }
            {
                const f32x4 a0 = MR_LD4(dr + 512 + 4 * lane), a1 = MR_LD4(dr + 768 + 4 * lane);
                float ss = a0[0] * a0[0] + a0[1] * a0[1] + a0[2] * a0[2] + a0[3] * a0[3] + a1[0] * a1[0] + a1[1] * a1[1] + a1[2] * a1[2] + a1[3] * a1[3];
                ss = wave_sum(ss); const float rstd = rsqrtf(ss * (1.f / 512.f) + 1e-6f);
                const f32x4 g0 = *(const f32x4*)(g_kv + 4 * lane), g1 = *(const f32x4*)(g_kv + 256 + 4 * lane);
                const f32x4 y0 = a0 * rstd * g0, y1 = a1 * rstd * g1;
                u32x2 w; w.x = pk_bf16(y0[0], y0[1]); w.y = pk_bf16(y0[2], y0[3]); *(u32x2*)(CKV + (size_t)krow * 512 + 4 * lane) = w;
                w.x = pk_bf16(y1[0], y1[1]); w.y = pk_bf16(y1[2], y1[3]); *(u32x2*)(CKV + (size_t)krow * 512 + 256 + 4 * lane) = w;
                if (row < TC) { *(f32x4*)(out_ckv + (size_t)row * 512 + 4 * lane) = y0; *(f32x4*)(out_ckv + (size_t)row * 512 + 256 + 4 * lane) = y1; }
            }
            {
                const float v = __uint_as_float((unsigned)dr[1024 + lane] << 16);
#undef MR_LD4
                if (row < TC) { out_kpe[(size_t)row * 64 + lane] = v; KPE[(size_t)krow * 64 + rp] = f2bf(v); }
                else {
                    const int l = (row - TC) & 2047, pos = ra ? (l & 63) : (l >> 6);
                    const float c = rope[pos * 16 + rf], s = rope[1024 + pos * 16 + rf];
                    const float other = __shfl_xor(v, 16);
                    const float x1 = rx2 ? other : v, x2 = rx2 ? v : other;
                    KPE[(size_t)krow * 64 + rp] = f2bf(rx2 ? (x1 * s + x2 * c) : (x1 * c - x2 * s));
                }
            }
        } else {
            const int cr = r - T, b = cr >> 8, pos = cr & 255, krow = TC + b * 2304 + 2048 + pos;
            const float* src = cache_ckv + (size_t)cr * 512;
            const f32x4 a0 = *(const f32x4*)(src + 4 * lane), a1 = *(const f32x4*)(src + 256 + 4 * lane);
            u32x2 w; w.x = pk_bf16(a0[0], a0[1]); w.y = pk_bf16(a0[2], a0[3]); *(u32x2*)(CKV + (size_t)krow * 512 + 4 * lane) = w;
            w.x = pk_bf16(a1[0], a1[1]); w.y = pk_bf16(a1[2], a1[3]); *(u32x2*)(CKV + (size_t)krow * 512 + 256 + 4 * lane) = w;
            KPE[(size_t)krow * 64 + rp] = f2bf(cache_kpe[(size_t)cr * 64 + lane]);
        }
    }
}

template <int DK2>
__device__ __forceinline__ void attn_unit(LDSP unsigned char* lds,
        const bf16_t* __restrict__ Qp, int q_ld, int qrow0, const bf16_t* __restrict__ K1p, int k1_ld, const bf16_t* __restrict__ K2p, int k2_ld,
        const bf16_t* __restrict__ VTp, int vt_ld, bf16_t* __restrict__ Op, int o_ld, float scale_log2, bool has_sink, float sink_log2,
        int kb0, int nt0, int kb1, int nt1, bool band, int qpos0, int kpos0) {
    constexpr int DK = 128 + DK2, NDS = DK / 32, KROW = DK * 2 + 16, VROW = 144, KT_BYTES = 64 * KROW, VT_BYTES = 128 * VROW;
    const int tid = threadIdx.x, lane = tid & 63, wave = tid >> 6, fr = lane & 15, fq = lane >> 4;
    bf16x8 Qf[2][NDS];
#pragma unroll
    for (int qs = 0; qs < 2; ++qs)
#pragma unroll
        for (int ds = 0; ds < NDS; ++ds) Qf[qs][ds] = *(const bf16x8*)(Qp + (size_t)(qrow0 + 32 * wave + 16 * qs + fr) * q_ld + 32 * ds + 8 * fq);
    f32x4 O[2][8];
#pragma unroll
    for (int qs = 0; qs < 2; ++qs)
#pragma unroll
        for (int n = 0; n < 8; ++n) O[qs][n] = (f32x4){0.f, 0.f, 0.f, 0.f};
    float mrow[2] = {-1e30f, -1e30f}, lrow[2] = {0.f, 0.f};
    const int nt = nt0 + nt1;
    u32x4 rs[3];
    rs[2] = (u32x4){0u, 0u, 0u, 0u};
#define ATT_KB(t_) ((t_) < nt0 ? kb0 + 64 * (t_) : kb1 + 64 * ((t_) - nt0))
#define ATT_LOADK(t_) do { const int kb_ = ATT_KB(t_); \
        _Pragma("unroll") for (int i_ = 0; i_ < 2; ++i_) { const int c_ = tid + 512 * i_; rs[i_] = *(const u32x4*)(K1p + (size_t)(kb_ + (c_ >> 4)) * k1_ld + (c_ & 15) * 8); } \
        if (DK2) rs[2] = *(const u32x4*)(K2p + (size_t)(kb_ + (tid >> 3)) * k2_ld + (tid & 7) * 8); } while (0)
#define ATT_STOREK(b_) do { LDSP unsigned char* Kb_ = lds + (b_) * KT_BYTES; \
        _Pragma("unroll") for (int i_ = 0; i_ < 2; ++i_) { const int c_ = tid + 512 * i_; *(LDSP u32x4*)(Kb_ + (c_ >> 4) * KROW + (c_ & 15) * 16) = rs[i_]; } \
        if (DK2) *(LDSP u32x4*)(Kb_ + (tid >> 3) * KROW + 256 + (tid & 7) * 16) = rs[2]; } while (0)
#define ATT_LOADV(t_) do { const int kb_ = ATT_KB(t_); \
        _Pragma("unroll") for (int i_ = 0; i_ < 2; ++i_) { const int c_ = tid + 512 * i_; rs[i_] = *(const u32x4*)(VTp + (size_t)(c_ >> 3) * vt_ld + kb_ + (c_ & 7) * 8); } } while (0)
#define ATT_STOREV(b_) do { LDSP unsigned char* Vb_ = lds + 2 * KT_BYTES + (b_) * VT_BYTES; \
        _Pragma("unroll") for (int i_ = 0; i_ < 2; ++i_) { const int c_ = tid + 512 * i_; *(LDSP u32x4*)(Vb_ + (c_ >> 3) * VROW + (c_ & 7) * 16) = rs[i_]; } } while (0)
    ATT_LOADK(0); ATT_STOREK(0); ATT_LOADV(0); ATT_STOREV(0);
    __syncthreads();
    for (int t = 0; t < nt; ++t) {
        const int b = t & 1;
        if (t + 1 < nt) ATT_LOADK(t + 1);
        LDSP unsigned char* Kb = lds + b * KT_BYTES; LDSP unsigned char* Vb = lds + 2 * KT_BYTES + b * VT_BYTES;
        f32x4 S[2][4];
#pragma unroll
        for (int qs = 0; qs < 2; ++qs)
#pragma unroll
            for (int kt = 0; kt < 4; ++kt) S[qs][kt] = (f32x4){0.f, 0.f, 0.f, 0.f};
#pragma unroll
        for (int ds = 0; ds < NDS; ++ds)
#pragma unroll
            for (int kt = 0; kt < 4; ++kt) {
                const bf16x8 kf = *(const LDSP bf16x8*)(Kb + (16 * kt + fr) * KROW + (32 * ds + 8 * fq) * 2);
                S[0][kt] = __builtin_amdgcn_mfma_f32_16x16x32_bf16(kf, Qf[0][ds], S[0][kt], 0, 0, 0);
                S[1][kt] = __builtin_amdgcn_mfma_f32_16x16x32_bf16(kf, Qf[1][ds], S[1][kt], 0, 0, 0);
            }
        if (t + 1 < nt) { ATT_STOREK(b ^ 1); ATT_LOADV(t + 1); }
        bf16x8 Pf[2][2];
        const bool do_mask = band && t < nt0;
#pragma unroll
        for (int qs = 0; qs < 2; ++qs) {
            float sv[16]; float mx = -INFINITY;
            const int qpos = qpos0 + 32 * wave + 16 * qs + fr;
#pragma unroll
            for (int kt = 0; kt < 4; ++kt)
#pragma unroll
                for (int j = 0; j < 4; ++j) { float x = S[qs][kt][j];
                    if (do_mask) { const int dlt = qpos - (kpos0 + 64 * t + 16 * kt + 4 * fq + j); if (dlt > 128 || dlt < -128) x = -INFINITY; }
                    sv[kt * 4 + j] = x; mx = fmaxf(mx, x); }
            mx = xmax_16_32(mx);
            const float mnew = fmaxf(mrow[qs], mx * scale_log2), alpha = fexp2(mrow[qs] - mnew); mrow[qs] = mnew;
            if (__builtin_amdgcn_ballot_w64(alpha < 1.f) != 0ull) {
#pragma unroll
                for (int n = 0; n < 8; ++n) O[qs][n] *= alpha;
            }
            float ps = 0.f;
#pragma unroll
            for (int i = 0; i < 16; ++i) { sv[i] = fexp2(__builtin_fmaf(sv[i], scale_log2, -mnew)); ps += sv[i]; }
            lrow[qs] = lrow[qs] * alpha + ps;
#pragma unroll
            for (int s = 0; s < 2; ++s) { u32x4 w; w.x = pk_bf16(sv[8 * s + 0], sv[8 * s + 1]); w.y = pk_bf16(sv[8 * s + 2], sv[8 * s + 3]); w.z = pk_bf16(sv[8 * s + 4], sv[8 * s + 5]); w.w = pk_bf16(sv[8 * s + 6], sv[8 * s + 7]); Pf[qs][s] = as_bf16x8(w); }
        }
#pragma unroll
        for (int s = 0; s < 2; ++s)
#pragma unroll
            for (int n = 0; n < 8; ++n) {
                const LDSP unsigned char* vp = Vb + (16 * n + fr) * VROW + (32 * s + 4 * fq) * 2;
                const u32x2 lo = *(const LDSP u32x2*)vp, hi = *(const LDSP u32x2*)(vp + 32);
                const bf16x8 vf = as_bf16x8((u32x4){lo.x, lo.y, hi.x, hi.y});
                O[0][n] = __builtin_amdgcn_mfma_f32_16x16x32_bf16(vf, Pf[0][s], O[0][n], 0, 0, 0);
                O[1][n] = __builtin_amdgcn_mfma_f32_16x16x32_bf16(vf, Pf[1][s], O[1][n], 0, 0, 0);
            }
        if (t + 1 < nt) ATT_STOREV(b ^ 1);
        __syncthreads();
    }
#undef ATT_KB
#undef ATT_LOADK
#undef ATT_STOREK
#undef ATT_LOADV
#undef ATT_STOREV
#pragma unroll
    for (int qs = 0; qs < 2; ++qs) {
        float lt = lrow[qs]; lt += __shfl_xor(lt, 16); lt += __shfl_xor(lt, 32);
        const float mf = has_sink ? fmaxf(mrow[qs], sink_log2) : mrow[qs], a = fexp2(mrow[qs] - mf);
        const float denom = lt * a + (has_sink ? fexp2(sink_log2 - mf) : 0.f), inv = a / denom;
        bf16_t* orow = Op + (size_t)(qrow0 + 32 * wave + 16 * qs + fr) * o_ld + 4 * fq;
#pragma unroll
        for (int n = 0; n < 8; ++n) { const f32x4 o = O[qs][n] * inv; u32x2 w; w.x = pk_bf16(o[0], o[1]); w.y = pk_bf16(o[2], o[3]); *(u32x2*)(orow + 16 * n) = w; }
    }
}

template <int KIND>
__device__ __forceinline__ void attn_phase(LDSP unsigned char* lds, const bf16_t* Q, const bf16_t* K1, const bf16_t* K2, const bf16_t* VT, bf16_t* O, const float* sink) {
    const float LOG2E = 1.4426950408889634f;
    for (int u0 = blockIdx.x; u0 < 1280; u0 += gridDim.x) {
        int u = u0;
        if (gridDim.x == 256 && u0 < 1024) {
            const int j = u0 >> 8, x = u0 & 255, vx = x & 7, r = x >> 3;
            u = ((32 * j + 4 * vx + (r >> 3)) << 3) | (r & 7);
        }
        int b, head, qb, qrow0, kb0, nt0, kb1 = 0, nt1 = 0, qpos0 = 0, kpos0 = 0; bool band = false;
        if (u < 1024) { b = u >> 7; head = (u >> 3) & 15; qb = u & 7; qrow0 = TC + b * 2048 + qb * 256; const int kbase = TC + b * 2304;
            if (KIND == 0) { kb0 = kbase; nt0 = 36; }
            else { const int lo = qb * 256 - 128 < 0 ? 0 : qb * 256 - 128, hi = qb * 256 + 384 > 2048 ? 2048 : qb * 256 + 384; kb0 = kbase + lo; nt0 = (hi - lo) >> 6; kb1 = kbase + 2048; nt1 = 4; band = true; qpos0 = qb * 256; kpos0 = lo; }
        } else { const int v = u - 1024; b = v >> 4; head = v & 15; qb = 0; qrow0 = b * 256; kb0 = b * 256; nt0 = 4; }
        if (KIND == 0)
            attn_unit<64>(lds, Q + head * 192, 3072, qrow0, K1 + head * 128, 2048, K2, 64, VT + (size_t)(head * 128) * NKEY, NKEY, O + head * 128, D,
                          0.07216878364870322f * LOG2E, false, 0.f, kb0, nt0, kb1, nt1, false, 0, 0);
        else
            attn_unit<0>(lds, Q + head * 128, D, qrow0, K1 + (head >> 2) * 128, 512, nullptr, 0, VT + (size_t)((head >> 2) * 128) * NKEY, NKEY, O + head * 128, D,
                         0.08838834764831845f * LOG2E, true, sink[head] * LOG2E, kb0, nt0, kb1, nt1, band, qpos0, kpos0);
    }
}

__device__ __forceinline__ void s5_chain(LDSP unsigned char* wl, const bf16_t* __restrict__ U, bf16_t* __restrict__ Y, int rowbase, int L, int b, int g, int dir,
        const float* __restrict__ lam_re, const float* __restrict__ lam_im, const float* __restrict__ log_dt, const float* __restrict__ b_re, const float* __restrict__ b_im,
        const float* __restrict__ c_re, const float* __restrict__ c_im, const float* __restrict__ h0re, const float* __restrict__ h0im, float* __restrict__ fin_re, float* __restrict__ fin_im) {
    const int lane = threadIdx.x & 63, fr = lane & 15, fq = lane >> 4, p = lane;
    const int pg = dir * 128 + g;
    float a_re, a_im, cf_re, cf_im;
    { const float lr = lam_re[pg * 64 + p], li = lam_im[pg * 64 + p], dt = __expf(log_dt[pg]);
      const float ea = __expf(lr * dt); float sn, cs; sincosf(li * dt, &sn, &cs); a_re = ea * cs; a_im = ea * sn;
      const float den = 1.f / (lr * lr + li * li), nr = a_re - 1.f, ni = a_im; cf_re = (nr * lr + ni * li) * den; cf_im = (ni * lr - nr * li) * den; }
    bf16x8 Bf[8];
#pragma unroll
    for (int k = 0; k < 4; ++k) {
        const int pk = 16 * k + fr; const float cr = __shfl(cf_re, pk), cim = __shfl(cf_im, pk);
        u32x4 wre = (u32x4){0u, 0u, 0u, 0u}, wim = (u32x4){0u, 0u, 0u, 0u};
        if (fq < 2) {
            const float* br = b_re + ((size_t)pg * 64 + pk) * 16 + 8 * fq; const float* bi = b_im + ((size_t)pg * 64 + pk) * 16 + 8 * fq;
            const f32x4 r0 = *(const f32x4*)br, r1 = *(const f32x4*)(br + 4), i0 = *(const f32x4*)bi, i1 = *(const f32x4*)(bi + 4);
            const f32x4 xr0 = r0 * cr - i0 * cim, xr1 = r1 * cr - i1 * cim, xi0 = i0 * cr + r0 * cim, xi1 = i1 * cr + r1 * cim;
            wre.x = pk_bf16(xr0[0], xr0[1]); wre.y = pk_bf16(xr0[2], xr0[3]); wre.z = pk_bf16(xr1[0], xr1[1]); wre.w = pk_bf16(xr1[2], xr1[3]);
            wim.x = pk_bf16(xi0[0], xi0[1]); wim.y = pk_bf16(xi0[2], xi0[3]); wim.z = pk_bf16(xi1[0], xi1[1]); wim.w = pk_bf16(xi1[2], xi1[3]);
        }
        Bf[k] = as_bf16x8(wre); Bf[4 + k] = as_bf16x8(wim);
    }
    bf16x8 Cf[4];
#pragma unroll
    for (int ks = 0; ks < 4; ++ks) {
        const float* src = (ks < 2 ? c_re : c_im) + ((size_t)pg * 16 + fr) * 64 + (ks & 1) * 32 + 8 * fq;
        f32x4 v0 = *(const f32x4*)src, v1 = *(const f32x4*)(src + 4);
        if (ks >= 2) { v0 = -v0; v1 = -v1; }
        u32x4 w; w.x = pk_bf16(v0[0], v0[1]); w.y = pk_bf16(v0[2], v0[3]); w.z = pk_bf16(v1[0], v1[1]); w.w = pk_bf16(v1[2], v1[3]); Cf[ks] = as_bf16x8(w);
    }
    float h_re = 0.f, h_im = 0.f;
    if (h0re) { const size_t hi = (((size_t)b * 2 + dir) * 128 + g) * 64 + p; h_re = h0re[hi]; h_im = h0im[hi]; }
    LDSP float* BUl = (LDSP float*)wl;
    LDSP unsigned char* Hl = wl + 16 * 132 * 4;
    const int nch = L >> 4;
    const bf16_t* ubase = U + (size_t)rowbase * D + 16 * g + 8 * fq;
    u32x4 uf = (u32x4){0u, 0u, 0u, 0u};
    if (fq < 2) { const int tt = dir ? L - 1 - fr : fr; uf = *(const u32x4*)(ubase + (size_t)tt * D); }
    for (int ci = 0; ci < nch; ++ci) {
        u32x4 ufn = (u32x4){0u, 0u, 0u, 0u};
        if (fq < 2 && ci + 1 < nch) { const int r = 16 * (ci + 1) + fr, tt = dir ? L - 1 - r : r; ufn = *(const u32x4*)(ubase + (size_t)tt * D); }
        const bf16x8 ua = as_bf16x8(uf);
#pragma unroll
        for (int nt = 0; nt < 8; ++nt) {
            const f32x4 bu = __builtin_amdgcn_mfma_f32_16x16x32_bf16(ua, Bf[nt], (f32x4){0.f, 0.f, 0.f, 0.f}, 0, 0, 0);
#pragma unroll
            for (int j = 0; j < 4; ++j) BUl[(4 * fq + j) * 132 + 16 * nt + fr] = bu[j];
        }
        WAVE_SYNC();
#pragma unroll
        for (int r = 0; r < 16; ++r) {
            const float br = BUl[r * 132 + p], bi = BUl[r * 132 + 64 + p];
            const float nre = a_re * h_re - a_im * h_im + br, nim = a_re * h_im + a_im * h_re + bi;
            h_re = nre; h_im = nim;
            *(LDSP bf16_t*)(Hl + r * 272 + p * 2) = f2bf(h_re); *(LDSP bf16_t*)(Hl + r * 272 + 128 + p * 2) = f2bf(h_im);
        }
        WAVE_SYNC();
        f32x4 y = (f32x4){0.f, 0.f, 0.f, 0.f};
#pragma unroll
        for (int ks = 0; ks < 4; ++ks) { const bf16x8 hf = *(const LDSP bf16x8*)(Hl + fr * 272 + (32 * ks + 8 * fq) * 2); y = __builtin_amdgcn_mfma_f32_16x16x32_bf16(hf, Cf[ks], y, 0, 0, 0); }
#pragma unroll
        for (int j = 0; j < 4; ++j) { const int r = 16 * ci + 4 * fq + j, tt = dir ? L - 1 - r : r; Y[(size_t)(rowbase + tt) * D + 16 * g + fr] = f2bf(y[j]); }
        WAVE_SYNC();
        uf = ufn;
    }
    if (fin_re) { const size_t fi = (((size_t)b * 2 + dir) * 128 + g) * 64 + p; fin_re[fi] = h_re; fin_im[fi] = h_im; }
}
__device__ __forceinline__ void s5_scan_phase(LDSP unsigned char* lds, const bf16_t* U, bf16_t* YF, bf16_t* YB, const float* const* in, float* out) {
    const int wave = threadIdx.x >> 6, gw = blockIdx.x * 8 + wave, nw = gridDim.x * 8;
    LDSP unsigned char* wl = lds + wave * 12800;
    for (int c = gw; c < 2048; c += nw) {
        const int b = c >> 8, g = (c >> 1) & 127, dir = c & 1;
        s5_chain(wl, U, dir ? YB : YF, TC + b * 2048, 2048, b, g, dir, in[I_S5LRE], in[I_S5LIM], in[I_S5LDT], in[I_S5BRE], in[I_S5BIM], in[I_S5CRE], in[I_S5CIM], in[I_S5RE], in[I_S5IM], nullptr, nullptr);
    }
    for (int c = gw; c < 4096; c += nw) {
        const int b = c >> 8, g = (c >> 1) & 127, dir = c & 1;
        s5_chain(wl, U, dir ? YB : YF, b * 256, 256, b, g, dir, in[I_S5LRE], in[I_S5LIM], in[I_S5LDT], in[I_S5BRE], in[I_S5BIM], in[I_S5CRE], in[I_S5CIM], nullptr, nullptr, out + OUT_S5RE, out + OUT_S5IM);
    }
}
__device__ __forceinline__ void s5_combine_phase(const bf16_t* __restrict__ U, const bf16_t* __restrict__ YF, const bf16_t* __restrict__ YB, const float* __restrict__ dvec, bf16_t* __restrict__ Z) {
    const size_t ng = (size_t)T * D / 8, stride = (size_t)gridDim.x * NTH;
    constexpr int NU = 4;
    size_t gi = (size_t)blockIdx.x * NTH + threadIdx.x;
    const int col = (int)((gi * 8) & 2047); const f32x4 d0 = *(const f32x4*)(dvec + col), d1 = *(const f32x4*)(dvec + col + 4);
#define S5C_ONE(u_, yf_, yb_, g_) do { u32x4 w; \
        w.x = pk_bf16(gelu_tanh(d0[0] * bf_lo(u_.x) + bf_lo(yf_.x) + bf_lo(yb_.x)), gelu_tanh(d0[1] * bf_hi(u_.x) + bf_hi(yf_.x) + bf_hi(yb_.x))); \
        w.y = pk_bf16(gelu_tanh(d0[2] * bf_lo(u_.y) + bf_lo(yf_.y) + bf_lo(yb_.y)), gelu_tanh(d0[3] * bf_hi(u_.y) + bf_hi(yf_.y) + bf_hi(yb_.y))); \
        w.z = pk_bf16(gelu_tanh(d1[0] * bf_lo(u_.z) + bf_lo(yf_.z) + bf_lo(yb_.z)), gelu_tanh(d1[1] * bf_hi(u_.z) + bf_hi(yf_.z) + bf_hi(yb_.z))); \
        w.w = pk_bf16(gelu_tanh(d1[2] * bf_lo(u_.w) + bf_lo(yf_.w) + bf_lo(yb_.w)), gelu_tanh(d1[3] * bf_hi(u_.w) + bf_hi(yf_.w) + bf_hi(yb_.w))); \
        *(u32x4*)(Z + (g_) * 8) = w; } while (0)
    for (; gi + (NU - 1) * stride < ng; gi += NU * stride) {
        u32x4 u[NU], yf[NU], yb[NU];
#pragma unroll
        for (int k = 0; k < NU; ++k) { const size_t g = gi + k * stride; u[k] = *(const u32x4*)(U + g * 8); yf[k] = *(const u32x4*)(YF + g * 8); yb[k] = *(const u32x4*)(YB + g * 8); }
        asm volatile("" ::: "memory"); __builtin_amdgcn_sched_barrier(0);
#pragma unroll
        for (int k = 0; k < NU; ++k) { const size_t g = gi + k * stride; S5C_ONE(u[k], yf[k], yb[k], g); }
    }
    for (; gi < ng; gi += stride) { const u32x4 u = *(const u32x4*)(U + gi * 8), yf = *(const u32x4*)(YF + gi * 8), yb = *(const u32x4*)(YB + gi * 8); S5C_ONE(u, yf, yb, gi); }
#undef S5C_ONE
}

__device__ __forceinline__ u32x4 shl_elems(u32x4 lo, u32x4 hi, int s) {
    const unsigned d[8] = {lo.x, lo.y, lo.z, lo.w, hi.x, hi.y, hi.z, hi.w};
    const int dw = s >> 1; u32x4 r;
    if (s & 1) { r.x = __builtin_amdgcn_alignbyte(d[dw + 1], d[dw], 2); r.y = __builtin_amdgcn_alignbyte(d[dw + 2], d[dw + 1], 2); r.z = __builtin_amdgcn_alignbyte(d[dw + 3], d[dw + 2], 2); r.w = __builtin_amdgcn_alignbyte(d[(dw + 4) & 7], d[dw + 3], 2); }
    else { r.x = d[dw]; r.y = d[dw + 1]; r.z = d[dw + 2]; r.w = d[dw + 3]; }
    return r;
}
template <int NB, int L, bool ROLL, int GW>
__device__ __forceinline__ void hy_conv_unit(LDSP unsigned char* lds0, int d0, int tokbase, const bf16_t* __restrict__ ZT, const bf16_t* __restrict__ Fg,
        const float* __restrict__ short_w, const float* __restrict__ short_b, const float* __restrict__ bias, bf16_t* __restrict__ VOT, int dnext, unsigned& sink) {
    constexpr int VSROW = L * 2 + 16, FCROW = 4 * L + 32, NT = L / 16, TPW = NT / GW, NTHG = 64 * GW, GSZ = 2 * NB * VSROW + 8 * FCROW;
    static_assert(!ROLL || (TPW == 16 && GW == 8), "rolling window is written for 16 tiles per wave");
    static_assert((8 / GW) * GSZ <= LDS_BYTES, "LDS");
    const int tid = threadIdx.x, lane = tid & 63, wv = __builtin_amdgcn_readfirstlane(tid >> 6), grp = GW == 8 ? 0 : wv / GW, wave = GW == 8 ? wv : wv % GW, gtid = tid % NTHG, d = d0 + grp, fr = lane & 15, fq = lane >> 4;
    LDSP unsigned char* lds = lds0 + grp * GSZ;
    LDSP unsigned char* VS = lds; LDSP unsigned char* XS = lds + NB * VSROW; LDSP unsigned char* FC = lds + 2 * NB * VSROW;
#define HY_T0(i_) (ROLL ? 16 * (16 * wave + (i_)) : 16 * (wave + GW * (i_)))
    constexpr int NCH = NB * L / 8 / NTHG;
#define HY_FENCE() do { asm volatile("" ::: "memory"); __builtin_amdgcn_sched_barrier(0); } while (0)
#define HY_PINW(cw_) asm volatile("" : "+v"(cw_[0]), "+v"(cw_[1]), "+v"(cw_[2]), "+v"(cw_[3]))
#define HY_PINF(a_, b_, c_) asm volatile("" : "+v"(a_), "+v"(b_), "+v"(c_))
#define HY_LD(zq_, zl_, zr_, ch_) do { const bf16_t* base_ = ZT + (size_t)(ch_) * T + tokbase; \
        _Pragma("unroll") for (int k_ = 0; k_ < NCH; ++k_) { const int c_ = gtid + k_ * NTHG, b_ = c_ / (L / 8), t8_ = (c_ % (L / 8)) * 8; const bf16_t* src_ = base_ + b_ * L; \
            zq_[k_] = *(const u32x4*)(src_ + t8_); zl_[k_] = src_[t8_ > 0 ? t8_ - 1 : 0]; zr_[k_] = src_[t8_ + 8 < L ? t8_ + 8 : L - 1]; } } while (0)
#define HY_LDW(cw_, ch_) do { const int chv_ = (ch_); cw_[0] = short_w[chv_]; cw_[1] = short_w[6144 + chv_]; cw_[2] = short_w[2 * 6144 + chv_]; cw_[3] = short_b[chv_]; } while (0)
#define HY_ST(dst_, zq_, zl_, zr_, cw_) do { const float w0_ = cw_[0], w1_ = cw_[1], w2_ = cw_[2], sb_ = cw_[3]; \
        _Pragma("unroll") for (int k_ = 0; k_ < NCH; ++k_) { const int c_ = gtid + k_ * NTHG, b_ = c_ / (L / 8), t8_ = (c_ % (L / 8)) * 8; \
            const u32x4 z_ = zq_[k_]; float zz_[10]; zz_[0] = t8_ > 0 ? bf2f(zl_[k_]) : 0.f; zz_[9] = t8_ + 8 < L ? bf2f(zr_[k_]) : 0.f; \
            zz_[1] = bf_lo(z_.x); zz_[2] = bf_hi(z_.x); zz_[3] = bf_lo(z_.y); zz_[4] = bf_hi(z_.y); zz_[5] = bf_lo(z_.z); zz_[6] = bf_hi(z_.z); zz_[7] = bf_lo(z_.w); zz_[8] = bf_hi(z_.w); \
            float o_[8]; _Pragma("unroll") for (int j_ = 0; j_ < 8; ++j_) o_[j_] = w0_ * zz_[j_] + w1_ * zz_[j_ + 1] + w2_ * zz_[j_ + 2] + sb_; \
            u32x4 w_; w_.x = pk_bf16(o_[0], o_[1]); w_.y = pk_bf16(o_[2], o_[3]); w_.z = pk_bf16(o_[4], o_[5]); w_.w = pk_bf16(o_[6], o_[7]); \
            *(LDSP u32x4*)((dst_) + b_ * VSROW + t8_ * 2) = w_; } } while (0)
    constexpr int NQ = 2 * L / 8;
    static_assert(NQ <= NTHG, "filter groups");
#define HY_FLD(cm_, c0_, cp_, o_) do { const bf16_t* Fo_ = Fg + ((size_t)(o_) * 2048 + d) * (size_t)(2 * L); const int q_ = gtid < NQ ? gtid : 0; \
        cm_ = *(const u32x4*)(Fo_ + 8 * (q_ > 0 ? q_ - 1 : 0)); c0_ = *(const u32x4*)(Fo_ + 8 * q_); cp_ = *(const u32x4*)(Fo_ + 8 * (q_ + 1 < NQ ? q_ + 1 : q_)); } while (0)
#define HY_FST(cm_, c0_, cp_) do { if (gtid < NQ) { const int q_ = gtid; const u32x4 z0_ = (u32x4){0u, 0u, 0u, 0u}; const u32x4 cmv_ = q_ > 0 ? cm_ : z0_, cpv_ = q_ + 1 < NQ ? cp_ : z0_; \
            *(LDSP u32x4*)(FC + 0 * FCROW + q_ * 16) = shl_elems(cmv_, c0_, 7); \
            _Pragma("unroll") for (int c_ = 1; c_ < 8; ++c_) *(LDSP u32x4*)(FC + c_ * FCROW + q_ * 16) = shl_elems(c0_, cpv_, c_ - 1); } } while (0)
#define HY_AFRAG(phi_) (*(const LDSP bf16x8*)(FC + cc_ * FCROW + ((8 * fq - 16 * (phi_) - fr + L) - cc_) * 2))
#define HY_CONV(Bsrc_) do { _Pragma("unroll") for (int i_ = 0; i_ < TPW; ++i_) acc[i_] = (f32x4){0.f, 0.f, 0.f, 0.f}; \
        const int bsel_ = fr & (NB - 1), cc_ = (16 - fr) & 7; \
        if constexpr (ROLL) { \
            bf16x8 W_[16]; \
            _Pragma("unroll") for (int j_ = 0; j_ < 16; ++j_) W_[j_] = HY_AFRAG(16 * wave + j_); \
            bf16x8 bfn_ = *(const LDSP bf16x8*)((Bsrc_) + bsel_ * VSROW + (8 * fq) * 2); \
            _Pragma("unroll 1") for (int mb_ = 0; mb_ < L / 32; mb_ += 8) { \
                _Pragma("unroll") for (int mm_ = 0; mm_ < 8; ++mm_) { const int m_ = mb_ + mm_; \
                    const bf16x8 bf_ = bfn_; bfn_ = *(const LDSP bf16x8*)((Bsrc_) + bsel_ * VSROW + (32 * (m_ + 1 < L / 32 ? m_ + 1 : m_) + 8 * fq) * 2); \
                    _Pragma("unroll") for (int jj_ = 2; jj_ < 18; ++jj_) { const int j_ = jj_ & 15; acc[j_] = __builtin_amdgcn_mfma_f32_16x16x32_bf16(W_[(j_ - 2 * mm_) & 15], bf_, acc[j_], 0, 0, 0); }   \
                    if (m_ + 1 < L / 32) { W_[(0 - 2 * (mm_ + 1)) & 15] = HY_AFRAG(16 * wave - 2 * (m_ + 1)); W_[(1 - 2 * (mm_ + 1)) & 15] = HY_AFRAG(16 * wave + 1 - 2 * (m_ + 1)); } } } \
        } else { \
            for (int s0_ = 0; s0_ < L; s0_ += 32) { const bf16x8 bf_ = *(const LDSP bf16x8*)((Bsrc_) + bsel_ * VSROW + (s0_ + 8 * fq) * 2); \
                _Pragma("unroll") for (int i_ = 0; i_ < TPW; ++i_) { const int t0_ = HY_T0(i_), idx_ = 8 * fq - (t0_ - s0_) - fr + L, x0_ = idx_ - cc_; \
                    const bf16x8 af_ = *(const LDSP bf16x8*)(FC + cc_ * FCROW + x0_ * 2); acc[i_] = __builtin_amdgcn_mfma_f32_16x16x32_bf16(af_, bf_, acc[i_], 0, 0, 0); } } } } while (0)
    f32x4 acc[TPW];
#define HY_TOUCH(dst_, ptr_, nlines_, off_) do { const int li_ = tid - (off_); if (li_ >= 0 && li_ < (nlines_)) dst_ = *(const unsigned*)((const char*)(ptr_) + (size_t)li_ * 128); } while (0)
    constexpr bool HY_USE_TOUCH = false;
    unsigned tc0 = 0u, tc1 = 0u, tc2 = 0u;
    { u32x4 za[NCH], zb[NCH], fm, f0, fp; bf16_t zal[NCH], zar[NCH], zbl[NCH], zbr[NCH]; float cwa[4], cwb[4];
      HY_LD(za, zal, zar, 4096 + d); HY_LD(zb, zbl, zbr, d); HY_FLD(fm, f0, fp, 0); HY_LDW(cwa, 4096 + d); HY_LDW(cwb, d); HY_PINW(cwa); HY_PINW(cwb); HY_PINF(fm, f0, fp); HY_FENCE();
      HY_ST(VS, za, zal, zar, cwa); HY_ST(XS, zb, zbl, zbr, cwb); HY_FST(fm, f0, fp); }
    __syncthreads();
    if constexpr (ROLL && HY_USE_TOUCH) { HY_TOUCH(tc0, ZT + (size_t)(2048 + d) * T + tokbase, NB * L * 2 / 128, 0); HY_TOUCH(tc0, Fg + ((size_t)2048 + d) * (size_t)(2 * L), 2 * L * 2 / 128, NB * L * 2 / 128); }
    HY_CONV(VS);
    sink ^= tc0;
    { const float bias0 = bias[d];
      if (fr < NB) {
#pragma unroll
        for (int i = 0; i < TPW; ++i) { const int t0 = HY_T0(i) + 4 * fq;
            const u32x2 vs = *(const LDSP u32x2*)(VS + fr * VSROW + t0 * 2), x1 = *(const LDSP u32x2*)(XS + fr * VSROW + t0 * 2);
            u32x2 w; w.x = pk_bf16(bf_lo(x1.x) * (acc[i][0] + bias0 * bf_lo(vs.x)), bf_hi(x1.x) * (acc[i][1] + bias0 * bf_hi(vs.x)));
            w.y = pk_bf16(bf_lo(x1.y) * (acc[i][2] + bias0 * bf_lo(vs.y)), bf_hi(x1.y) * (acc[i][3] + bias0 * bf_hi(vs.y)));
            *(LDSP u32x2*)(XS + fr * VSROW + t0 * 2) = w; } } }
    __syncthreads();
    { u32x4 za[NCH], fm, f0, fp; bf16_t zal[NCH], zar[NCH]; float cwa[4];
      HY_LD(za, zal, zar, 2048 + d); HY_FLD(fm, f0, fp, 1); HY_LDW(cwa, 2048 + d); HY_PINW(cwa); HY_PINF(fm, f0, fp); HY_FENCE();
      HY_ST(VS, za, zal, zar, cwa); HY_FST(fm, f0, fp); }
    __syncthreads();
    if constexpr (ROLL && HY_USE_TOUCH) { if (dnext >= 0) { HY_TOUCH(tc1, ZT + (size_t)(4096 + dnext) * T + tokbase, NB * L * 2 / 128, 0); HY_TOUCH(tc1, ZT + (size_t)dnext * T + tokbase, NB * L * 2 / 128, NB * L * 2 / 128);
        HY_TOUCH(tc2, Fg + (size_t)dnext * (size_t)(2 * L), 2 * L * 2 / 128, 0); } }
    HY_CONV(XS);
    sink ^= tc1 ^ tc2;
    { const float bias1 = bias[2048 + d];
      if (fr < NB) {
#pragma unroll
        for (int i = 0; i < TPW; ++i) { const int t0 = HY_T0(i) + 4 * fq;
            const u32x2 x2 = *(const LDSP u32x2*)(VS + fr * VSROW + t0 * 2), v1 = *(const LDSP u32x2*)(XS + fr * VSROW + t0 * 2);
            u32x2 w; w.x = pk_bf16(bf_lo(x2.x) * (acc[i][0] + bias1 * bf_lo(v1.x)), bf_hi(x2.x) * (acc[i][1] + bias1 * bf_hi(v1.x)));
            w.y = pk_bf16(bf_lo(x2.y) * (acc[i][2] + bias1 * bf_lo(v1.y)), bf_hi(x2.y) * (acc[i][3] + bias1 * bf_hi(v1.y)));
            *(u32x2*)(VOT + (size_t)d * T + tokbase + fr * L + t0) = w; } } }
    __syncthreads();
#undef HY_TOUCH
#undef HY_LD
#undef HY_LDW
#undef HY_ST
#undef HY_FLD
#undef HY_FST
#undef HY_FENCE
#undef HY_PINW
#undef HY_PINF
#undef HY_CONV
#undef HY_AFRAG
#undef HY_T0
}
__device__ __forceinline__ void hy_conv_phase(LDSP unsigned char* lds, const bf16_t* ZT, const bf16_t* F, const float* short_w, const float* short_b, const float* bias, bf16_t* VOT, unsigned* sinkp) {
    unsigned sink = 0u;
    for (int u = blockIdx.x; u < 2048 + 512; u += gridDim.x) {
        if (u < 2048) hy_conv_unit<8, 2048, true, 8>(lds, u, TC, ZT, F + (size_t)2 * 2048 * 512, short_w, short_b, bias, VOT, u + (int)gridDim.x < 2048 ? u + (int)gridDim.x : -1, sink);
        else hy_conv_unit<16, 256, false, 2>(lds, 4 * (u - 2048), 0, ZT, F, short_w, short_b, bias, VOT, -1, sink);
    }
    if (sink == 0x9e3779b9u) *sinkp = sink;
}
__device__ __forceinline__ void transpose_phase(LDSP unsigned char* lds, const bf16_t* __restrict__ VOT, bf16_t* __restrict__ VO) {
    constexpr int NTB = 8, TSZ = 64 * 66;
    LDSP bf16_t* tiles = (LDSP bf16_t*)lds;
    const int tid = threadIdx.x;
    for (int t0 = blockIdx.x * NTB; t0 < 32 * 320; t0 += gridDim.x * NTB) {
        u32x4 v[NTB];
        { const int r = tid >> 3, part = tid & 7;
#pragma unroll
          for (int i = 0; i < NTB; ++i) { const int t = t0 + i, d0 = (t & 31) * 64, k0 = (t >> 5) * 64; v[i] = *(const u32x4*)(VOT + (size_t)(d0 + r) * T + k0 + part * 8); }
#pragma unroll
          for (int i = 0; i < NTB; ++i) { LDSP bf16_t* dst = tiles + i * TSZ + r * 66 + part * 8;
            dst[0] = (bf16_t)(v[i].x & 0xffff); dst[1] = (bf16_t)(v[i].x >> 16); dst[2] = (bf16_t)(v[i].y & 0xffff); dst[3] = (bf16_t)(v[i].y >> 16);
            dst[4] = (bf16_t)(v[i].z & 0xffff); dst[5] = (bf16_t)(v[i].z >> 16); dst[6] = (bf16_t)(v[i].w & 0xffff); dst[7] = (bf16_t)(v[i].w >> 16); } }
        __syncthreads();
        { const int tok = tid >> 3, part = tid & 7;
#pragma unroll
          for (int i = 0; i < NTB; ++i) { const int t = t0 + i, d0 = (t & 31) * 64, k0 = (t >> 5) * 64; unsigned e[8];
#pragma unroll
            for (int j = 0; j < 8; ++j) e[j] = tiles[i * TSZ + (part * 8 + j) * 66 + tok];
            u32x4 w; w.x = e[0] | (e[1] << 16); w.y = e[2] | (e[3] << 16); w.z = e[4] | (e[5] << 16); w.w = e[6] | (e[7] << 16);
            *(u32x4*)(VO + (size_t)(k0 + tok) * D + d0 + part * 8) = w; } }
        __syncthreads();
    }
}

__device__ __forceinline__ unsigned f2sort(float f) { const unsigned u = __float_as_uint(f); return u ^ ((u >> 31) ? 0xffffffffu : 0x80000000u); }
__device__ __forceinline__ float sort2f(unsigned s) { return __uint_as_float((s & 0x80000000u) ? (s ^ 0x80000000u) : ~s); }
__device__ __forceinline__ unsigned umax4(unsigned v) { const unsigned a = __shfl_xor(v, 16); v = v > a ? v : a; const unsigned b = __shfl_xor(v, 32); return v > b ? v : b; }

template <int N> __device__ __forceinline__ void bitonic_sort_desc(unsigned (&v)[N]) {
#pragma unroll
    for (int k = 2; k <= N; k <<= 1)
#pragma unroll
        for (int j = k >> 1; j > 0; j >>= 1)
#pragma unroll
            for (int i = 0; i < N; ++i) { const int l = i ^ j;
                if (l > i) { const unsigned x = v[i], y = v[l], mx = x > y ? x : y, mn = x > y ? y : x; if ((i & k) == 0) { v[i] = mx; v[l] = mn; } else { v[i] = mn; v[l] = mx; } } }
}
__device__ __forceinline__ void merge_top16(unsigned (&v)[16], int xr) {
    unsigned c[16];
#pragma unroll
    for (int i = 0; i < 16; ++i) { const unsigned p = (unsigned)__shfl_xor((int)v[15 - i], xr); c[i] = v[i] > p ? v[i] : p; }
#pragma unroll
    for (int j = 8; j > 0; j >>= 1)
#pragma unroll
        for (int i = 0; i < 16; ++i) { const int l = i ^ j; if (l > i) { const unsigned x = c[i], y = c[l]; c[i] = x > y ? x : y; c[l] = x > y ? y : x; } }
#pragma unroll
    for (int i = 0; i < 16; ++i) v[i] = c[i];
}
__device__ __forceinline__ void cvt_row_i4(const f32x4 (&v)[8], int row, unsigned char* __restrict__ dst, float* __restrict__ scale_inv, int lane);
__device__ __forceinline__ void cvt_row_fp4(const f32x4 (&v)[8], int row, unsigned char* __restrict__ dst, float* __restrict__ scale_inv, int lane);
__device__ __forceinline__ void peer_select_phase(LDSP unsigned char* lds, const bf16_t* __restrict__ PQ, const bf16_t* __restrict__ KEYS  , int* __restrict__ EID, float* __restrict__ GATE,
        int next_layer = -1, const float* __restrict__ cu = nullptr, const float* __restrict__ cv = nullptr, unsigned char* __restrict__ tu = nullptr, unsigned char* __restrict__ tv = nullptr, float* __restrict__ tsc = nullptr) {
    constexpr int KR = 272;
    const int tid = threadIdx.x, lane = tid & 63, wave = tid >> 6, fr = lane & 15, fq = lane >> 4;
    const int h = blockIdx.x & 7, rk = blockIdx.x >> 3, nblk = ((int)gridDim.x - h + 7) >> 3, tstride = nblk * 8;
    for (int c = tid; c < 256 * 16; c += NTH) { const int row = c >> 4, part = c & 15; *(LDSP u32x4*)(lds + row * KR + part * 16) = *(const u32x4*)(KEYS + ((size_t)(h * 2) * 128 + row) * 128 + part * 8); }
    __syncthreads();
    f32x4 cr[8]; int cj = 0;
    const int cgw = __builtin_amdgcn_readfirstlane((int)blockIdx.x * 8 + wave), cnw = (int)gridDim.x * 8, cper = (16384 + cnw - 1) / cnw, cnit = next_layer >= 0 ? 2 * cper : 0;
#define CV_OK(j_) ((j_) < cnit && cgw + ((j_) % cper) * cnw < 16384)
#define CV_ROW(j_) (next_layer * 16384 + cgw + ((j_) % cper) * cnw)
#define CV_ISSUE(j_) do { if (CV_OK(j_)) { const float* sp_ = ((j_) / cper ? cv : cu) + (size_t)CV_ROW(j_) * 2048 + 4 * lane; \
        _Pragma("unroll") for (int q_ = 0; q_ < 8; ++q_) cr[q_] = __builtin_nontemporal_load((const f32x4*)(sp_ + 256 * q_)); } } while (0)
#define CV_FINISH(j_) do { if (CV_OK(j_)) { if ((j_) / cper) cvt_row_fp4(cr, CV_ROW(j_), tv, tsc + 4 * 16384, lane); else cvt_row_i4(cr, CV_ROW(j_), tu, tsc, lane); } } while (0)
#define CV_STEP() do { CV_FINISH(cj); ++cj; CV_ISSUE(cj); } while (0)
    CV_ISSUE(0);
    LDSP int* wsc = (LDSP int*)(lds + 69632 + wave * 2048) + fr * 32;
    int tg = rk * 8 + wave;
    bf16x8 qf[2][4];
    if (tg < T / 16) {
#pragma unroll
        for (int pp = 0; pp < 2; ++pp)
#pragma unroll
            for (int ks = 0; ks < 4; ++ks) qf[pp][ks] = *(const bf16x8*)(PQ + (size_t)(tg * 16 + fr) * D + h * 256 + pp * 128 + 32 * ks + 8 * fq);
    }
    for (; tg < T / 16; tg += tstride) {
        const int tok = tg * 16 + fr;
        f32x4 acc[2][8];
#pragma unroll
        for (int pp = 0; pp < 2; ++pp) {
#pragma unroll
            for (int nt = 0; nt < 8; ++nt) acc[pp][nt] = (f32x4){0.f, 0.f, 0.f, 0.f};
#pragma unroll
            for (int ks = 0; ks < 4; ++ks)
#pragma unroll
                for (int nt = 0; nt < 8; ++nt) { const bf16x8 kf = *(const LDSP bf16x8*)(lds + (pp * 128 + 16 * nt + fr) * KR + (32 * ks + 8 * fq) * 2);
                    acc[pp][nt] = __builtin_amdgcn_mfma_f32_16x16x32_bf16(kf, qf[pp][ks], acc[pp][nt], 0, 0, 0); }
        }
        { const int tgn = tg + tstride < T / 16 ? tg + tstride : tg;
#pragma unroll
          for (int pp = 0; pp < 2; ++pp)
#pragma unroll
              for (int ks = 0; ks < 4; ++ks) qf[pp][ks] = *(const bf16x8*)(PQ + (size_t)(tgn * 16 + fr) * D + h * 256 + pp * 128 + 32 * ks + 8 * fq); }
        unsigned top[2][16];
#pragma unroll
        for (int pp = 0; pp < 2; ++pp) {
            unsigned key[32];
#pragma unroll
            for (int nt = 0; nt < 8; ++nt)
#pragma unroll
                for (int j = 0; j < 4; ++j) key[nt * 4 + j] = (f2sort(acc[pp][nt][j]) & ~127u) | (unsigned)(16 * nt + 4 * fq + j);
            bitonic_sort_desc<32>(key);
#pragma unroll
            for (int i = 0; i < 16; ++i) top[pp][i] = key[i];
            merge_top16(top[pp], 16); merge_top16(top[pp], 32);
            CV_STEP();
        }
        if (fq == 0) {
#pragma unroll
            for (int i = 0; i < 16; ++i) { wsc[i] = (int)(top[0][i] & 127u); wsc[16 + i] = (int)(top[1][i] & 127u); }
        }
        float sA[4];
#pragma unroll
        for (int i = 0; i < 4; ++i) { const unsigned t0 = top[0][4 * i], t1 = top[0][4 * i + 1], t2 = top[0][4 * i + 2], t3 = top[0][4 * i + 3];
            sA[i] = sort2f((fq == 0 ? t0 : fq == 1 ? t1 : fq == 2 ? t2 : t3) & ~127u); }
        unsigned cand[16];
#pragma unroll
        for (int bb = 0; bb < 16; ++bb) cand[bb] = (f2sort(sA[0] + sort2f(top[1][bb] & ~127u)) & ~255u) | (unsigned)(fq << 4) | (unsigned)(15 - bb);
#pragma unroll
        for (int k = 0; k < 5; ++k) {
            const int i = k < 3 ? 1 : k == 3 ? 2 : 3, bb = k < 3 ? k : 0;
            unsigned x = (f2sort(sA[i] + sort2f(top[1][bb] & ~127u)) & ~255u) | (unsigned)((fq + 4 * i) << 4) | (unsigned)(15 - bb);
#pragma unroll
            for (int j = 0; j < 16; ++j) { const unsigned c0 = cand[j], mx = c0 > x ? c0 : x, mn = c0 > x ? x : c0; cand[j] = mx; x = mn; }
        }
        merge_top16(cand, 16); merge_top16(cand, 32);
        WAVE_SYNC();
        float es[16], sum = 0.f; int ids[16];
        const float v0 = sort2f(cand[0] & ~255u);
#pragma unroll
        for (int r = 0; r < 16; ++r) { const unsigned w = cand[r]; es[r] = __expf(sort2f(w & ~255u) - v0); sum += es[r];
            ids[r] = wsc[(w >> 4) & 15u] * 128 + wsc[16 + 15 - (int)(w & 15u)]; }
        const float inv = 1.f / sum;
        if (fq == 0) {
            int* ep = EID + (size_t)tok * 128 + 2 * h; float* gp = GATE + (size_t)tok * 128 + 2 * h;
#pragma unroll
            for (int r = 0; r < 16; ++r) { ep[(r & 7) * 16 + (r >> 3)] = ids[r]; gp[(r & 7) * 16 + (r >> 3)] = es[r] * inv; }
        }
        CV_STEP();
        WAVE_SYNC();
    }
    while (cj < cnit) CV_STEP();
#undef CV_STEP
#undef CV_FINISH
#undef CV_ISSUE
#undef CV_ROW
#undef CV_OK
}

#define PG_FENCE() do { asm volatile("" ::: "memory"); __builtin_amdgcn_sched_barrier(0); } while (0)
#define PE_ISSUE(buf_, tab_, ev_) do { _Pragma("unroll") for (int li_ = 0; li_ < 16; ++li_) { \
        const unsigned e_ = (unsigned)ev_[li_ >> 2][li_ & 3]; buf_[li_] = *(const u32x4*)((tab_) + (size_t)(e_ * 128u + sub16)); } } while (0)
#define PE_LOADE(ev_, n_) do { const int t_ = PE_TOK(n_); const u32x4* ep_ = (const u32x4*)(EID + (size_t)t_ * 128 + grp * 16); ev_[0] = ep_[0]; ev_[1] = ep_[1]; ev_[2] = ep_[2]; ev_[3] = ep_[3]; } while (0)
#define PE_TOK(n_) (((n_) < ntok ? t0 + (n_) * tstride : t0))

__device__ __forceinline__ void peer_u_phase(const unsigned* __restrict__ X8, const float* __restrict__ SX, const unsigned char* __restrict__ TU, const int* __restrict__ EID, bf16_t* __restrict__ PA) {
    const int lane = threadIdx.x & 63, wave = threadIdx.x >> 6, grp = lane >> 3, sub = lane & 7;
    const int vx = blockIdx.x & 7, rk = blockIdx.x >> 3, nblk = ((int)gridDim.x - vx + 7) >> 3, tstride = nblk * 8, t0 = rk * 8 + wave;
    const int ntok = t0 < T ? (T - t0 + tstride - 1) / tstride : 0, npair = (ntok + 1) >> 1;
    {
        const int s = vx;
        const unsigned char* tab = TU + (size_t)s * 16384 * 128 + 16 * sub;
        const unsigned* xb8 = X8 + 64 * s + 8 * sub;
        bf16_t* pab = PA + (size_t)s * T * 128 + grp * 16;
        u32x4 b0[16], b1[16], xa0, xb0, xa1, xb1, ev[4], evn[4];
        float sx0, sx1;
        int p_[16], xs_;
#define PU_ISSUE_Q(buf_, ev_, q_) do { _Pragma("unroll") for (int li_ = 4 * (q_); li_ < 4 * (q_) + 4; ++li_) { \
        const unsigned e_ = (unsigned)ev_[li_ >> 2][li_ & 3]; buf_[li_] = *(const u32x4*)(tab + (size_t)(e_ * 128u)); } } while (0)
#define PU_ISSUE(buf_, ev_) do { PU_ISSUE_Q(buf_, ev_, 0); PU_ISSUE_Q(buf_, ev_, 1); PU_ISSUE_Q(buf_, ev_, 2); PU_ISSUE_Q(buf_, ev_, 3); } while (0)
#define PU_LOADX(xa_, xb_, sx_, n_) do { const int t_ = PE_TOK(n_); xa_ = *(const u32x4*)(xb8 + (size_t)t_ * 512); xb_ = *(const u32x4*)(xb8 + (size_t)t_ * 512 + 4); sx_ = SX[t_]; } while (0)
#define PU_D4(w_, xlo_, xhi_, a_) do { a_ = __builtin_amdgcn_sdot4((int)((w_) & 0x0f0f0f0fu), (int)(xlo_), a_, false); a_ = __builtin_amdgcn_sdot4((int)(((w_) >> 4) & 0x0f0f0f0fu), (int)(xhi_), a_, false); } while (0)
#define PU_BEGIN(xa_, xb_) do { \
            xs_ = __builtin_amdgcn_sdot4(0x01010101, (int)xa_.x, 0, false); xs_ = __builtin_amdgcn_sdot4(0x01010101, (int)xa_.y, xs_, false); \
            xs_ = __builtin_amdgcn_sdot4(0x01010101, (int)xa_.z, xs_, false); xs_ = __builtin_amdgcn_sdot4(0x01010101, (int)xa_.w, xs_, false); \
            xs_ = __builtin_amdgcn_sdot4(0x01010101, (int)xb_.x, xs_, false); xs_ = __builtin_amdgcn_sdot4(0x01010101, (int)xb_.y, xs_, false); \
            xs_ = __builtin_amdgcn_sdot4(0x01010101, (int)xb_.z, xs_, false); xs_ = __builtin_amdgcn_sdot4(0x01010101, (int)xb_.w, xs_, false); xs_ *= -8; } while (0)
#define PU_ROWS(buf_, xa_, xb_, q_) do { _Pragma("unroll") for (int li_ = 4 * (q_); li_ < 4 * (q_) + 4; ++li_) { const u32x4 q4_ = buf_[li_]; int a_ = xs_; \
                PU_D4(q4_.x, xa_.x, xa_.y, a_); PU_D4(q4_.y, xa_.z, xa_.w, a_); PU_D4(q4_.z, xb_.x, xb_.y, a_); PU_D4(q4_.w, xb_.z, xb_.w, a_); p_[li_] = a_; } } while (0)
#define PU_END(sx_, n_) do { \
            int v8_[8], v4_[4], v2_[2]; \
            _Pragma("unroll") for (int i_ = 0; i_ < 8; ++i_) { const bool up_ = sub & 4; const int keep_ = up_ ? p_[i_ + 8] : p_[i_], send_ = up_ ? p_[i_] : p_[i_ + 8]; v8_[i_] = keep_ + dpp_i<0x141>(send_); } \
            _Pragma("unroll") for (int i_ = 0; i_ < 4; ++i_) { const bool up_ = sub & 2; const int keep_ = up_ ? v8_[i_ + 4] : v8_[i_], send_ = up_ ? v8_[i_] : v8_[i_ + 4]; v4_[i_] = keep_ + dpp_i<0x4E>(send_); } \
            _Pragma("unroll") for (int i_ = 0; i_ < 2; ++i_) { const bool up_ = sub & 1; const int keep_ = up_ ? v4_[i_ + 2] : v4_[i_], send_ = up_ ? v4_[i_] : v4_[i_ + 2]; v2_[i_] = keep_ + dpp_i<0xB1>(send_); } \
            f32x2 r_ = {(float)v2_[0] * sx_, (float)v2_[1] * sx_}; \
            if ((n_) < ntok) { const int lb_ = 2 * (sub & 1) + 4 * ((sub >> 1) & 1) + 8 * ((sub >> 2) & 1); *(unsigned*)(pab + (size_t)(t0 + (n_) * tstride) * 128 + lb_) = pk_bf16(r_.x, r_.y); } \
            asm volatile("" : "+v"(r_) :: "memory"); } while (0)
#define PU_KEEP(dst_, src_) do { dst_[0] = src_[0]; dst_[1] = src_[1]; dst_[2] = src_[2]; dst_[3] = src_[3]; } while (0)
#define PU_STEP(bc_, xac_, xbc_, sxc_, bn_, xan_, xbn_, sxn_, n_) do { \
            PU_BEGIN(xac_, xbc_); \
            PE_LOADE(evn, (n_) + 2); PU_ISSUE_Q(bn_, ev, 0); PG_FENCE(); PU_ROWS(bc_, xac_, xbc_, 0); PG_FENCE(); \
            PU_ISSUE_Q(bn_, ev, 1); PG_FENCE(); PU_ROWS(bc_, xac_, xbc_, 1); PG_FENCE(); \
            PU_ISSUE_Q(bn_, ev, 2); PG_FENCE(); PU_ROWS(bc_, xac_, xbc_, 2); PG_FENCE(); \
            PU_ISSUE_Q(bn_, ev, 3); PU_LOADX(xan_, xbn_, sxn_, (n_) + 1); PG_FENCE(); PU_ROWS(bc_, xac_, xbc_, 3); PU_END(sxc_, n_); PU_KEEP(ev, evn); PG_FENCE(); } while (0)
        if (ntok > 0) {
            PE_LOADE(ev, 0); PU_ISSUE(b0, ev); PU_LOADX(xa0, xb0, sx0, 0); PE_LOADE(ev, 1);
#pragma unroll 1
            for (int pr = 0; pr < npair; ++pr) {
                const int n = 2 * pr;
                PU_STEP(b0, xa0, xb0, sx0, b1, xa1, xb1, sx1, n);
                PU_STEP(b1, xa1, xb1, sx1, b0, xa0, xb0, sx0, n + 1);
            }
        }
#undef PU_STEP
#undef PU_KEEP
#undef PU_END
#undef PU_ROWS
#undef PU_BEGIN
#undef PU_ISSUE_Q
#undef PU_D4
#undef PU_LOADX
#undef PU_ISSUE
    }
}

__device__ __forceinline__ void peer_act_phase(const bf16_t* __restrict__ PA, const int* __restrict__ EID, const float* __restrict__ USC, const float* __restrict__ VSC, float* GATE, float* __restrict__ ISC) {
    const int n4 = T * 128 / 4, stride = gridDim.x * NTH;
    for (int i = blockIdx.x * NTH + threadIdx.x; i < n4; i += stride) {
        f32x4 acc = (f32x4){0.f, 0.f, 0.f, 0.f};
#pragma unroll
        for (int s = 0; s < 8; ++s) { const u32x2 p = *(const u32x2*)(PA + (size_t)s * T * 128 + (size_t)i * 4); acc += (f32x4){bf_lo(p.x), bf_hi(p.x), bf_lo(p.y), bf_hi(p.y)}; }
        const u32x4 e = *(const u32x4*)(EID + (size_t)i * 4); const f32x4 g = *(const f32x4*)(GATE + (size_t)i * 4);
        f32x4 w;
        w[0] = gelu_tanh(acc[0] * USC[e.x]) * g[0] * VSC[e.x]; w[1] = gelu_tanh(acc[1] * USC[e.y]) * g[1] * VSC[e.y];
        w[2] = gelu_tanh(acc[2] * USC[e.z]) * g[2] * VSC[e.z]; w[3] = gelu_tanh(acc[3] * USC[e.w]) * g[3] * VSC[e.w];
        float mx = fmaxf(fmaxf(fabsf(w[0]), fabsf(w[1])), fmaxf(fabsf(w[2]), fabsf(w[3])));
        mx = fmaxf(mx, __shfl_xor(mx, 1)); mx = fmaxf(mx, __shfl_xor(mx, 2)); mx = fmaxf(mx, __shfl_xor(mx, 4)); mx = fmaxf(mx, __shfl_xor(mx, 8)); mx = fmaxf(mx, __shfl_xor(mx, 16));
        const unsigned ex = __float_as_uint(mx) >> 23; const float sc = __uint_as_float((254u - ex) << 23);
        u32x4 o;
#pragma unroll
        for (int j = 0; j < 4; ++j) o[j] = (e[j] & 0xffffu) | ((unsigned)__builtin_bit_cast(unsigned short, (_Float16)(w[j] * sc)) << 16);
        *(u32x4*)(GATE + (size_t)i * 4) = o;
        if ((threadIdx.x & 31) == 0) ISC[i >> 5] = __uint_as_float(ex << 23);
    }
}

__device__ __forceinline__ void peer_v_phase(const unsigned char* __restrict__ TV, const int* __restrict__ EID  , const float* __restrict__ ISC, const float* __restrict__ g2  , const bf16_t* X, bf16_t* Xw) {
    const int lane = threadIdx.x & 63, wave = threadIdx.x >> 6, grp = lane >> 3, sub = lane & 7; const unsigned sub16 = 16u * sub;
    const int vx = blockIdx.x & 7, rk = blockIdx.x >> 3, nblk = ((int)gridDim.x - vx + 7) >> 3, tstride = nblk * 8, t0 = rk * 8 + wave;
    const int ntok = t0 < T ? (T - t0 + tstride - 1) / tstride : 0, npair = (ntok + 1) >> 1;
    {
        const int s = vx;
        const unsigned char* tab = TV + (size_t)s * 16384 * 128;
        const int colb = 256 * s + 32 * sub + 4 * grp;
        u32x4 b0[16], b1[16], ev[4], evn[4];
        u32x4 e0[4], e1[4]; u32x2 xo0, xo1; float is0, is1; f32x4 gg0, gg1;
#define PV_ISSUE_Q(buf_, ev_, q_) do { _Pragma("unroll") for (int li_ = 4 * (q_); li_ < 4 * (q_) + 4; ++li_) { \
            const unsigned e_ = (unsigned)ev_[li_ >> 2][li_ & 3] & 0xffffu; buf_[li_] = *(const u32x4*)(tab + (size_t)(e_ * 128u + sub16)); } } while (0)
#define PV_KEEP(keep_, ev_) do { keep_[0] = ev_[0]; keep_[1] = ev_[1]; keep_[2] = ev_[2]; keep_[3] = ev_[3]; } while (0)
#define PV_ISSUE(buf_, keep_, ev_) do { PV_ISSUE_Q(buf_, ev_, 0); PV_ISSUE_Q(buf_, ev_, 1); PV_ISSUE_Q(buf_, ev_, 2); PV_ISSUE_Q(buf_, ev_, 3); PV_KEEP(keep_, ev_); } while (0)
#define PV_LOADX(xo_, is_, gg_, n_) do { const int t_ = PE_TOK(n_); xo_ = *(const u32x2*)(X + (size_t)t_ * D + colb); is_ = ISC[t_]; gg_ = *(const f32x4*)(g2 + (size_t)cond_of(t_) * 4 * 12288 + colb); } while (0)
#define PV_CVT(w_, s_) __builtin_bit_cast(h2_t, __builtin_amdgcn_cvt_scalef32_pk_f16_fp4((w_), 1.0f, s_))
#define PV_DW(w_, o0_, o1_, o2_, o3_) do { o0_ = __builtin_elementwise_fma(PV_CVT(w_, 0), w2_, o0_); o1_ = __builtin_elementwise_fma(PV_CVT(w_, 1), w2_, o1_); \
            o2_ = __builtin_elementwise_fma(PV_CVT(w_, 2), w2_, o2_); o3_ = __builtin_elementwise_fma(PV_CVT(w_, 3), w2_, o3_); } while (0)
        h2_t o_[16];
#define PV_BEGIN() do { _Pragma("unroll") for (int j_ = 0; j_ < 16; ++j_) o_[j_] = (h2_t){(_Float16)0.f, (_Float16)0.f}; } while (0)
#define PV_ROWS(buf_, wv_, q_) do { _Pragma("unroll") for (int li_ = 4 * (q_); li_ < 4 * (q_) + 4; ++li_) { const u32x4 q4_ = buf_[li_]; unsigned ww_ = wv_[li_ >> 2][li_ & 3]; asm volatile("" : "+v"(ww_));   \
                const _Float16 wk_ = __builtin_bit_cast(h2_t, ww_).y; const h2_t w2_ = {wk_, wk_}; \
                PV_DW(q4_.x, o_[0], o_[1], o_[2], o_[3]); PV_DW(q4_.y, o_[4], o_[5], o_[6], o_[7]); PV_DW(q4_.z, o_[8], o_[9], o_[10], o_[11]); PV_DW(q4_.w, o_[12], o_[13], o_[14], o_[15]); } } while (0)
#define PV_END(xo_, isc_, gg_, n_) do { \
            h2_t v8_[8], v4_[4], v2_[2]; \
            _Pragma("unroll") for (int i_ = 0; i_ < 8; ++i_) v8_[i_] = xsum32h(o_[i_], o_[i_ + 8]); \
            _Pragma("unroll") for (int i_ = 0; i_ < 4; ++i_) v4_[i_] = xsum16h(v8_[i_], v8_[i_ + 4]); \
            _Pragma("unroll") for (int i_ = 0; i_ < 2; ++i_) { const bool up_ = grp & 1; const h2_t keep_ = up_ ? v4_[i_ + 2] : v4_[i_], send_ = up_ ? v4_[i_] : v4_[i_ + 2]; \
                v2_[i_] = keep_ + __builtin_bit_cast(h2_t, dpp_i<0x128>(__builtin_bit_cast(int, send_))); } \
            f32x4 r_ = {(float)v2_[0].x, (float)v2_[0].y, (float)v2_[1].x, (float)v2_[1].y}; r_ = r_ * isc_; \
            if ((n_) < ntok) { const int t_ = t0 + (n_) * tstride; const f32x4 g_ = gg_; \
                const f32x4 xf_ = {bf_lo(xo_.x), bf_hi(xo_.x), bf_lo(xo_.y), bf_hi(xo_.y)}; const f32x4 y_ = xf_ + g_ * r_; u32x2 yo_; yo_.x = pk_bf16(y_[0], y_[1]); yo_.y = pk_bf16(y_[2], y_[3]); *(u32x2*)(Xw + (size_t)t_ * D + colb) = yo_; } \
            asm volatile("" : "+v"(r_) :: "memory"); } while (0)
#define PV_STEP(bc_, ec_, xoc_, isc_, ggc_, bn_, en_, xon_, isn_, ggn_, n_) do { \
            PV_BEGIN(); \
            PE_LOADE(evn, (n_) + 2); PV_ISSUE_Q(bn_, ev, 0); PG_FENCE(); PV_ROWS(bc_, ec_, 0); PG_FENCE(); \
            PV_ISSUE_Q(bn_, ev, 1); PG_FENCE(); PV_ROWS(bc_, ec_, 1); PG_FENCE(); \
            PV_ISSUE_Q(bn_, ev, 2); PG_FENCE(); PV_ROWS(bc_, ec_, 2); PG_FENCE(); \
            PV_ISSUE_Q(bn_, ev, 3); PV_KEEP(en_, ev); PV_LOADX(xon_, isn_, ggn_, (n_) + 1); PG_FENCE(); PV_ROWS(bc_, ec_, 3); PV_END(xoc_, isc_, ggc_, n_); PV_KEEP(ev, evn); PG_FENCE(); } while (0)
        if (ntok > 0) {
            PE_LOADE(ev, 0); PV_ISSUE(b0, e0, ev); PV_LOADX(xo0, is0, gg0, 0); PE_LOADE(ev, 1);
#pragma unroll 1
            for (int pr = 0; pr < npair; ++pr) {
                const int n = 2 * pr;
                PV_STEP(b0, e0, xo0, is0, gg0, b1, e1, xo1, is1, gg1, n);
                PV_STEP(b1, e1, xo1, is1, gg1, b0, e0, xo0, is0, gg0, n + 1);
            }
        }
#undef PV_STEP
#undef PV_END
#undef PV_ROWS
#undef PV_BEGIN
#undef PV_KEEP
#undef PV_ISSUE_Q
#undef PV_DW
#undef PV_CVT
#undef PV_LOADX
#undef PV_ISSUE
    }
}
#undef PE_TOK
#undef PE_LOADE
#undef PE_ISSUE


__device__ __forceinline__ void cvt_row_i4(const f32x4 (&v)[8], int row, unsigned char* __restrict__ dst, float* __restrict__ scale_inv, int lane) {
        float mx = 0.f, ss = 0.f;
#pragma unroll
        for (int q = 0; q < 8; ++q) { mx = fmaxf(mx, fmaxf(fmaxf(fabsf(v[q][0]), fabsf(v[q][1])), fmaxf(fabsf(v[q][2]), fabsf(v[q][3])))); ss += v[q][0] * v[q][0] + v[q][1] * v[q][1] + v[q][2] * v[q][2] + v[q][3] * v[q][3]; }
        mx = fmaxf(mx, __shfl_xor(mx, 32)); mx = fmaxf(mx, __shfl_xor(mx, 16)); mx = fmaxf(mx, __shfl_xor(mx, 8)); mx = fmaxf(mx, __shfl_xor(mx, 4)); mx = fmaxf(mx, __shfl_xor(mx, 2)); mx = fmaxf(mx, __shfl_xor(mx, 1));
        ss = wave_sum(ss);
        float step = fminf(0.36f * sqrtf(ss * (1.f / 2048.f)), mx * (1.f / 7.f)); if (!(step > 0.f)) step = 1.f;
        const float sc = 1.f / step;
        const int layer = row >> 14, e = row & 16383;
#pragma unroll
        for (int q = 0; q < 8; ++q) {
            unsigned nib = 0u;
#pragma unroll
            for (int j = 0; j < 4; ++j) { int qi = (int)rintf(v[q][j] * sc); qi = qi < -7 ? -7 : qi > 7 ? 7 : qi; nib |= (unsigned)(qi + 8) << (8 * j); }
            const unsigned other = (unsigned)__shfl_xor((int)nib, 1);
            if ((lane & 1) == 0) *(unsigned*)(dst + (((size_t)layer * 8 + q) * 16384 + e) * 128 + 4 * (lane >> 1)) = nib | (other << 4); }
        if (lane == 0) scale_inv[row] = step;
}
__device__ __forceinline__ void cvt_table_i4(const float* __restrict__ src, unsigned char* __restrict__ dst, float* __restrict__ scale_inv, int row_lo, int nrows  ) {
    const int lane = threadIdx.x & 63, gw = row_lo + blockIdx.x * 8 + (threadIdx.x >> 6), nw = gridDim.x * 8;
    f32x4 vn[8];
    if (gw < nrows) {
#pragma unroll
        for (int q = 0; q < 8; ++q) vn[q] = __builtin_nontemporal_load((const f32x4*)(src + (size_t)gw * 2048 + 256 * q + 4 * lane)); }
    for (int row = gw; row < nrows; row += nw) {
        f32x4 v[8];
#pragma unroll
        for (int q = 0; q < 8; ++q) v[q] = vn[q];
        { const int rn = row + nw < nrows ? row + nw : row;
#pragma unroll
          for (int q = 0; q < 8; ++q) vn[q] = __builtin_nontemporal_load((const f32x4*)(src + (size_t)rn * 2048 + 256 * q + 4 * lane)); }
        asm volatile("" ::: "memory"); __builtin_amdgcn_sched_barrier(0);
        cvt_row_i4(v, row, dst, scale_inv, lane);
    }
}

__device__ __forceinline__ void cvt_row_fp4(const f32x4 (&v)[8], int row, unsigned char* __restrict__ dst, float* __restrict__ scale_inv, int lane) {
        float mx = 0.f, ss = 0.f;
#pragma unroll
        for (int q = 0; q < 8; ++q) { mx = fmaxf(mx, fmaxf(fmaxf(fabsf(v[q][0]), fabsf(v[q][1])), fmaxf(fabsf(v[q][2]), fabsf(v[q][3])))); ss += v[q][0] * v[q][0] + v[q][1] * v[q][1] + v[q][2] * v[q][2] + v[q][3] * v[q][3]; }
        mx = fmaxf(mx, __shfl_xor(mx, 32)); mx = fmaxf(mx, __shfl_xor(mx, 16)); mx = fmaxf(mx, __shfl_xor(mx, 8)); mx = fmaxf(mx, __shfl_xor(mx, 4)); mx = fmaxf(mx, __shfl_xor(mx, 2)); mx = fmaxf(mx, __shfl_xor(mx, 1));
        ss = wave_sum(ss);
        float unit = fminf(0.48f * sqrtf(ss * (1.f / 2048.f)), mx * (1.f / 6.f)); if (!(unit > 0.f)) unit = 1.f;
        const float sc = 1.f / unit;
        const int layer = row >> 14, e = row & 16383;
#pragma unroll
        for (int q = 0; q < 8; ++q) {
            const float c0 = fminf(fmaxf(v[q][0] * sc, -6.f), 6.f), c1 = fminf(fmaxf(v[q][1] * sc, -6.f), 6.f), c2 = fminf(fmaxf(v[q][2] * sc, -6.f), 6.f), c3 = fminf(fmaxf(v[q][3] * sc, -6.f), 6.f);
            unsigned p = 0u;
            p = __builtin_amdgcn_cvt_scalef32_pk_fp4_f32(p, c0, c1, 1.0f, 0); p = __builtin_amdgcn_cvt_scalef32_pk_fp4_f32(p, c2, c3, 1.0f, 1);
            const unsigned other = (unsigned)__shfl_xor((int)p, 1);
            if ((lane & 1) == 0) *(unsigned*)(dst + (((size_t)layer * 8 + q) * 16384 + e) * 128 + 4 * (lane >> 1)) = (p & 0xffffu) | (other << 16); }
        if (lane == 0) scale_inv[row] = unit;
}
__device__ __forceinline__ void cvt_table_fp4(const float* __restrict__ src, unsigned char* __restrict__ dst, float* __restrict__ scale_inv, int row_lo, int nrows  ) {
    const int lane = threadIdx.x & 63, gw = row_lo + blockIdx.x * 8 + (threadIdx.x >> 6), nw = gridDim.x * 8;
    f32x4 vn[8];
    if (gw < nrows) {
#pragma unroll
        for (int q = 0; q < 8; ++q) vn[q] = __builtin_nontemporal_load((const f32x4*)(src + (size_t)gw * 2048 + 256 * q + 4 * lane)); }
    for (int row = gw; row < nrows; row += nw) {
        f32x4 v[8];
#pragma unroll
        for (int q = 0; q < 8; ++q) v[q] = vn[q];
        { const int rn = row + nw < nrows ? row + nw : row;
#pragma unroll
          for (int q = 0; q < 8; ++q) vn[q] = __builtin_nontemporal_load((const f32x4*)(src + (size_t)rn * 2048 + 256 * q + 4 * lane)); }
        asm volatile("" ::: "memory"); __builtin_amdgcn_sched_barrier(0);
        cvt_row_fp4(v, row, dst, scale_inv, lane);
    }
}

#ifndef MK_PER_PHASE
#define MK_PER_PHASE 0
#endif
constexpr int N_PHASES = 47;
#ifndef DUP
#define DUP 0
#endif
struct Args { const float* in[N_IN]; float* out; unsigned char* ws; int lo, hi; };
static_assert(sizeof(Args) == (N_IN + 2) * 8 + 8, "Args has padding");

template <int LAYER>
__device__ __forceinline__ void peer_phases(int sub, LDSP unsigned char* lds, const Args& a, float* mod) {
    unsigned char* ws = a.ws; unsigned char* scr = ws + WS_SCR;
    bf16_t* X = (bf16_t*)(ws + WS_X); bf16_t* H = (bf16_t*)(ws + WS_H);
    const unsigned char* TU = ws + WS_UT + (size_t)LAYER * 16384 * (D / 2); const unsigned char* TV = ws + WS_VTAB + (size_t)LAYER * 16384 * (D / 2);
    const float* USC = (const float*)(ws + WS_TSC) + LAYER * 16384; const float* VSC = (const float*)(ws + WS_TSC) + (4 + LAYER) * 16384;
    int* EID = (int*)(ws + WS_EID); float* GATE = (float*)(ws + WS_GATE); bf16_t* PA = (bf16_t*)(scr + SC_PA);
    if (sub == 0) norm_phase<true>(nullptr, nullptr, X, a.in[I_N2G] + LAYER * D, mod + LAYER * 12288 + 6144, nullptr, (unsigned*)(scr + SC_X8), (float*)(scr + SC_SX));
    else if (sub == 1) run_gemm_i8_tok(lds, scr + SC_X8, ws + WS_PEERQ + (size_t)LAYER * D * D, 2048,
                                    FStoreBf16Scaled{(bf16_t*)(scr + SC_PQ), D, (const float*)(scr + SC_SX), (const float*)(ws + WS_PEERQ + 4 * (size_t)2048 * 2048) + LAYER * 2048});
    else if (sub == 2) peer_select_phase(lds, (const bf16_t*)(scr + SC_PQ), (const bf16_t*)(ws + WS_PKEYS) + (size_t)LAYER * 16 * 128 * 128, EID, GATE,
                                            LAYER < 3 ? LAYER + 1 : -1, a.in[I_PU], a.in[I_PV], ws + WS_UT, ws + WS_VTAB, (float*)(ws + WS_TSC));
    else if (sub == 3) { if (DUP & 1) peer_u_phase((const unsigned*)(scr + SC_X8), (const float*)(scr + SC_SX), TU, EID, PA); peer_u_phase((const unsigned*)(scr + SC_X8), (const float*)(scr + SC_SX), TU, EID, PA); }
    else if (sub == 4) peer_act_phase(PA, EID, USC, VSC, GATE, (float*)(scr + SC_ISC));
    else { if (DUP & 1) peer_v_phase(TV, (const int*)GATE, (const float*)(scr + SC_ISC), mod + LAYER * 12288 + 10240, X, (bf16_t*)(scr + 300 * MB)); peer_v_phase(TV, (const int*)GATE, (const float*)(scr + SC_ISC), mod + LAYER * 12288 + 10240, X, X); }
}

template <int PH>
__global__ void __launch_bounds__(NTH, 2) mk_fwd(Args a) {
    extern __shared__ __attribute__((aligned(16))) unsigned char lds_raw[];
    LDSP unsigned char* lds = (LDSP unsigned char*)lds_raw;
    unsigned char* ws = a.ws; unsigned char* scr = ws + WS_SCR;
    float* mod = (float*)(ws + WS_MOD); float* rope = (float*)(ws + WS_ROPE);
    bf16_t* X = (bf16_t*)(ws + WS_X); bf16_t* H = (bf16_t*)(ws + WS_H);
    const float* xp = a.in[I_XP]; const float* xs = a.in[I_XS];
    volatile LAS unsigned* xbw = (volatile LAS unsigned*)(lds + LDS_BYTES - 16);
    if (threadIdx.x == 0) { xbw[0] = 0u; xbw[1] = 0u; xbw[2] = 0u; xbw[3] = 0u; }
    __syncthreads();
    XcdBarrier bar; bar.bar = (unsigned*)(ws + WS_CTL); bar.x = 0; bar.st = xbw;
    if (!MK_PER_PHASE) bar = xcd_barrier_post((unsigned*)(ws + WS_CTL), xbw);
    const int lo = a.lo, hi = a.hi;
#ifndef ONLY
#define ONLY -1
#endif
#ifndef STOP_AFTER
#define STOP_AFTER 46
#endif
#define IN(k) ((PH < 0 || PH == (k)) && (ONLY < 0 || ONLY == (k)) && ((k) <= STOP_AFTER || (k) == 46) && lo <= (k) && (k) < hi)
#ifndef SEAMX
#define SEAMX 1
#endif
#define SEAM(k) do { if (!MK_PER_PHASE && IN((k) + 1)) { xcd_barrier(bar); if (SEAMX > 1) xcd_barrier(bar); } } while (0)

    if (IN(0)) {
#ifndef P0REP
#define P0REP 0
#endif
#define P0R(i) for (int rep_ = 0; rep_ < (((P0REP) >> (i)) & 1 ? 2 : 1); ++rep_)
        P0R(0) mod_phase(lds, a.in[I_CCTX], a.in[I_C], a.in[I_MODW], a.in[I_MODB], mod);
        rope_tables(rope);
        P0R(1) hy_filter_phase(lds, a.in[I_HFW1], a.in[I_HFB1], a.in[I_HFFREQ], a.in[I_HFW2], a.in[I_HFB2], a.in[I_HFW3], a.in[I_HLD], (bf16_t*)(ws + WS_HYF));
        P0R(2) cvt_transpose_all((LDSP float*)lds, a.in, ws);
        P0R(3) cvt_transpose_i8(lds, a.in[I_PWQ], ws + WS_PEERQ, (float*)(ws + WS_PEERQ + 4 * (size_t)2048 * 2048), 4);
        cvt_direct(a.in[I_PKEYS], (bf16_t*)(ws + WS_PKEYS), (size_t)4 * 16 * 128 * 128);
        P0R(4) { cvt_table_i4(a.in[I_PU], ws + WS_UT, (float*)(ws + WS_TSC), 0, 16384);
                 cvt_table_fp4(a.in[I_PV], ws + WS_VTAB, (float*)(ws + WS_TSC) + 4 * 16384, 0, 16384); }
        SEAM(0);
    }
    if (IN(1)) { norm_phase<false>(xp, xs, nullptr, a.in[I_N1G], mod, H); SEAM(1); }
    if (IN(2)) { run_gemm(lds, H, (const bf16_t*)(ws + WS_WDOWN), T, 1280, D, FStoreBf16{(bf16_t*)(scr + SC_DOWN), 1280}); SEAM(2); }
    if (IN(3)) { mla_rows_phase((const bf16_t*)(scr + SC_DOWN), a.in[I_MGQ], a.in[I_MGKV], a.in[I_CCKV], a.in[I_CKPE], rope, (bf16_t*)(scr + SC_CQ), (bf16_t*)(scr + SC_CKV), (bf16_t*)(scr + SC_KPE),
                                a.out + OUT_CKV, a.out + OUT_KPE); SEAM(3); }
    if (IN(4)) {
        run_gemm(lds, (const bf16_t*)(scr + SC_CQ), (const bf16_t*)(ws + WS_WUQ), T, 3072, 512, FMlaQ{(bf16_t*)(scr + SC_MQ), rope});
        run_gemm(lds, (const bf16_t*)(scr + SC_CKV), (const bf16_t*)(ws + WS_WUK), NKEY, 2048, 512, FStoreBf16{(bf16_t*)(scr + SC_KN), 2048});
        run_gemm(lds, (const bf16_t*)(ws + WS_WUV), (const bf16_t*)(scr + SC_CKV), 2048, NKEY, 512, FStoreBf16{(bf16_t*)(scr + SC_MVT), NKEY});
        SEAM(4); }
    if (IN(5)) { if (DUP & 4) attn_phase<0>(lds, (const bf16_t*)(scr + SC_MQ), (const bf16_t*)(scr + SC_KN), (const bf16_t*)(scr + SC_KPE), (const bf16_t*)(scr + SC_MVT), (bf16_t*)(scr + SC_MO), nullptr);
        attn_phase<0>(lds, (const bf16_t*)(scr + SC_MQ), (const bf16_t*)(scr + SC_KN), (const bf16_t*)(scr + SC_KPE), (const bf16_t*)(scr + SC_MVT), (bf16_t*)(scr + SC_MO), nullptr); SEAM(5); }
    if (IN(6)) { run_gemm_tok(lds, (const bf16_t*)(scr + SC_MO), (const bf16_t*)(ws + WS_WOMLA), D, FResidIn{xp, xs, X, mod + 0 * 12288 + 4096}); SEAM(6); }
    if (IN(7)) { peer_phases<0>(0, lds, a, mod); SEAM(7); }
    if (IN(8)) { peer_phases<0>(1, lds, a, mod); SEAM(8); }
    if (IN(9)) { peer_phases<0>(2, lds, a, mod); SEAM(9); }
    if (IN(10)) { peer_phases<0>(3, lds, a, mod); SEAM(10); }
    if (IN(11)) { peer_phases<0>(4, lds, a, mod); SEAM(11); }
    if (IN(12)) { peer_phases<0>(5, lds, a, mod); SEAM(12); }
    if (IN(13)) { norm_phase<true>(nullptr, nullptr, X, a.in[I_N1G] + 1 * D, mod + 1 * 12288, H); SEAM(13); }
    if (IN(14)) { run_gemm_tok(lds, H, (const bf16_t*)(ws + WS_S5IN), D, FStoreBf16{(bf16_t*)(scr + SC_U), D}); SEAM(14); }
    if (IN(15)) { if (DUP & 8) s5_scan_phase(lds, (const bf16_t*)(scr + SC_U), (bf16_t*)(scr + SC_YF), (bf16_t*)(scr + SC_YB), a.in, a.out);
        s5_scan_phase(lds, (const bf16_t*)(scr + SC_U), (bf16_t*)(scr + SC_YF), (bf16_t*)(scr + SC_YB), a.in, a.out); SEAM(15); }
    if (IN(16)) { s5_combine_phase((const bf16_t*)(scr + SC_U), (const bf16_t*)(scr + SC_YF), (const bf16_t*)(scr + SC_YB), a.in[I_S5D], (bf16_t*)(scr + SC_Z)); SEAM(16); }
    if (IN(17)) { run_gemm_tok(lds, (const bf16_t*)(scr + SC_Z), (const bf16_t*)(ws + WS_S5GATE), D, FS5Gate{(const bf16_t*)(scr + SC_Z), (bf16_t*)(scr + SC_ZZ)}); SEAM(17); }
    if (IN(18)) { run_gemm_tok(lds, (const bf16_t*)(scr + SC_ZZ), (const bf16_t*)(ws + WS_S5OUT), D, FResid{X, mod + 1 * 12288 + 4096}); SEAM(18); }
    if (IN(19)) { peer_phases<1>(0, lds, a, mod); SEAM(19); }
    if (IN(20)) { peer_phases<1>(1, lds, a, mod); SEAM(20); }
    if (IN(21)) { peer_phases<1>(2, lds, a, mod); SEAM(21); }
    if (IN(22)) { peer_phases<1>(3, lds, a, mod); SEAM(22); }
    if (IN(23)) { peer_phases<1>(4, lds, a, mod); SEAM(23); }
    if (IN(24)) { peer_phases<1>(5, lds, a, mod); SEAM(24); }
    if (IN(25)) { norm_phase<true>(nullptr, nullptr, X, a.in[I_N1G] + 2 * D, mod + 2 * 12288, H); SEAM(25); }
    if (IN(26)) { run_gemm_tailhalf(lds, (const bf16_t*)(ws + WS_HYIN), H, 6144, T, D, FStoreBf16RowBias{(bf16_t*)(scr + SC_ZT), T, a.in[I_HBIN]}); SEAM(26); }
    if (IN(27)) { if (DUP & 16) hy_conv_phase(lds, (const bf16_t*)(scr + SC_ZT), (const bf16_t*)(ws + WS_HYF), a.in[I_HSW], a.in[I_HSB], a.in[I_HBIAS], (bf16_t*)(scr + SC_VOT), (unsigned*)(ws + WS_CTL + 32768));
        hy_conv_phase(lds, (const bf16_t*)(scr + SC_ZT), (const bf16_t*)(ws + WS_HYF), a.in[I_HSW], a.in[I_HSB], a.in[I_HBIAS], (bf16_t*)(scr + SC_VOT), (unsigned*)(ws + WS_CTL + 32768)); SEAM(27); }
    if (IN(28)) { transpose_phase(lds, (const bf16_t*)(scr + SC_VOT), (bf16_t*)(scr + SC_VO)); SEAM(28); }
    if (IN(29)) { run_gemm_tok(lds, (const bf16_t*)(scr + SC_VO), (const bf16_t*)(ws + WS_HYOUT), D, FResid{X, mod + 2 * 12288 + 4096}); SEAM(29); }
    if (IN(30)) { peer_phases<2>(0, lds, a, mod); SEAM(30); }
    if (IN(31)) { peer_phases<2>(1, lds, a, mod); SEAM(31); }
    if (IN(32)) { peer_phases<2>(2, lds, a, mod); SEAM(32); }
    if (IN(33)) { peer_phases<2>(3, lds, a, mod); SEAM(33); }
    if (IN(34)) { peer_phases<2>(4, lds, a, mod); SEAM(34); }
    if (IN(35)) { peer_phases<2>(5, lds, a, mod); SEAM(35); }
    if (IN(36)) {
        norm_phase<true>(nullptr, nullptr, X, a.in[I_N1G] + 3 * D, mod + 3 * 12288, H);
        {
            bf16_t* KALL = (bf16_t*)(scr + SC_SK); bf16_t* VTs = (bf16_t*)(scr + SC_SVT);
            const float* ck = a.in[I_CSK]; const float* cv = a.in[I_CSV];
            for (int i = blockIdx.x * NTH + threadIdx.x; i < 8 * 256 * 512; i += gridDim.x * NTH) {
                const int c = i & 511, pos = (i >> 9) & 255, b = i >> 17, krow = TC + b * 2304 + 2048 + pos;
                { const int hh = c >> 7, p = c & 127, pi = p >> 1, aa = pi >> 5, f = pi & 31, orig = hh * 128 + 64 * aa + f + 32 * (p & 1); KALL[(size_t)krow * 512 + c] = f2bf(ck[(size_t)(b * 256 + pos) * 512 + orig]); }
                VTs[(size_t)c * NKEY + krow] = f2bf(cv[(size_t)(b * 256 + pos) * 512 + c]);
            }
        }
        SEAM(36); }
    if (IN(37)) {
        run_gemm(lds, H, (const bf16_t*)(ws + WS_SWAQKV), T, 2560, D, FSwaQK{(bf16_t*)(scr + SC_SQ), (bf16_t*)(scr + SC_SK), a.out + OUT_SWAK, rope + 2048});
        run_gemm(lds, (const bf16_t*)(ws + WS_SWAQKV) + (size_t)2560 * D, H, 512, T, D, FSwaVT{(bf16_t*)(scr + SC_SVT), a.out + OUT_SWAV}, gridDim.x == 256 ? 32 : 0);
        SEAM(37); }
    if (IN(38)) { if (DUP & 4) attn_phase<1>(lds, (const bf16_t*)(scr + SC_SQ), (const bf16_t*)(scr + SC_SK), nullptr, (const bf16_t*)(scr + SC_SVT), (bf16_t*)(scr + SC_SO), a.in[I_SSINK]);
        attn_phase<1>(lds, (const bf16_t*)(scr + SC_SQ), (const bf16_t*)(scr + SC_SK), nullptr, (const bf16_t*)(scr + SC_SVT), (bf16_t*)(scr + SC_SO), a.in[I_SSINK]); SEAM(38); }
    if (IN(39)) { run_gemm_tok(lds, (const bf16_t*)(scr + SC_SO), (const bf16_t*)(ws + WS_SWAO), D, FResid{X, mod + 3 * 12288 + 4096}); SEAM(39); }
    if (IN(40)) { peer_phases<3>(0, lds, a, mod); SEAM(40); }
    if (IN(41)) { peer_phases<3>(1, lds, a, mod); SEAM(41); }
    if (IN(42)) { peer_phases<3>(2, lds, a, mod); SEAM(42); }
    if (IN(43)) { peer_phases<3>(3, lds, a, mod); SEAM(43); }
    if (IN(44)) { peer_phases<3>(4, lds, a, mod); SEAM(44); }
    if (IN(45)) { peer_phases<3>(5, lds, a, mod); SEAM(45); }
    if (IN(46)) { final_norm_phase(X, a.in[I_FING], a.out + OUT_Y); }
#undef IN
#undef SEAM
}

#ifndef REP_LO
#define REP_LO 0ull
#endif
template <int P> static void launch_phase(const Args& a, int grid, hipStream_t stream) {
    static bool attr = false;
    if (!attr) { (void)hipFuncSetAttribute((const void*)mk_fwd<P>, hipFuncAttributeMaxDynamicSharedMemorySize, LDS_BYTES); attr = true; }
    hipLaunchKernelGGL(mk_fwd<P>, dim3(grid), dim3(NTH), LDS_BYTES, stream, a);
}
#if MK_PER_PHASE
template <int P> static void launch_all(Args a, int grid, hipStream_t stream) {
    if constexpr (P < N_PHASES) {
        a.lo = P; a.hi = P + 1;
        launch_phase<P>(a, grid, stream);
        if ((REP_LO >> P) & 1ull) launch_phase<P>(a, grid, stream);
        launch_all<P + 1>(a, grid, stream);
    }
}
#endif
extern "C" void kernel_launch(void* const* d_in, const int* in_sizes, int n_in, void* d_out, int out_size, void* d_ws, size_t ws_size, hipStream_t stream) {
    static int grid = 0;
    if (grid == 0) {
        if (n_in != N_IN || (size_t)out_size != OUT_END || ws_size < WS_END) { fprintf(stderr, "kernel_launch: unexpected shapes: n_in %d out %d ws %zu (need %zu)\n", n_in, out_size, ws_size, (size_t)WS_END); grid = -1; return; }
        int dev = 0, cus = 0;
        if (hipGetDevice(&dev) != hipSuccess || hipDeviceGetAttribute(&cus, hipDeviceAttributeMultiprocessorCount, dev) != hipSuccess) { grid = -1; return; }
        grid = cus;
    }
    if (grid < 0) return;
    (void)hipMemsetAsync((char*)d_ws + WS_CTL, 0, 65536, stream);
    Args a{};
    for (int i = 0; i < N_IN; ++i) a.in[i] = (const float*)d_in[i];
    a.out = (float*)d_out; a.ws = (unsigned char*)d_ws;
#if MK_PER_PHASE
    launch_all<0>(a, grid, stream);
#else
    a.lo = 0; a.hi = N_PHASES;
    launch_phase<-1>(a, grid, stream);
#endif
    const hipError_t le = hipPeekAtLastError();
    if (le != hipSuccess) fprintf(stderr, "kernel_launch: launch failed: %s\n", hipGetErrorName(le));
}
```

```cpp
#include <hip/hip_runtime.h>
#include <cstdio>
#include <cstdint>
#define MK_PER_PHASE 0
namespace pg8 {
#define PG8_LAS __attribute__((address_space(3)))
typedef unsigned short bf16_t;
typedef short bf16x8 __attribute__((ext_vector_type(8)));
typedef float f32x4 __attribute__((ext_vector_type(4)));
typedef unsigned u32x4 __attribute__((ext_vector_type(4)));
constexpr int BM = 256, BK = 64, HALF = 128, HTB = HALF * BK * 2  , STAGE_BYTES = 8 * HTB, NXCD = 8, WGM = 8;

__host__ __device__ __forceinline__ int lds_byte(int r, int c) { const int st = (r >> 4) * 2 + (c >> 5), rr = r & 15, cc = c & 31, ob = rr * 64 + cc * 2; return st * 1024 + (ob ^ (((ob >> 9) & 1) << 5)); }
__host__ __device__ __forceinline__ void stage_rc(int b, int& R, int& C) { const int st = b / 1024, sb = b % 1024, swz = sb ^ (((sb >> 9) & 1) << 5); R = (st >> 1) * 16 + swz / 64; C = (st & 1) * 32 + (swz % 64) / 2; }
__host__ __device__ __forceinline__ int perm32(int rho) { const int n = rho >> 4, i = rho & 15; return 8 * (i >> 2) + 4 * n + (i & 3); }

struct Unit { int pm, pn, arow, half; };
struct Gemm { const bf16_t* A; const bf16_t* Bt; int M, N, K; };

struct StaticOrder {
    int nM, nN, nwg, G, c;
    __host__ __device__ void init(int M, int N, int G_, int c_) { nM = M / BM; nN = N / BM; nwg = nM * nN; G = G_; c = c_; }
    __host__ __device__ int remap(int wgid) const { const int q = nwg / NXCD, r = nwg % NXCD, xcd = wgid % NXCD, off = wgid / NXCD; return (xcd < r ? xcd * (q + 1) : r * (q + 1) + (xcd - r) * q) + off; }
    __host__ __device__ void decode(int wgid, Unit& u) const {
        const int nig = WGM * nN, gid = wgid / nig, fm = gid * WGM, gsz = (nM - fm) < WGM ? (nM - fm) : WGM;
        u.pm = fm + ((wgid % nig) % gsz); u.pn = (wgid % nig) / gsz; u.arow = u.pm * BM; u.half = 0;
    }
    __host__ __device__ bool next(int i, Unit& u) const {
        const long L = (long)i * G + c; if (L >= nwg) return false;
        decode(remap((int)L), u); return true;
    }
    __device__ __forceinline__ void a_ready(const Unit&) const {}
    __device__ __forceinline__ void done(const Unit&) const {}
};
struct TailHalfOrder {
    StaticOrder so; int nfull, nh, G, c;
    __host__ __device__ void init(int M, int N, int nh_, int G_, int c_) { so.init(M, N, G_, c_); nh = nh_; nfull = so.nwg - nh_; G = G_; c = c_; }
    __host__ __device__ bool next(int i, Unit& u) const {
        const long L = (long)i * G + c;
        if (L < nfull) { so.decode(so.remap((int)L), u); return true; }
        const long h = L - nfull; if (h >= 2 * nh) return false;
        const int x = (int)(h % NXCD), r = (int)(h / NXCD), q = so.nwg / NXCD;
        so.decode(x * q + (q - nh / NXCD) + (r >> 1), u); u.arow += (r & 1) * HALF; u.half = 1; return true;
    }
    __device__ __forceinline__ void a_ready(const Unit&) const {}
    __device__ __forceinline__ void done(const Unit&) const {}
};
struct HalfOrder {
    StaticOrder so; int nN, nhalf, G, c;
    __host__ __device__ void init(int Mfull, int M, int N, int G_, int c_) { so.init(Mfull, N, G_, c_); nN = N / BM; nhalf = ((M - Mfull) / HALF) * nN; G = G_; c = c_; }
    __host__ __device__ bool next(int i, Unit& u) const {
        if (so.next(i, u)) return true;
        const long L = (long)i * G + c - so.nwg; if (L < 0 || L >= nhalf) return false;
        const int hm = (int)(L / nN); u.pn = (int)(L % nN); u.pm = so.nM + (hm >> 1); u.arow = so.nM * BM + hm * HALF; u.half = 1; return true;
    }
    __device__ __forceinline__ void a_ready(const Unit&) const {}
    __device__ __forceinline__ void done(const Unit&) const {}
};
typedef int i32x4 __attribute__((ext_vector_type(4)));
template <bool I8> __device__ __forceinline__ f32x4 pg8_mma(bf16x8 a, bf16x8 b, f32x4 c) { return __builtin_amdgcn_mfma_f32_16x16x32_bf16(a, b, c, 0, 0, 0); }
template <bool I8> __device__ __forceinline__ i32x4 pg8_mma(bf16x8 a, bf16x8 b, i32x4 c) { return __builtin_amdgcn_mfma_i32_16x16x64_i8(__builtin_bit_cast(i32x4, a), __builtin_bit_cast(i32x4, b), c, 0, 0, 0); }
template <bool I8> struct AccSel { typedef f32x4 type; };
template <> struct AccSel<true> { typedef i32x4 type; };
template <class Epi, class Sched, bool ALIGN_EPI = false, bool SP2 = false, bool I8 = false>
__device__ __forceinline__ void gemm_phase(PG8_LAS unsigned char* lds, const Gemm g, const Sched& S, const Epi& E) {
    const int tid = threadIdx.x, wid = __builtin_amdgcn_readfirstlane(tid >> 6), lane = tid & 63, wr = wid >> 2, wc = wid & 3, fr = lane & 15, fq = lane >> 4;
    const int K = g.K, nt = K / BK;
    unsigned voffA[2], voffB[2];
#pragma unroll
    for (int i = 0; i < 2; ++i) { int R, C; stage_rc(tid * 16 + i * 8192, R, C); const int Rb = Epi::PERM ? ((R & ~31) + perm32(R & 31)) : R;
        voffA[i] = (unsigned)(R * K + C) * 2u; voffB[i] = (unsigned)(Rb * K + C) * 2u; }
    const size_t kstep = (size_t)(BK * 2);
    const size_t hstep = (size_t)HALF * K * 2;
    const size_t tstep = 2 * hstep;
    const unsigned ldsw = (unsigned)wid * 1024u;
    const int aoff = lds_byte(wr * 64 + fr, fq * 8), boff = lds_byte(wc * 32 + fr, fq * 8);
#define PG8_SA(b, h) (((b) * 2 + (h)) * HTB)
#define PG8_SB(b, h) ((4 + (b) * 2 + (h)) * HTB)
#define PG8_STAGE(bufoff, gbase, voff) do { _Pragma("unroll") for (int _i = 0; _i < 2; ++_i) \
        __builtin_amdgcn_global_load_lds((const unsigned*)((const char*)(gbase) + (voff)[_i]), (PG8_LAS unsigned*)(lds + (bufoff) + ldsw + _i * 8192), 16, 0, 0); } while (0)
#define PG8_LDA(dst, b, h) do { _Pragma("unroll") for (int m = 0; m < 4; ++m) _Pragma("unroll") for (int k = 0; k < 2; ++k) dst[m][k] = *(const PG8_LAS bf16x8*)(lds + PG8_SA(b, h) + aoff + m * 2048 + k * 1024); } while (0)
#define PG8_LDB(dst, b, h) do { _Pragma("unroll") for (int n = 0; n < 2; ++n) _Pragma("unroll") for (int k = 0; k < 2; ++k) dst[n][k] = *(const PG8_LAS bf16x8*)(lds + PG8_SB(b, h) + boff + n * 2048 + k * 1024); } while (0)
#define PG8_MMA(ai, bj, At, Bt) do { __builtin_amdgcn_s_setprio(1); _Pragma("unroll") for (int m = 0; m < 4; ++m) _Pragma("unroll") for (int n = 0; n < 2; ++n) _Pragma("unroll") for (int k = 0; k < 2; ++k) \
        acc[ai][bj][m][n] = pg8_mma<I8>(Bt[n][k], At[m][k], acc[ai][bj][m][n]); __builtin_amdgcn_s_setprio(0); } while (0)
#define PG8_WAIT_V(n) asm volatile("s_waitcnt vmcnt(" #n ")" ::: "memory")
#define PG8_WAIT_L(n) asm volatile("s_waitcnt lgkmcnt(" #n ")" ::: "memory")
#define PG8_BAR __builtin_amdgcn_s_barrier()
#define PG8_SCHED __builtin_amdgcn_sched_barrier(0)
    Unit cur, nxt; int ui = 0;
    if (!S.next(0, cur)) return;
    typedef typename AccSel<I8>::type acc_t;
    acc_t acc[2][2][4][2];
#pragma unroll
    for (int a = 0; a < 2; ++a)
#pragma unroll
        for (int b = 0; b < 2; ++b)
#pragma unroll
            for (int m = 0; m < 4; ++m)
#pragma unroll
                for (int n = 0; n < 2; ++n) acc[a][b][m][n] = (acc_t){0, 0, 0, 0};
    bf16x8 At[4][2], B0[2][2], B1[2][2];
    const char* cA = (const char*)g.A + (size_t)cur.arow * K * 2; const char* cB = (const char*)g.Bt + (size_t)cur.pn * tstep;
    size_t hsA_c = cur.half ? 0 : hstep;
    S.a_ready(cur);
    if constexpr (SP2) {
        PG8_STAGE(PG8_SB(0, 0), cB, voffB); PG8_STAGE(PG8_SB(0, 1), cB + hstep, voffB); PG8_STAGE(PG8_SA(0, 0), cA, voffA); PG8_STAGE(PG8_SA(0, 1), cA + hsA_c, voffA);
        if (wr == 1) PG8_BAR;
        PG8_WAIT_V(2); PG8_BAR;
        PG8_STAGE(PG8_SB(1, 0), cB + kstep, voffB); PG8_STAGE(PG8_SA(1, 0), cA + kstep, voffA); PG8_STAGE(PG8_SB(1, 1), cB + hstep + kstep, voffB);
        PG8_WAIT_V(6); PG8_BAR;
    } else {
        PG8_STAGE(PG8_SB(0, 0), cB, voffB); PG8_STAGE(PG8_SA(0, 0), cA, voffA); PG8_STAGE(PG8_SB(0, 1), cB + hstep, voffB); PG8_STAGE(PG8_SA(0, 1), cA + hstep, voffA);
        if (wr == 1) PG8_BAR;
        PG8_WAIT_V(4); PG8_BAR;
        PG8_STAGE(PG8_SB(1, 0), cB + kstep, voffB); PG8_STAGE(PG8_SA(1, 0), cA + kstep, voffA); PG8_STAGE(PG8_SB(1, 1), cB + hstep + kstep, voffB);
        PG8_WAIT_V(6); PG8_BAR;
    }
    for (;;) {
        const bool has_next = S.next(ui + 1, nxt);
        const char* nA = has_next ? (const char*)g.A + (size_t)nxt.arow * K * 2 : cA; const size_t hsA_n = has_next ? (nxt.half ? 0 : hstep) : hsA_c; const bool full = !cur.half; const char* nB = has_next ? (const char*)g.Bt + (size_t)nxt.pn * tstep : cB;
        for (int t = 0; t < nt; t += 2) {
            const bool last = (t == nt - 2);
            const char* a1 = cA + (size_t)(t + 1) * kstep;
            const char* a2 = last ? nA : cA + (size_t)(t + 2) * kstep; const char* b2 = last ? nB : cB + (size_t)(t + 2) * kstep;
            const char* a3 = a2 + kstep; const char* b3 = b2 + kstep;
            if (last && has_next) S.a_ready(nxt);
            if constexpr (SP2) {
            PG8_LDB(B0, 0, 0); PG8_LDB(B1, 0, 1); PG8_SCHED; PG8_LDA(At, 0, 0); PG8_STAGE(PG8_SA(1, 1), a1 + hsA_c, voffA);
            PG8_WAIT_V(8); PG8_WAIT_L(0); PG8_BAR; PG8_MMA(0, 0, At, B0); PG8_MMA(0, 1, At, B1); PG8_BAR; PG8_SCHED;
            if (full) PG8_LDA(At, 0, 1); PG8_STAGE(PG8_SB(0, 0), b2, voffB); PG8_STAGE(PG8_SB(0, 1), b2 + hstep, voffB); PG8_STAGE(PG8_SA(0, 0), a2, voffA);
            PG8_WAIT_V(8); PG8_WAIT_L(0); PG8_BAR; if (full) { PG8_MMA(1, 0, At, B0); PG8_MMA(1, 1, At, B1); } PG8_BAR; PG8_SCHED;
            PG8_LDB(B0, 1, 0); PG8_LDB(B1, 1, 1); PG8_SCHED; PG8_LDA(At, 1, 0); PG8_STAGE(PG8_SA(0, 1), a2 + (last ? hsA_n : hsA_c), voffA);
            PG8_WAIT_V(8); PG8_WAIT_L(0); PG8_BAR; PG8_MMA(0, 0, At, B0); PG8_MMA(0, 1, At, B1); PG8_BAR; PG8_SCHED;
            if (full) PG8_LDA(At, 1, 1); PG8_STAGE(PG8_SB(1, 0), b3, voffB); PG8_STAGE(PG8_SB(1, 1), b3 + hstep, voffB); PG8_STAGE(PG8_SA(1, 0), a3, voffA);
            PG8_WAIT_V(8); PG8_WAIT_L(0); PG8_BAR; if (full) { PG8_MMA(1, 0, At, B0); PG8_MMA(1, 1, At, B1); } PG8_BAR; PG8_SCHED;
            } else {
            PG8_LDB(B0, 0, 0); PG8_SCHED; PG8_LDA(At, 0, 0); PG8_STAGE(PG8_SA(1, 1), a1 + hstep, voffA);
            PG8_WAIT_L(8); PG8_BAR; PG8_WAIT_L(0); PG8_MMA(0, 0, At, B0); PG8_BAR; PG8_SCHED;
            PG8_LDB(B1, 0, 1); PG8_STAGE(PG8_SB(0, 0), b2, voffB);
            PG8_BAR; PG8_WAIT_L(0); PG8_MMA(0, 1, At, B1); PG8_BAR;
            PG8_LDA(At, 0, 1); PG8_STAGE(PG8_SA(0, 0), a2, voffA);
            PG8_BAR; PG8_WAIT_L(0); PG8_MMA(1, 0, At, B0); PG8_BAR; PG8_SCHED;
            PG8_STAGE(PG8_SB(0, 1), b2 + hstep, voffB);
            PG8_WAIT_V(6); PG8_BAR; PG8_MMA(1, 1, At, B1); PG8_BAR;
            PG8_LDB(B0, 1, 0); PG8_SCHED; PG8_LDA(At, 1, 0); PG8_STAGE(PG8_SA(0, 1), a2 + hstep, voffA);
            PG8_WAIT_L(8); PG8_BAR; PG8_WAIT_L(0); PG8_MMA(0, 0, At, B0); PG8_BAR; PG8_SCHED;
            PG8_LDB(B1, 1, 1); PG8_STAGE(PG8_SB(1, 0), b3, voffB);
            PG8_BAR; PG8_WAIT_L(0); PG8_MMA(0, 1, At, B1); PG8_BAR;
            PG8_LDA(At, 1, 1); PG8_STAGE(PG8_SA(1, 0), a3, voffA);
            PG8_BAR; PG8_WAIT_L(0); PG8_MMA(1, 0, At, B0); PG8_BAR; PG8_SCHED;
            PG8_STAGE(PG8_SB(1, 1), b3 + hstep, voffB);
            PG8_WAIT_V(6); PG8_BAR; PG8_MMA(1, 1, At, B1); PG8_BAR;
            }
        }
        if constexpr (ALIGN_EPI) { if (wr == 0) PG8_BAR; }
        if constexpr (!Epi::AFTER_DRAIN) { E(acc, cur, wr, wc, fr, fq); S.done(cur); }
        if (!has_next) break;
#pragma unroll
        for (int a = 0; a < 2; ++a)
#pragma unroll
            for (int b = 0; b < 2; ++b)
#pragma unroll
                for (int m = 0; m < 4; ++m)
#pragma unroll
                    for (int n = 0; n < 2; ++n) acc[a][b][m][n] = (acc_t){0, 0, 0, 0};
        cur = nxt; cA = nA; cB = nB; hsA_c = hsA_n; ++ui;
        if constexpr (ALIGN_EPI) { if (wr == 1) PG8_BAR; }
    }
    PG8_WAIT_V(0);
    if constexpr (!ALIGN_EPI) { if (wr == 0) PG8_BAR; }
    PG8_BAR;
    if constexpr (Epi::AFTER_DRAIN) { E.fused(acc, cur, wr, wc, fr, fq, lds, wid, lane); S.done(cur); }
#undef PG8_SA
#undef PG8_SB
#undef PG8_STAGE
#undef PG8_LDA
#undef PG8_LDB
#undef PG8_MMA
#undef PG8_WAIT_V
#undef PG8_WAIT_L
#undef PG8_BAR
#undef PG8_SCHED
}
}

#define LDSP __attribute__((address_space(3)))
typedef unsigned short bf16_t;
typedef short bf16x8 __attribute__((ext_vector_type(8)));
typedef float f32x4 __attribute__((ext_vector_type(4)));
typedef float f32x2 __attribute__((ext_vector_type(2)));
typedef unsigned u32x4 __attribute__((ext_vector_type(4)));
typedef unsigned u32x2 __attribute__((ext_vector_type(2)));
typedef __bf16 bf16x2_t __attribute__((ext_vector_type(2)));

constexpr int D = 2048, TC = 4096, TL = 16384, T = TC + TL, NKEY = 22528;
constexpr int NTH = 512;
constexpr int LDS_BYTES = 147456;

constexpr size_t al256(size_t x) { return (x + 255) & ~(size_t)255; }
constexpr size_t MB = 1024 * 1024;
constexpr size_t WS_CTL    = 0;
constexpr size_t WS_MOD    = 65536;
constexpr size_t WS_ROPE   = WS_MOD + al256((size_t)9 * 4 * 12288 * 4);
constexpr size_t WS_WDOWN  = WS_ROPE + 32768;
constexpr size_t WS_WUQ    = WS_WDOWN + (size_t)1280 * 2048 * 2;
constexpr size_t WS_WUK    = WS_WUQ + (size_t)3072 * 512 * 2;
constexpr size_t WS_WUV    = WS_WUK + (size_t)2048 * 512 * 2;
constexpr size_t WS_WOMLA  = WS_WUV + (size_t)2048 * 512 * 2;
constexpr size_t WSZ_SQ    = (size_t)2048 * 2048 * 2;
constexpr size_t WS_S5IN   = WS_WOMLA + WSZ_SQ;
constexpr size_t WS_S5GATE = WS_S5IN + WSZ_SQ;
constexpr size_t WS_S5OUT  = WS_S5GATE + WSZ_SQ;
constexpr size_t WS_HYIN   = WS_S5OUT + WSZ_SQ;
constexpr size_t WS_HYOUT  = WS_HYIN + (size_t)6144 * 2048 * 2;
constexpr size_t WS_SWAQKV = WS_HYOUT + WSZ_SQ;
constexpr size_t WS_SWAO   = WS_SWAQKV + (size_t)3072 * 2048 * 2;
constexpr size_t WS_PEERQ  = WS_SWAO + WSZ_SQ;
constexpr size_t WS_PKEYS  = WS_PEERQ + 4 * WSZ_SQ;
constexpr size_t WS_HYF    = WS_PKEYS + (size_t)4 * 16 * 128 * 128 * 2;
constexpr size_t WS_UT     = WS_HYF + (size_t)2 * 2048 * 512 * 2 + (size_t)2 * 2048 * 4096 * 2;
constexpr size_t WSZ_TAB   = (size_t)4 * 16384 * 2048;
constexpr size_t WS_VTAB   = WS_UT + WSZ_TAB;
constexpr size_t WS_TSC    = WS_VTAB + WSZ_TAB;
constexpr size_t WS_X      = WS_TSC + (size_t)2 * 4 * 16384 * 4;
constexpr size_t WS_H      = WS_X + (size_t)T * D * 4;
constexpr size_t WS_EID    = WS_H + (size_t)T * D * 2;
constexpr size_t WS_GATE   = WS_EID + (size_t)T * 128 * 4;
constexpr size_t WS_SCR    = WS_GATE + (size_t)T * 128 * 4;
constexpr size_t SC_DOWN = 0;
constexpr size_t SC_CQ   = SC_DOWN + (size_t)T * 1280 * 4;
constexpr size_t SC_CKV  = SC_CQ + (size_t)T * 512 * 2;
constexpr size_t SC_KPE  = SC_CKV + (size_t)NKEY * 512 * 2;
constexpr size_t SC_MQ   = SC_KPE + (size_t)NKEY * 64 * 2;
constexpr size_t SC_KN   = SC_MQ + (size_t)T * 3072 * 2;
constexpr size_t SC_MVT  = SC_KN + (size_t)NKEY * 2048 * 2;
constexpr size_t SC_MO   = SC_MVT + (size_t)NKEY * 2048 * 2;
constexpr size_t SC_MLA_END = SC_MO + (size_t)T * D * 2;
constexpr size_t SZ_ACT  = (size_t)T * D * 2;
constexpr size_t SC_U = 0, SC_YF = SZ_ACT, SC_YB = 2 * SZ_ACT, SC_Z = 3 * SZ_ACT, SC_ZZ = 4 * SZ_ACT;
constexpr size_t SC_ZT = 0;
constexpr size_t SC_VOT = SC_ZT + (size_t)6144 * T * 2;
constexpr size_t SC_VO  = SC_VOT + SZ_ACT;
constexpr size_t SC_SQ = 0;
constexpr size_t SC_SK = SZ_ACT;
constexpr size_t SC_SVT = SC_SK + (size_t)NKEY * 512 * 2;
constexpr size_t SC_SO = SC_SVT + (size_t)NKEY * 512 * 2;
constexpr size_t SC_PQ = 0;
constexpr size_t SC_PA = SZ_ACT;
constexpr size_t SC_X8 = 256 * MB;
constexpr size_t SC_SX = 299 * MB;
constexpr size_t SC_ISC = 299 * MB + 131072;
static_assert(SC_PA + (size_t)16 * T * 128 * 4 <= SC_X8 && SC_X8 + (size_t)T * D <= SC_SX, "peer scratch");
constexpr size_t WS_END = WS_SCR + SC_MLA_END;
static_assert(SC_VO + SZ_ACT <= SC_MLA_END && 5 * SZ_ACT <= SC_MLA_END, "scratch");

constexpr size_t OUT_Y = 0;
constexpr size_t OUT_CKV = (size_t)T * D;
constexpr size_t OUT_KPE = OUT_CKV + (size_t)TC * 512;
constexpr size_t OUT_S5RE = OUT_KPE + (size_t)TC * 64;
constexpr size_t OUT_S5IM = OUT_S5RE + (size_t)16 * 2 * 128 * 64;
constexpr size_t OUT_SWAK = OUT_S5IM + (size_t)16 * 2 * 128 * 64;
constexpr size_t OUT_SWAV = OUT_SWAK + (size_t)TC * 512;
constexpr size_t OUT_END = OUT_SWAV + (size_t)TC * 512;

enum { I_XP = 0, I_XS, I_C, I_CCKV, I_CKPE, I_S5RE, I_S5IM, I_CSK, I_CSV, I_CCTX, I_MODW, I_MODB, I_N1G, I_N2G, I_FING,
       I_MWDOWN, I_MGQ, I_MGKV, I_MWUQ, I_MWUKV, I_MWO, I_S5WIN, I_S5LRE, I_S5LIM, I_S5LDT, I_S5BRE, I_S5BIM, I_S5CRE, I_S5CIM, I_S5D, I_S5WG, I_S5WO,
       I_HWIN, I_HBIN, I_HSW, I_HSB, I_HFW1, I_HFB1, I_HFFREQ, I_HFW2, I_HFB2, I_HFW3, I_HLD, I_HBIAS, I_HWOUT, I_SWQKV, I_SWO, I_SSINK,
       I_PWQ, I_PKEYS, I_PU, I_PV, N_IN };

__device__ __forceinline__ unsigned pk_bf16(float lo, float hi) { const f32x2 v = {lo, hi}; return __builtin_bit_cast(unsigned, __builtin_convertvector(v, bf16x2_t)); }
__device__ __forceinline__ bf16_t f2bf(float f) { return (bf16_t)(pk_bf16(f, 0.f) & 0xffffu); }
__device__ __forceinline__ float bf_lo(unsigned w) { return __uint_as_float(w << 16); }
__device__ __forceinline__ float bf_hi(unsigned w) { return __uint_as_float(w & 0xffff0000u); }
__device__ __forceinline__ float bf2f(bf16_t h) { return __uint_as_float((unsigned)h << 16); }
__device__ __forceinline__ float wave_sum(float v) { v += __shfl_xor(v, 32); v += __shfl_xor(v, 16); v += __shfl_xor(v, 8); v += __shfl_xor(v, 4); v += __shfl_xor(v, 2); v += __shfl_xor(v, 1); return v; }
__device__ __forceinline__ float fexp2(float x) { return __builtin_amdgcn_exp2f(x); }
__device__ __forceinline__ float gelu_tanh(float a) { const float u = 1.5957691216057308f * (a + 0.044715f * a * a * a); return a / (1.f + __expf(-u)); }
__device__ __forceinline__ int keyrow_of(int row) { return row < TC ? row : TC + ((row - TC) >> 11) * 2304 + ((row - TC) & 2047); }
__device__ __forceinline__ int cond_of(int row) { return row < TC ? 0 : 1 + ((row - TC) >> 11); }
__device__ __forceinline__ bf16x8 as_bf16x8(u32x4 v) { return __builtin_bit_cast(bf16x8, v); }
template <int CTRL> __device__ __forceinline__ int dpp_i(int x) { return __builtin_amdgcn_update_dpp(0, x, CTRL, 0xf, 0xf, true); }
template <int CTRL> __device__ __forceinline__ float dpp_f(float x) { return __int_as_float(__builtin_amdgcn_update_dpp(0, __float_as_int(x), CTRL, 0xf, 0xf, true)); }
__device__ __forceinline__ float xsum32(float a, float b) { const auto r = __builtin_amdgcn_permlane32_swap(__float_as_uint(a), __float_as_uint(b), false, false); return __uint_as_float(r[0]) + __uint_as_float(r[1]); }
__device__ __forceinline__ float xsum16(float a, float b) { const auto r = __builtin_amdgcn_permlane16_swap(__float_as_uint(a), __float_as_uint(b), false, false); return __uint_as_float(r[0]) + __uint_as_float(r[1]); }
typedef _Float16 h2_t __attribute__((ext_vector_type(2)));
__device__ __forceinline__ h2_t xsum32h(h2_t a, h2_t b) { const auto r = __builtin_amdgcn_permlane32_swap(__builtin_bit_cast(unsigned, a), __builtin_bit_cast(unsigned, b), false, false); unsigned r0 = r[0], r1 = r[1]; asm volatile("" : "+v"(r0), "+v"(r1)); return __builtin_bit_cast(h2_t, r0) + __builtin_bit_cast(h2_t, r1); }
__device__ __forceinline__ h2_t xsum16h(h2_t a, h2_t b) { const auto r = __builtin_amdgcn_permlane16_swap(__builtin_bit_cast(unsigned, a), __builtin_bit_cast(unsigned, b), false, false); unsigned r0 = r[0], r1 = r[1]; asm volatile("" : "+v"(r0), "+v"(r1)); return __builtin_bit_cast(h2_t, r0) + __builtin_bit_cast(h2_t, r1); }
__device__ __forceinline__ float xmax_16_32(float x) {
    auto s = __builtin_amdgcn_permlane16_swap(__float_as_uint(x), __float_as_uint(x), false, false); x = fmaxf(__uint_as_float(s[0]), __uint_as_float(s[1]));
    auto t = __builtin_amdgcn_permlane32_swap(__float_as_uint(x), __float_as_uint(x), false, false); return fmaxf(__uint_as_float(t[0]), __uint_as_float(t[1])); }
#define WAVE_SYNC() do { asm volatile("s_waitcnt lgkmcnt(0)" ::: "memory"); __builtin_amdgcn_wave_barrier(); } while (0)

namespace pg8 {
template <class F> struct EpiFn {
    static constexpr bool PERM = false, AFTER_DRAIN = false;
    F f;
    template <class AccT>
    __device__ __forceinline__ void operator()(const AccT (&acc)[2][2][4][2], const Unit& u, int wr, int wc, int fr, int fq) const {
        const int row0 = u.arow + wr * 64 + fr, col0 = u.pn * BM + wc * 32 + 4 * fq;
#pragma unroll
        for (int ai = 0; ai < 2; ++ai) {
            if (ai == 1 && u.half) break;
#pragma unroll
            for (int m = 0; m < 4; ++m) {
                const int row = row0 + ai * HALF + m * 16;
#pragma unroll
                for (int bj = 0; bj < 2; ++bj)
#pragma unroll
                    for (int n = 0; n < 2; ++n) f(row, col0 + bj * HALF + n * 16, __builtin_convertvector(acc[ai][bj][m][n], f32x4));
            }
        }
    }
};
template <class F> struct EpiFn8 {
    static constexpr bool PERM = true, AFTER_DRAIN = false;
    F f;
    template <class AccT>
    __device__ __forceinline__ void operator()(const AccT (&acc)[2][2][4][2], const Unit& u, int wr, int wc, int fr, int fq) const {
        const int row0 = u.arow + wr * 64 + fr, col0 = u.pn * BM + wc * 32 + 8 * fq;
#pragma unroll
        for (int ai = 0; ai < 2; ++ai) {
            if (ai == 1 && u.half) break;
#pragma unroll
            for (int m = 0; m < 4; ++m) {
                const int row = row0 + ai * HALF + m * 16;
#pragma unroll
                for (int bj = 0; bj < 2; ++bj)
                    f(row, col0 + bj * HALF, __builtin_convertvector(acc[ai][bj][m][0], f32x4), __builtin_convertvector(acc[ai][bj][m][1], f32x4));
            }
        }
    }
};
template <class F, bool W8 = F::W8> struct EpiSelT { using type = EpiFn<F>; };
template <class F> struct EpiSelT<F, true> { using type = EpiFn8<F>; };
template <class F> using EpiSel = typename EpiSelT<F>::type;
}

__device__ __forceinline__ u32x4 pk8_bf16(const f32x4& a, const f32x4& b) { u32x4 w; w.x = pk_bf16(a[0], a[1]); w.y = pk_bf16(a[2], a[3]); w.z = pk_bf16(b[0], b[1]); w.w = pk_bf16(b[2], b[3]); return w; }
struct FStoreF32 { static constexpr bool W8 = false; float* C; int ldc;
    __device__ __forceinline__ void operator()(int row, int col, f32x4 v) const { *(f32x4*)(C + (size_t)row * ldc + col) = v; } };
struct FStoreBf16 { static constexpr bool W8 = true; bf16_t* O; int ldc;
    __device__ __forceinline__ void operator()(int row, int col, f32x4 v, f32x4 v2) const { *(u32x4*)(O + (size_t)row * ldc + col) = pk8_bf16(v, v2); } };
struct FStoreBf16RowBias { static constexpr bool W8 = true; bf16_t* O; int ldc; const float* bias;
    __device__ __forceinline__ void operator()(int row, int col, f32x4 v, f32x4 v2) const { const float b = bias[row]; *(u32x4*)(O + (size_t)row * ldc + col) = pk8_bf16(v + b, v2 + b); } };
struct FResidIn { static constexpr bool W8 = true; const float* xc; const float* xl; bf16_t* X; const float* gate;
    __device__ __forceinline__ void operator()(int row, int col, f32x4 v, f32x4 v2) const {
        const float* xr = (row < TC ? xc + (size_t)row * D : xl + (size_t)(row - TC) * D) + col; const float* gp = gate + (size_t)cond_of(row) * 4 * 12288 + col;
        *(u32x4*)(X + (size_t)row * D + col) = pk8_bf16(*(const f32x4*)xr + *(const f32x4*)gp * v, *(const f32x4*)(xr + 4) + *(const f32x4*)(gp + 4) * v2); } };
struct FResid { static constexpr bool W8 = true; bf16_t* X; const float* gate;
    __device__ __forceinline__ void operator()(int row, int col, f32x4 v, f32x4 v2) const {
        bf16_t* xp = X + (size_t)row * D + col; const float* gp = gate + (size_t)cond_of(row) * 4 * 12288 + col; const u32x4 x = *(const u32x4*)xp;
        const f32x4 x0 = {bf_lo(x.x), bf_hi(x.x), bf_lo(x.y), bf_hi(x.y)}, x1 = {bf_lo(x.z), bf_hi(x.z), bf_lo(x.w), bf_hi(x.w)};
        *(u32x4*)xp = pk8_bf16(x0 + *(const f32x4*)gp * v, x1 + *(const f32x4*)(gp + 4) * v2); } };
__device__ __forceinline__ void rope8(f32x4& v, f32x4& v2, const float* cs, int soff, int f0) {
    const f32x4 c = *(const f32x4*)(cs + f0), s = *(const f32x4*)(cs + soff + f0);
    const float a0 = v[0], b0 = v[1], a1 = v[2], b1 = v[3], a2 = v2[0], b2 = v2[1], a3 = v2[2], b3 = v2[3];
    v[0] = a0 * c[0] - b0 * s[0]; v[1] = a0 * s[0] + b0 * c[0]; v[2] = a1 * c[1] - b1 * s[1]; v[3] = a1 * s[1] + b1 * c[1];
    v2[0] = a2 * c[2] - b2 * s[2]; v2[1] = a2 * s[2] + b2 * c[2]; v2[2] = a3 * c[3] - b3 * s[3]; v2[3] = a3 * s[3] + b3 * c[3];
}
struct FMlaQ { static constexpr bool W8 = true; bf16_t* Q; const float* rope;
    __device__ __forceinline__ void operator()(int row, int col, f32x4 v, f32x4 v2) const {
        const int r = col % 192;
        if (r >= 128 && row >= TC) {
            const int l = (row - TC) & 2047, p = r - 128, pi = p >> 1, a = pi >> 4, f = pi & 15, pos = a ? (l & 63) : (l >> 6);
            rope8(v, v2, rope + pos * 16, 1024, f);
        }
        *(u32x4*)(Q + (size_t)row * 3072 + col) = pk8_bf16(v, v2); } };
struct FS5Gate { static constexpr bool W8 = true; const bf16_t* Z; bf16_t* ZZ;
    __device__ __forceinline__ void operator()(int row, int col, f32x4 v, f32x4 v2) const {
        const u32x4 z = *(const u32x4*)(Z + (size_t)row * D + col);
        f32x4 o, o2;
        o[0] = bf_lo(z.x) / (1.f + __expf(-v[0])); o[1] = bf_hi(z.x) / (1.f + __expf(-v[1])); o[2] = bf_lo(z.y) / (1.f + __expf(-v[2])); o[3] = bf_hi(z.y) / (1.f + __expf(-v[3]));
        o2[0] = bf_lo(z.z) / (1.f + __expf(-v2[0])); o2[1] = bf_hi(z.z) / (1.f + __expf(-v2[1])); o2[2] = bf_lo(z.w) / (1.f + __expf(-v2[2])); o2[3] = bf_hi(z.w) / (1.f + __expf(-v2[3]));
        *(u32x4*)(ZZ + (size_t)row * D + col) = pk8_bf16(o, o2); } };
struct FSwaQK { static constexpr bool W8 = true; bf16_t* Q; bf16_t* KALL; float* outk; const float* rope;
    __device__ __forceinline__ void operator()(int row, int col, f32x4 v, f32x4 v2) const {
        const int p = col & 127, pi = p >> 1, a = pi >> 5, f = pi & 31;
        if (row >= TC) {
            const int l = (row - TC) & 2047, pos = a ? (l & 63) : (l >> 6);
            rope8(v, v2, rope + pos * 32, 2048, f);
        }
        const u32x4 w = pk8_bf16(v, v2);
        if (col < 2048) *(u32x4*)(Q + (size_t)row * D + col) = w;
        else {
            const int kc = col - 2048;
            *(u32x4*)(KALL + (size_t)keyrow_of(row) * 512 + kc) = w;
            if (row < TC) { float* o = outk + (size_t)row * 512 + (kc & ~127) + 64 * a + f;
                f32x4 e, od; e[0] = v[0]; e[1] = v[2]; e[2] = v2[0]; e[3] = v2[2]; od[0] = v[1]; od[1] = v[3]; od[2] = v2[1]; od[3] = v2[3];
                *(f32x4*)o = e; *(f32x4*)(o + 32) = od; }
        } } };
struct FSwaVT { static constexpr bool W8 = true; bf16_t* VT; float* outv;
    __device__ __forceinline__ void operator()(int row, int col, f32x4 v, f32x4 v2) const {
        *(u32x4*)(VT + (size_t)row * NKEY + keyrow_of(col)) = pk8_bf16(v, v2);
        if (col < TC) { float* o = outv + (size_t)col * 512 + row; o[0] = v[0]; o[512] = v[1]; o[1024] = v[2]; o[1536] = v[3]; o[2048] = v2[0]; o[2560] = v2[1]; o[3072] = v2[2]; o[3584] = v2[3]; } } };

struct FStoreBf16Scaled { static constexpr bool W8 = true; bf16_t* O; int ldc; const float* sa; const float* sb;
    __device__ __forceinline__ void operator()(int row, int col, f32x4 v, f32x4 v2) const { const float a = sa[row]; const f32x4 b = *(const f32x4*)(sb + col), b2 = *(const f32x4*)(sb + col + 4);
        *(u32x4*)(O + (size_t)row * ldc + col) = pk8_bf16(v * a * b, v2 * a * b2); } };
template <class F> __device__ __forceinline__ void run_gemm_i8_tok(LDSP unsigned char* lds, const void* A8, const void* B8, int Kb, const F& f) {
    pg8::Gemm g{(const bf16_t*)A8, (const bf16_t*)B8, T, D, Kb / 2}; pg8::EpiSel<F> E{f};
    pg8::HalfOrder S; S.init(TL, T, D, (int)gridDim.x, (int)blockIdx.x); pg8::gemm_phase<pg8::EpiSel<F>, pg8::HalfOrder, true, true, true>(lds, g, S, E);
}
template <class F> __device__ __forceinline__ void run_gemm_i8(LDSP unsigned char* lds, const void* A8, const void* B8, int M, int N, int Kb, const F& f) {
    pg8::Gemm g{(const bf16_t*)A8, (const bf16_t*)B8, M, N, Kb / 2}; pg8::StaticOrder S; S.init(M, N, (int)gridDim.x, (int)blockIdx.x);
    pg8::EpiSel<F> E{f};
    pg8::gemm_phase<pg8::EpiSel<F>, pg8::StaticOrder, true, true, true>(lds, g, S, E);
}
template <class F> __device__ __forceinline__ void run_gemm_tok(LDSP unsigned char* lds, const bf16_t* A, const bf16_t* Bt, int K, const F& f) {
    pg8::Gemm g{A, Bt, T, D, K}; pg8::EpiSel<F> E{f};
    pg8::HalfOrder S; S.init(TL, T, D, (int)gridDim.x, (int)blockIdx.x); pg8::gemm_phase<pg8::EpiSel<F>, pg8::HalfOrder, true, true>(lds, g, S, E);
}
template <class F> __device__ __forceinline__ void run_gemm_tailhalf(LDSP unsigned char* lds, const bf16_t* A, const bf16_t* Bt, int M, int N, int K, const F& f) {
    const int nwg = (M / pg8::BM) * (N / pg8::BM), G = (int)gridDim.x, rem = nwg % G;
    const int nh = (rem * 2 == G && nwg % 8 == 0 && (G / 2) % 8 == 0) ? G / 2 : 0;
    pg8::Gemm g{A, Bt, M, N, K}; pg8::TailHalfOrder S; S.init(M, N, nh, G, (int)blockIdx.x);
    pg8::EpiSel<F> E{f};
    pg8::gemm_phase<pg8::EpiSel<F>, pg8::TailHalfOrder, true, true>(lds, g, S, E);
}
template <class F> __device__ __forceinline__ void run_gemm(LDSP unsigned char* lds, const bf16_t* A, const bf16_t* Bt, int M, int N, int K, const F& f, int rot = 0) {
    pg8::Gemm g{A, Bt, M, N, K}; pg8::StaticOrder S; S.init(M, N, (int)gridDim.x, (int)((blockIdx.x + gridDim.x - rot) % gridDim.x));
    pg8::EpiSel<F> E{f};
    pg8::gemm_phase<pg8::EpiSel<F>, pg8::StaticOrder, true, true>(lds, g, S, E);
}
#define XB_TMO      128
#define XB_XCNT(j)  (256  + 64 * (j))
#define XB_XSUB(j)  (1280 + 64 * (j))
#define XB_XGEN(j)  (2304 + 64 * (j))
#define XB_TOP      3328
#define XB_TOPGEN   3392
#define XCD_BAR_WORDS 3456
#define XB_SPIN_CAP (1u << 22)
#define LAS __attribute__((address_space(3)))

__device__ __forceinline__ unsigned xb_ld(unsigned* p)              { return __hip_atomic_load(p, __ATOMIC_RELAXED, __HIP_MEMORY_SCOPE_AGENT); }
__device__ __forceinline__ unsigned xb_add(unsigned* p, unsigned v) { return __hip_atomic_fetch_add(p, v, __ATOMIC_RELAXED, __HIP_MEMORY_SCOPE_AGENT); }
__device__ __forceinline__ unsigned xb_xcc_id() { return (unsigned)__builtin_amdgcn_s_getreg((3 << 11) | 20) & 0xFu; }
#define XB_SPIN(cond, bar) do { unsigned _sp = 0; while (cond) { __builtin_amdgcn_s_sleep(1); \
    if ((++_sp & 255u) == 0u) { if (xb_ld(&(bar)[XB_TMO])) break; if (_sp > XB_SPIN_CAP) { atomicAdd(&(bar)[XB_TMO], 1u); break; } } } } while (0)

struct XcdBarrier {
    unsigned* bar; unsigned x;
    volatile LAS unsigned* st;
};

__device__ __forceinline__ XcdBarrier xcd_barrier_post(unsigned* bar, volatile LAS unsigned* st) {
    XcdBarrier b; b.bar = bar; b.x = xb_xcc_id(); b.st = st;
    if (threadIdx.x == 0) (void)xb_add(&bar[XB_XCNT(b.x)], 1u);
    return b;
}
__device__ __forceinline__ void xcd_barrier_complete(unsigned* bar, unsigned x, unsigned& nloc, unsigned& nx) {
    const unsigned G = gridDim.x * gridDim.y * gridDim.z;
    unsigned sum, cnt, mine, sp = 0u;
    for (;;) {
        sum = 0u; cnt = 0u; mine = 0u;
#pragma unroll
        for (unsigned j = 0; j < 16; ++j) { const unsigned c = xb_ld(&bar[XB_XCNT(j)]); sum += c; cnt += (c > 0u) ? 1u : 0u; mine = (j == x) ? c : mine; }
        if (sum == G) break;
        __builtin_amdgcn_s_sleep(1);
        if ((++sp & 255u) == 0u) { if (xb_ld(&bar[XB_TMO])) break; if (sp > XB_SPIN_CAP) { atomicAdd(&bar[XB_TMO], 1u); break; } }
    }
    nloc = mine > 0u ? mine : 1u; nx = cnt > 0u ? cnt : 1u;
}

__device__ __forceinline__ void xcd_barrier(const XcdBarrier& b) {
    asm volatile("s_waitcnt vmcnt(0)" ::: "memory");
    __syncthreads();
    if (threadIdx.x == 0) {
        unsigned* bar = b.bar;
        __builtin_amdgcn_s_waitcnt(0);
        unsigned nloc = b.st[0], nx = b.st[1];
        if (nloc == 0u) { xcd_barrier_complete(bar, b.x, nloc, nx); b.st[0] = nloc; b.st[1] = nx; }
        const unsigned old = xb_add(&bar[XB_XSUB(b.x)], 1u);
        const unsigned gen = old / nloc;
        if (old + 1u == (gen + 1u) * nloc) {
            __builtin_amdgcn_fence(__ATOMIC_RELEASE, "agent");
            asm volatile("s_waitcnt vmcnt(0)" ::: "memory");
            const unsigned og = xb_add(&bar[XB_TOP], 1u);
            const unsigned tg = og / nx;
            if (og + 1u == (tg + 1u) * nx) xb_add(&bar[XB_TOPGEN], 1u);
            else XB_SPIN(xb_ld(&bar[XB_TOPGEN]) == tg, bar);
            __builtin_amdgcn_fence(__ATOMIC_ACQUIRE, "agent");
            xb_add(&bar[XB_XGEN(b.x)], 1u);
            asm volatile("s_waitcnt vmcnt(0)" ::: "memory");
        } else {
            XB_SPIN(xb_ld(&bar[XB_XGEN(b.x)]) == gen, bar);
            __builtin_amdgcn_fence(__ATOMIC_ACQUIRE, "agent");
            asm volatile("s_waitcnt vmcnt(0)" ::: "memory");
        }
    }
    __syncthreads();
}

__device__ __forceinline__ int src_col(int mode, int n) {
    if (mode == 1) { const int h = n / 192, r = n % 192; if (r < 128) return n; const int p = r - 128, pi = p >> 1, a = pi >> 4, f = pi & 15; return h * 192 + 128 + 32 * a + f + 16 * (p & 1); }
    if (mode == 2) return (n >> 7) * 256 + (n & 127);
    if (mode == 3) return (n >> 7) * 256 + 128 + (n & 127);
    if (mode == 4) { if (n >= 2560) return n; const int h = n >> 7, p = n & 127, pi = p >> 1, a = pi >> 5, f = pi & 31; return h * 128 + 64 * a + f + 32 * (p & 1); }
    return n;
}
struct CvtJob { int in_idx; unsigned src_off; size_t dst_off; int K, ldsrc, nvalid, nrows, mode; };
__device__ __forceinline__ void cvt_transpose_all(LDSP float* tile, const float* const* in, unsigned char* ws) {
    const CvtJob jobs[12] = {
        {I_MWDOWN, 0u, WS_WDOWN, 2048, 1088, 1088, 1280, 0}, {I_MWUQ, 0u, WS_WUQ, 512, 3072, 3072, 3072, 1}, {I_MWUKV, 0u, WS_WUK, 512, 4096, 2048, 2048, 2}, {I_MWUKV, 0u, WS_WUV, 512, 4096, 2048, 2048, 3},
        {I_MWO, 0u, WS_WOMLA, 2048, 2048, 2048, 2048, 0}, {I_S5WIN, 0u, WS_S5IN, 2048, 2048, 2048, 2048, 0}, {I_S5WG, 0u, WS_S5GATE, 2048, 2048, 2048, 2048, 0}, {I_S5WO, 0u, WS_S5OUT, 2048, 2048, 2048, 2048, 0},
        {I_HWIN, 0u, WS_HYIN, 2048, 6144, 6144, 6144, 0}, {I_HWOUT, 0u, WS_HYOUT, 2048, 2048, 2048, 2048, 0}, {I_SWQKV, 0u, WS_SWAQKV, 2048, 3072, 3072, 3072, 4}, {I_SWO, 0u, WS_SWAO, 2048, 2048, 2048, 2048, 0} };
    const int tid = threadIdx.x;
    int total = 0;
#pragma unroll
    for (int j = 0; j < 12; ++j) total += (jobs[j].nrows >> 6) * (jobs[j].K >> 6);
    float r[8];
#define CT_DECODE(t_, src_, dst_, K_, n0_, k0_) do { int rem_ = (t_); int ji_ = 0; \
        _Pragma("unroll") for (int j_ = 0; j_ < 11; ++j_) { const int nt_ = (jobs[j_].nrows >> 6) * (jobs[j_].K >> 6); if (ji_ == j_ && rem_ >= nt_) { rem_ -= nt_; ji_ = j_ + 1; } } \
        int in_idx_ = 0, ldsrc_ = 0, nvalid_ = 0, nrows_ = 64, mode_ = 0; unsigned so_ = 0; size_t do_ = 0; K_ = 64; \
        _Pragma("unroll") for (int j_ = 0; j_ < 12; ++j_) if (ji_ == j_) { in_idx_ = jobs[j_].in_idx; so_ = jobs[j_].src_off; do_ = jobs[j_].dst_off; K_ = jobs[j_].K; ldsrc_ = jobs[j_].ldsrc; nvalid_ = jobs[j_].nvalid; nrows_ = jobs[j_].nrows; mode_ = jobs[j_].mode; } \
        const int tn_ = nrows_ >> 6; n0_ = (rem_ % tn_) << 6; k0_ = (rem_ / tn_) << 6; dst_ = (bf16_t*)(ws + do_); \
        const int n_ = n0_ + (tid & 63); const bool valid_ = n_ < nvalid_; const int sc_ = valid_ ? src_col(mode_, n_) : 0; \
        src_ = valid_ ? in[in_idx_] + so_ + (size_t)(k0_ + (tid >> 6)) * ldsrc_ + sc_ : nullptr; ldr_ = ldsrc_; } while (0)
    int t = blockIdx.x;
    const float* src = nullptr; bf16_t* dst = nullptr; int K = 64, n0 = 0, k0 = 0, ldr_ = 0;
    float rb[8]; bf16_t* dstb = nullptr; int Kb = 64, n0b = 0, k0b = 0;
#define CT_LOAD(reg_) do { _Pragma("unroll") for (int i = 0; i < 8; ++i) reg_[i] = src ? src[(size_t)(8 * i) * ldr_] : 0.f; } while (0)
    if (t < total) { CT_DECODE(t, src, dst, K, n0, k0); CT_LOAD(r); }
    if (t + (int)gridDim.x < total) { CT_DECODE(t + (int)gridDim.x, src, dstb, Kb, n0b, k0b); CT_LOAD(rb); }
    for (; t < total; t += gridDim.x) {
#pragma unroll
        for (int i = 0; i < 8; ++i) tile[((tid >> 6) + 8 * i) * 65 + (tid & 63)] = r[i];
        bf16_t* cdst = dst; const int cK = K, cn0 = n0, ck0 = k0;
#pragma unroll
        for (int i = 0; i < 8; ++i) r[i] = rb[i];
        dst = dstb; K = Kb; n0 = n0b; k0 = k0b;
        const int tn = t + 2 * (int)gridDim.x;
        if (tn < total) { CT_DECODE(tn, src, dstb, Kb, n0b, k0b); CT_LOAD(rb); }
        __syncthreads();
        { const int nn = tid >> 3, kq = tid & 7; float v[8];
#pragma unroll
          for (int j = 0; j < 8; ++j) v[j] = tile[(kq * 8 + j) * 65 + nn];
          u32x4 w; w.x = pk_bf16(v[0], v[1]); w.y = pk_bf16(v[2], v[3]); w.z = pk_bf16(v[4], v[5]); w.w = pk_bf16(v[6], v[7]);
          *(u32x4*)(cdst + (size_t)(cn0 + nn) * cK + ck0 + kq * 8) = w; }
        __syncthreads();
    }
#undef CT_LOAD
#undef CT_DECODE
}
__device__ __forceinline__ void cvt_transpose_i8(LDSP unsigned char* lds, const float* __restrict__ src, unsigned char* __restrict__ dst8, float* __restrict__ wscale, int nmat) {
    LDSP float* tile = (LDSP float*)lds; LDSP float* red = tile + 64 * 65; LDSP float* inv = red + 512;
    const int tid = threadIdx.x, nn = tid & 63, kg = tid >> 6;
    for (int strip = blockIdx.x; strip < nmat * 32; strip += gridDim.x) {
        const int mat = strip >> 5, n0 = (strip & 31) * 64;
        const float* sm = src + (size_t)mat * 2048 * 2048 + n0;
        float mx = 0.f;
        for (int i = 0; i < 256; i += 8) {
            float v[8];
#pragma unroll
            for (int u = 0; u < 8; ++u) v[u] = sm[(size_t)(kg + 8 * (i + u)) * 2048 + nn];
#pragma unroll
            for (int u = 0; u < 8; ++u) mx = fmaxf(mx, fabsf(v[u]));
        }
        red[kg * 64 + nn] = mx;
        __syncthreads();
        if (tid < 64) { float m = red[tid];
#pragma unroll
            for (int g = 1; g < 8; ++g) m = fmaxf(m, red[g * 64 + tid]);
            inv[tid] = m > 0.f ? 127.f / m : 1.f; wscale[mat * 2048 + n0 + tid] = m > 0.f ? m / 127.f : 1.f; }
        __syncthreads();
        for (int k0 = 0; k0 < 2048; k0 += 64) {
#pragma unroll
            for (int i = 0; i < 8; ++i) { const int kk = kg + 8 * i; tile[kk * 65 + nn] = sm[(size_t)(k0 + kk) * 2048 + nn]; }
            __syncthreads();
            { const int n2 = tid >> 3, kq = tid & 7; const float s = inv[n2]; int q[8];
#pragma unroll
              for (int j = 0; j < 8; ++j) q[j] = (int)rintf(tile[(kq * 8 + j) * 65 + n2] * s);
              u32x2 w; w.x = (unsigned)(q[0] & 255) | ((unsigned)(q[1] & 255) << 8) | ((unsigned)(q[2] & 255) << 16) | ((unsigned)(q[3] & 255) << 24);
              w.y = (unsigned)(q[4] & 255) | ((unsigned)(q[5] & 255) << 8) | ((unsigned)(q[6] & 255) << 16) | ((unsigned)(q[7] & 255) << 24);
              *(u32x2*)(dst8 + ((size_t)mat * 2048 + n0 + n2) * 2048 + k0 + kq * 8) = w; }
            __syncthreads();
        }
    }
}
__device__ __forceinline__ void cvt_direct(const float* __restrict__ src, bf16_t* __restrict__ dst, size_t n) {
    const size_t ng = n >> 3, stride = (size_t)gridDim.x * NTH;
    for (size_t g = (size_t)blockIdx.x * NTH + threadIdx.x; g < ng; g += stride) {
        const f32x4 a = __builtin_nontemporal_load((const f32x4*)(src + g * 8)), b = __builtin_nontemporal_load((const f32x4*)(src + g * 8 + 4));
        u32x4 w; w.x = pk_bf16(a[0], a[1]); w.y = pk_bf16(a[2], a[3]); w.z = pk_bf16(b[0], b[1]); w.w = pk_bf16(b[2], b[3]);
        *(u32x4*)(dst + g * 8) = w;
    }
}
__device__ __forceinline__ void mod_phase(LDSP unsigned char* lds, const float* __restrict__ c_ctx, const float* __restrict__ c, const float* __restrict__ mod_w, const float* __restrict__ mod_b, float* __restrict__ mod) {
    LDSP float* act = (LDSP float*)lds;
    LDSP f32x4* red = (LDSP f32x4*)(lds + 73728);
    const int tid = threadIdx.x, lane = tid & 63, wave = tid >> 6;
    if ((int)blockIdx.x >= 192) return;
    for (int i = tid; i < 9 * 2048; i += NTH) { const int ci = i >> 11, k = i & 2047; const float x = ci == 0 ? c_ctx[k] : c[(ci - 1) * 2048 + k]; act[i] = x / (1.f + __expf(-x)); }
    __syncthreads();
    for (int item = blockIdx.x; item < 192; item += gridDim.x) {
        const int layer = item / 48, n0 = (item % 48) * 256;
        const float* wp = mod_w + ((size_t)layer * 2048 + wave) * 12288 + n0 + 4 * lane;
        f32x4 acc[9];
#pragma unroll
        for (int ci = 0; ci < 9; ++ci) acc[ci] = (f32x4){0.f, 0.f, 0.f, 0.f};
        for (int kk = 0; kk < 256; kk += 16) {
            f32x4 w[16];
#pragma unroll
            for (int u = 0; u < 16; ++u) w[u] = __builtin_nontemporal_load((const f32x4*)(wp + (size_t)(8 * (kk + u)) * 12288));
#pragma unroll
            for (int u = 0; u < 16; ++u)
#pragma unroll
                for (int ci = 0; ci < 9; ++ci) acc[ci] += act[ci * 2048 + wave + 8 * (kk + u)] * w[u];
        }
#pragma unroll
        for (int half = 4; half >= 1; half >>= 1) {
            if (wave >= half && wave < 2 * half) {
#pragma unroll
                for (int ci = 0; ci < 9; ++ci) red[((wave - half) * 9 + ci) * 64 + lane] = acc[ci]; }
            __syncthreads();
            if (wave < half) {
#pragma unroll
                for (int ci = 0; ci < 9; ++ci) acc[ci] += red[(wave * 9 + ci) * 64 + lane]; }
            __syncthreads();
        }
        if (wave == 0) { const f32x4 bb = *(const f32x4*)(mod_b + layer * 12288 + n0 + 4 * lane);
#pragma unroll
            for (int ci = 0; ci < 9; ++ci) *(f32x4*)(mod + ((size_t)ci * 4 + layer) * 12288 + n0 + 4 * lane) = acc[ci] + bb; }
    }
}
__device__ __forceinline__ void rope_tables(float* rt) {
    const int i = blockIdx.x * NTH + threadIdx.x;
    if (i < 1024) { const int pos = i >> 4, f = i & 15; const float ang = (float)pos * powf(10000.f, -(float)(2 * f) / 32.f); rt[i] = cosf(ang); rt[1024 + i] = sinf(ang); }
    else if (i < 1024 + 2048) { const int j = i - 1024, pos = j >> 5, f = j & 31; const float ang = (float)pos * powf(10000.f, -(float)(2 * f) / 64.f); rt[2048 + j] = cosf(ang); rt[4096 + j] = sinf(ang); }
}
__device__ __forceinline__ void hy_filter_phase(LDSP unsigned char* lds, const float* __restrict__ w1, const float* __restrict__ b1, const float* __restrict__ freq, const float* __restrict__ w2, const float* __restrict__ b2,
                                                const float* __restrict__ w3, const float* __restrict__ log_decay, bf16_t* __restrict__ F) {
    LDSP float* z1 = (LDSP float*)lds; LDSP float* z2 = z1 + 8 * 64;
    const int tid = threadIdx.x;
    for (int u = blockIdx.x; u < 576; u += gridDim.x) {
        const int dirn = u & 1, lc = u >> 1, grp = lc >= 32, L = grp ? 2048 : 256, l0 = (grp ? lc - 32 : lc) * 8;
        bf16_t* Fg = F + (grp ? (size_t)2 * 2048 * 512 : 0);
        const float invL = 1.f / (float)L;
        { const int li = tid >> 6, j = tid & 63, l = l0 + dirn + li; float v = 0.f;
            if (l < L) { const float t = (float)l * invL; float s = b1[j] + t * w1[j];
                for (int k = 1; k <= 8; ++k) { const float ang = 6.283185307179586f * t * (float)k; s += sinf(ang) * w1[k * 64 + j] + cosf(ang) * w1[(8 + k) * 64 + j]; }
                v = sinf(freq[j] * s); }
            z1[tid] = v; }
        __syncthreads();
        { const int li = tid >> 6, j = tid & 63, l = l0 + dirn + li; float v = 0.f;
            if (l < L) { float s = b2[j]; for (int i = 0; i < 64; ++i) s += z1[li * 64 + i] * w2[i * 64 + j]; v = sinf(freq[64 + j] * s); }
            z2[tid] = v; }
        __syncthreads();
        float acc[8][8];
#pragma unroll
        for (int jj = 0; jj < 8; ++jj)
#pragma unroll
            for (int r = 0; r < 8; ++r) acc[jj][r] = 0.f;
        const float* wb = w3 + 4096 * dirn + tid;
        float wa[8], wbn[8];
#pragma unroll
        for (int jj = 0; jj < 8; ++jj) { wa[jj] = wb[512 * jj]; wbn[jj] = wb[8192 + 512 * jj]; }
        for (int i = 0; i < 64; i += 2) {
            float wc[8], wd[8];
#pragma unroll
            for (int jj = 0; jj < 8; ++jj) { wc[jj] = wa[jj]; wd[jj] = wbn[jj]; }
            { const int i2 = i + 2 < 64 ? i + 2 : i, i3 = i + 3 < 64 ? i + 3 : i;
#pragma unroll
              for (int jj = 0; jj < 8; ++jj) { wa[jj] = wb[(size_t)i2 * 8192 + 512 * jj]; wbn[jj] = wb[(size_t)i3 * 8192 + 512 * jj]; } }
            float zr[8], zs[8];
#pragma unroll
            for (int r = 0; r < 8; ++r) { zr[r] = z2[r * 64 + i]; zs[r] = z2[r * 64 + i + 1]; }
#pragma unroll
            for (int jj = 0; jj < 8; ++jj)
#pragma unroll
                for (int r = 0; r < 8; ++r) acc[jj][r] += zr[r] * wc[jj] + zs[r] * wd[jj];
        }
#pragma unroll
        for (int jj = 0; jj < 8; ++jj) {
            const int col = 4096 * dirn + tid + 512 * jj, o = (col >> 11) & 1, d = col & 2047;
            const float dec = __expf(log_decay[(dirn * 2 + o) * 2048 + d]);
            float vals[8];
#pragma unroll
            for (int r = 0; r < 8; ++r) vals[r] = acc[jj][r] * __expf(-((float)(l0 + r + dirn) * invL) * dec);
            bf16_t* dst = Fg + ((size_t)o * 2048 + d) * (size_t)(2 * L);
            u32x4 w;
            if (dirn == 0) { w.x = pk_bf16(vals[7], vals[6]); w.y = pk_bf16(vals[5], vals[4]); w.z = pk_bf16(vals[3], vals[2]); w.w = pk_bf16(vals[1], vals[0]); *(u32x4*)(dst + L - l0 - 8) = w; }
            else { w.x = pk_bf16(vals[0], vals[1]); w.y = pk_bf16(vals[2], vals[3]); w.z = pk_bf16(vals[4], vals[5]); w.w = pk_bf16(vals[6], vals[7]); *(u32x4*)(dst + L + l0) = w; }
        }
        __syncthreads();
    }
}

#define NP_COL(i_) (512 * ((i_) >> 1) + 8 * lane + 4 * ((i_) & 1))
template <bool XBF> __device__ __forceinline__ void np_load(f32x4 (&dst)[8], const float* xc, const float* xl, const bf16_t* X, int row, int lane) {
    if (XBF) { const bf16_t* xr = X + (size_t)row * D;
#pragma unroll
        for (int p = 0; p < 4; ++p) { const u32x4 x = *(const u32x4*)(xr + 512 * p + 8 * lane); dst[2 * p] = (f32x4){bf_lo(x.x), bf_hi(x.x), bf_lo(x.y), bf_hi(x.y)}; dst[2 * p + 1] = (f32x4){bf_lo(x.z), bf_hi(x.z), bf_lo(x.w), bf_hi(x.w)}; }
    } else { const float* xr = row < TC ? xc + (size_t)row * D : xl + (size_t)(row - TC) * D;
#pragma unroll
        for (int i = 0; i < 8; ++i) dst[i] = *(const f32x4*)(xr + NP_COL(i)); }
}
__device__ __forceinline__ void np_raw(u32x4 (&q)[4], const bf16_t* X, int row, int lane) {
#pragma unroll
    for (int p = 0; p < 4; ++p) q[p] = *(const u32x4*)(X + (size_t)row * D + 512 * p + 8 * lane);
}
__device__ __forceinline__ void np_unpack(f32x4 (&dst)[8], const u32x4 (&q)[4]) {
#pragma unroll
    for (int p = 0; p < 4; ++p) { const u32x4 x = q[p]; dst[2 * p] = (f32x4){bf_lo(x.x), bf_hi(x.x), bf_lo(x.y), bf_hi(x.y)}; dst[2 * p + 1] = (f32x4){bf_lo(x.z), bf_hi(x.z), bf_lo(x.w), bf_hi(x.w)}; }
}
template <bool XBF> __device__ __forceinline__ void norm_phase(const float* __restrict__ xc, const float* __restrict__ xl, const bf16_t* __restrict__ X, const float* __restrict__ gain, const float* __restrict__ mp, bf16_t* __restrict__ H, unsigned* __restrict__ X8 = nullptr, float* __restrict__ SX = nullptr) {
    const int lane = threadIdx.x & 63, gw = blockIdx.x * 8 + (threadIdx.x >> 6), nw = gridDim.x * 8, per = (T + nw - 1) / nw;
    const int r0 = gw * per, r1 = r0 + per < T ? r0 + per : T;
    if (r0 >= r1) return;
    f32x4 ca[8], cb[8], v[8], vn[8]; int ccur = -1; u32x4 qn[4];
    if (XBF) np_raw(qn, X, r0, lane); else np_load<false>(vn, xc, xl, X, r0, lane);
    for (int row = r0; row < r1; ++row) {
        if (XBF) np_unpack(v, qn);
        else {
#pragma unroll
            for (int i = 0; i < 8; ++i) v[i] = vn[i]; }
#pragma unroll
        for (int i = 0; i < 8; ++i) asm volatile("" : "+v"(v[i]));
        const int cnd = cond_of(row);
        if (cnd != ccur) { ccur = cnd; const float* m = mp + (size_t)cnd * 4 * 12288;
#pragma unroll
            for (int i = 0; i < 8; ++i) { const int col = NP_COL(i); ca[i] = *(const f32x4*)(gain + col) * (*(const f32x4*)(m + 2048 + col) + 1.f); cb[i] = *(const f32x4*)(m + col); }
#pragma unroll
            for (int i = 0; i < 8; ++i) asm volatile("" : "+v"(ca[i]), "+v"(cb[i]));
        }
        if (row + 1 < r1) { if (XBF) np_raw(qn, X, row + 1, lane); else np_load<false>(vn, xc, xl, X, row + 1, lane); }
        float ss = 0.f;
#pragma unroll
        for (int i = 0; i < 8; ++i) ss += v[i][0] * v[i][0] + v[i][1] * v[i][1] + v[i][2] * v[i][2] + v[i][3] * v[i][3];
        ss = wave_sum(ss);
        const float rstd = rsqrtf(ss * (1.f / 2048.f) + 1e-6f);
        float amax = 0.f;
#pragma unroll
        for (int i = 0; i < 8; ++i) { const f32x4 y = v[i] * rstd * ca[i] + cb[i]; v[i] = y;
            amax = fmaxf(amax, fmaxf(fmaxf(fabsf(y[0]), fabsf(y[1])), fmaxf(fabsf(y[2]), fabsf(y[3])))); }
        if (H) {
#pragma unroll
            for (int p = 0; p < 4; ++p) *(u32x4*)(H + (size_t)row * D + 512 * p + 8 * lane) = pk8_bf16(v[2 * p], v[2 * p + 1]); }
        if (X8) {
            amax = fmaxf(amax, __shfl_xor(amax, 32)); amax = fmaxf(amax, __shfl_xor(amax, 16)); amax = fmaxf(amax, __shfl_xor(amax, 8)); amax = fmaxf(amax, __shfl_xor(amax, 4)); amax = fmaxf(amax, __shfl_xor(amax, 2)); amax = fmaxf(amax, __shfl_xor(amax, 1));
            const float qs = amax > 0.f ? 127.f / amax : 1.f;
#pragma unroll
            for (int p = 0; p < 4; ++p) { u32x2 w;
#pragma unroll
                for (int h = 0; h < 2; ++h) { const f32x4 y = v[2 * p + h]; const int q0 = (int)rintf(y[0] * qs), q1 = (int)rintf(y[1] * qs), q2 = (int)rintf(y[2] * qs), q3 = (int)rintf(y[3] * qs);
                    w[h] = (unsigned)(q0 & 255) | ((unsigned)(q1 & 255) << 8) | ((unsigned)(q2 & 255) << 16) | ((unsigned)(q3 & 255) << 24); }
                *(u32x2*)(X8 + (size_t)row * 512 + 128 * p + 2 * lane) = w; }
            if (lane == 0) SX[row] = amax > 0.f ? amax / 127.f : 1.f;
        }
    }
}
__device__ __forceinline__ void final_norm_phase(const bf16_t* __restrict__ X, const float* __restrict__ gain, float* __restrict__ out) {
    const int lane = threadIdx.x & 63, gw = blockIdx.x * 8 + (threadIdx.x >> 6), nw = gridDim.x * 8, per = (T + nw - 1) / nw;
    const int r0 = gw * per, r1 = r0 + per < T ? r0 + per : T;
    if (r0 >= r1) return;
    f32x4 g[8], v[8]; u32x4 qn[4];
#pragma unroll
    for (int i = 0; i < 8; ++i) g[i] = *(const f32x4*)(gain + NP_COL(i));
    np_raw(qn, X, r0, lane);
    for (int row = r0; row < r1; ++row) {
        np_unpack(v, qn); if (row + 1 < r1) np_raw(qn, X, row + 1, lane);
        float ss = 0.f;
#pragma unroll
        for (int i = 0; i < 8; ++i) ss += v[i][0] * v[i][0] + v[i][1] * v[i][1] + v[i][2] * v[i][2] + v[i][3] * v[i][3];
        ss = wave_sum(ss);
        const float rstd = rsqrtf(ss * (1.f / 2048.f) + 1e-6f);
#pragma unroll
        for (int i = 0; i < 8; ++i) *(f32x4*)(out + (size_t)row * D + NP_COL(i)) = v[i] * rstd * g[i];
    }
}
#undef NP_COL

__device__ __forceinline__ void mla_rows_phase(const bf16_t* __restrict__ DOWN, const float* __restrict__ g_q, const float* __restrict__ g_kv, const float* __restrict__ cache_ckv, const float* __restrict__ cache_kpe,
                                               const float* __restrict__ rope, bf16_t* __restrict__ CQ, bf16_t* __restrict__ CKV, bf16_t* __restrict__ KPE, float* __restrict__ out_ckv, float* __restrict__ out_kpe) {
    const int lane = threadIdx.x & 63, gw = blockIdx.x * 8 + (threadIdx.x >> 6), nw = gridDim.x * 8;
    const int ra = lane >> 5, ri = lane & 31, rf = ri & 15, rx2 = ri >> 4, rp = 2 * (16 * ra + rf) + rx2;
    for (int r = gw; r < T + 2048; r += nw) {
        if (r < T) {
            const int row = r, krow = keyrow_of(row);
            const bf16_t* dr = DOWN + (size_t)row * 1280;
#define MR_LD4(p_) ({ const u32x2 t_ = *(const u32x2*)(p_); (f32x4){bf_lo(t_.x), bf_hi(t_.x), bf_lo(t_.y), bf_hi(t_.y)}; })
            {
                const f32x4 a0 = MR_LD4(dr + 4 * lane), a1 = MR_LD4(dr + 256 + 4 * lane);
                float ss = a0[0] * a0[0] + a0[1] * a0[1] + a0[2] * a0[2] + a0[3] * a0[3] + a1[0] * a1[0] + a1[1] * a1[1] + a1[2] * a1[2] + a1[3] * a1[3];
                ss = wave_sum(ss); const float rstd = rsqrtf(ss * (1.f / 512.f) + 1e-6f);
                const f32x4 g0 = *(const f32x4*)(g_q + 4 * lane), g1 = *(const f32x4*)(g_q + 256 + 4 * lane);
                const f32x4 y0 = a0 * rstd * g0, y1 = a1 * rstd * g1;
                u32x2 w; w.x = pk_bf16(y0[0], y0[1]); w.y = pk_bf16(y0[2], y0[3]); *(u32x2*)(CQ + (size_t)row * 512 + 4 * lane) = w;
                w.x = pk_bf16(y1[0], y1[1]); w.y = pk_bf16(y1[2], y1[3]); *(u32x2*)(CQ + (size_t)row * 512 + 256 + 4 * lane) = w;
            }
            {
                const f32x4 a0 = MR_LD4(dr + 512 + 4 * lane), a1 = MR_LD4(dr + 768 + 4 * lane);
                float ss = a0[0] * a0[0] + a0[1] * a0[1] + a0[2] * a0[2] + a0[3] * a0[3] + a1[0] * a1[0] + a1[1] * a1[1] + a1[2] * a1[2] + a1[3] * a1[3];
                ss = wave_sum(ss); const float rstd = rsqrtf(ss * (1.f / 512.f) + 1e-6f);
                const f32x4 g0 = *(const f32x4*)(g_kv + 4 * lane), g1 = *(const f32x4*)(g_kv + 256 + 4 * lane);
                const f32x4 y0 = a0 * rstd * g0, y1 = a1 * rstd * g1;
                u32x2 w; w.x = pk_bf16(y0[0], y0[1]); w.y = pk_bf16(y0[2], y0[3]); *(u32x2*)(CKV + (size_t)krow * 512 + 4 * lane) = w;
                w.x = pk_bf16(y1[0], y1[1]); w.y = pk_bf16(y1[2], y1[3]); *(u32x2*)(CKV + (size_t)krow * 512 + 256 + 4 * lane) = w;
                if (row < TC) { *(f32x4*)(out_ckv + (size_t)row * 512 + 4 * lane) = y0; *(f32x4*)(out_ckv + (size_t)row * 512 + 256 + 4 * lane) = y1; }
            }
            {
                const float v = __uint_as_float((unsigned)dr[1024 + lane] << 16);
#undef MR_LD4
                if (row < TC) { out_kpe[(size_t)row * 64 + lane] = v; KPE[(size_t)krow * 64 + rp] = f2bf(v); }
                else {
                    const int l = (row - TC) & 2047, pos = ra ? (l & 63) : (l >> 6);
                    const float c = rope[pos * 16 + rf], s = rope[1024 + pos * 16 + rf];
                    const float other = __shfl_xor(v, 16);
                    const float x1 = rx2 ? other : v, x2 = rx2 ? v : other;
                    KPE[(size_t)krow * 64 + rp] = f2bf(rx2 ? (x1 * s + x2 * c) : (x1 * c - x2 * s));
                }
            }
        } else {
            const int cr = r - T, b = cr >> 8, pos = cr & 255, krow = TC + b * 2304 + 2048 + pos;
            const float* src = cache_ckv + (size_t)cr * 512;
            const f32x4 a0 = *(const f32x4*)(src + 4 * lane), a1 = *(const f32x4*)(src + 256 + 4 * lane);
            u32x2 w; w.x = pk_bf16(a0[0], a0[1]); w.y = pk_bf16(a0[2], a0[3]); *(u32x2*)(CKV + (size_t)krow * 512 + 4 * lane) = w;
            w.x = pk_bf16(a1[0], a1[1]); w.y = pk_bf16(a1[2], a1[3]); *(u32x2*)(CKV + (size_t)krow * 512 + 256 + 4 * lane) = w;
            KPE[(size_t)krow * 64 + rp] = f2bf(cache_kpe[(size_t)cr * 64 + lane]);
        }
    }
}

template <int DK2>
__device__ __forceinline__ void attn_unit(LDSP unsigned char* lds,
        const bf16_t* __restrict__ Qp, int q_ld, int qrow0, const bf16_t* __restrict__ K1p, int k1_ld, const bf16_t* __restrict__ K2p, int k2_ld,
        const bf16_t* __restrict__ VTp, int vt_ld, bf16_t* __restrict__ Op, int o_ld, float scale_log2, bool has_sink, float sink_log2,
        int kb0, int nt0, int kb1, int nt1, bool band, int qpos0, int kpos0) {
    constexpr int DK = 128 + DK2, NDS = DK / 32, KROW = DK * 2 + 16, VROW = 144, KT_BYTES = 64 * KROW, VT_BYTES = 128 * VROW;
    const int tid = threadIdx.x, lane = tid & 63, wave = tid >> 6, fr = lane & 15, fq = lane >> 4;
    bf16x8 Qf[2][NDS];
#pragma unroll
    for (int qs = 0; qs < 2; ++qs)
#pragma unroll
        for (int ds = 0; ds < NDS; ++ds) Qf[qs][ds] = *(const bf16x8*)(Qp + (size_t)(qrow0 + 32 * wave + 16 * qs + fr) * q_ld + 32 * ds + 8 * fq);
    f32x4 O[2][8];
#pragma unroll
    for (int qs = 0; qs < 2; ++qs)
#pragma unroll
        for (int n = 0; n < 8; ++n) O[qs][n] = (f32x4){0.f, 0.f, 0.f, 0.f};
    float mrow[2] = {-1e30f, -1e30f}, lrow[2] = {0.f, 0.f};
    const int nt = nt0 + nt1;
    u32x4 rs[3];
    rs[2] = (u32x4){0u, 0u, 0u, 0u};
#define ATT_KB(t_) ((t_) < nt0 ? kb0 + 64 * (t_) : kb1 + 64 * ((t_) - nt0))
#define ATT_LOADK(t_) do { const int kb_ = ATT_KB(t_); \
        _Pragma("unroll") for (int i_ = 0; i_ < 2; ++i_) { const int c_ = tid + 512 * i_; rs[i_] = *(const u32x4*)(K1p + (size_t)(kb_ + (c_ >> 4)) * k1_ld + (c_ & 15) * 8); } \
        if (DK2) rs[2] = *(const u32x4*)(K2p + (size_t)(kb_ + (tid >> 3)) * k2_ld + (tid & 7) * 8); } while (0)
#define ATT_STOREK(b_) do { LDSP unsigned char* Kb_ = lds + (b_) * KT_BYTES; \
        _Pragma("unroll") for (int i_ = 0; i_ < 2; ++i_) { const int c_ = tid + 512 * i_; *(LDSP u32x4*)(Kb_ + (c_ >> 4) * KROW + (c_ & 15) * 16) = rs[i_]; } \
        if (DK2) *(LDSP u32x4*)(Kb_ + (tid >> 3) * KROW + 256 + (tid & 7) * 16) = rs[2]; } while (0)
#define ATT_LOADV(t_) do { const int kb_ = ATT_KB(t_); \
        _Pragma("unroll") for (int i_ = 0; i_ < 2; ++i_) { const int c_ = tid + 512 * i_; rs[i_] = *(const u32x4*)(VTp + (size_t)(c_ >> 3) * vt_ld + kb_ + (c_ & 7) * 8); } } while (0)
#define ATT_STOREV(b_) do { LDSP unsigned char* Vb_ = lds + 2 * KT_BYTES + (b_) * VT_BYTES; \
        _Pragma("unroll") for (int i_ = 0; i_ < 2; ++i_) { const int c_ = tid + 512 * i_; *(LDSP u32x4*)(Vb_ + (c_ >> 3) * VROW + (c_ & 7) * 16) = rs[i_]; } } while (0)
    ATT_LOADK(0); ATT_STOREK(0); ATT_LOADV(0); ATT_STOREV(0);
    __syncthreads();
    for (int t = 0; t < nt; ++t) {
        const int b = t & 1;
        if (t + 1 < nt) ATT_LOADK(t + 1);
        LDSP unsigned char* Kb = lds + b * KT_BYTES; LDSP unsigned char* Vb = lds + 2 * KT_BYTES + b * VT_BYTES;
        f32x4 S[2][4];
#pragma unroll
        for (int qs = 0; qs < 2; ++qs)
#pragma unroll
            for (int kt = 0; kt < 4; ++kt) S[qs][kt] = (f32x4){0.f, 0.f, 0.f, 0.f};
#pragma unroll
        for (int ds = 0; ds < NDS; ++ds)
#pragma unroll
            for (int kt = 0; kt < 4; ++kt) {
                const bf16x8 kf = *(const LDSP bf16x8*)(Kb + (16 * kt + fr) * KROW + (32 * ds + 8 * fq) * 2);
                S[0][kt] = __builtin_amdgcn_mfma_f32_16x16x32_bf16(kf, Qf[0][ds], S[0][kt], 0, 0, 0);
                S[1][kt] = __builtin_amdgcn_mfma_f32_16x16x32_bf16(kf, Qf[1][ds], S[1][kt], 0, 0, 0);
            }
        if (t + 1 < nt) { ATT_STOREK(b ^ 1); ATT_LOADV(t + 1); }
        bf16x8 Pf[2][2];
        const bool do_mask = band && t < nt0;
#pragma unroll
        for (int qs = 0; qs < 2; ++qs) {
            float sv[16]; float mx = -INFINITY;
            const int qpos = qpos0 + 32 * wave + 16 * qs + fr;
#pragma unroll
            for (int kt = 0; kt < 4; ++kt)
#pragma unroll
                for (int j = 0; j < 4; ++j) { float x = S[qs][kt][j];
                    if (do_mask) { const int dlt = qpos - (kpos0 + 64 * t + 16 * kt + 4 * fq + j); if (dlt > 128 || dlt < -128) x = -INFINITY; }
                    sv[kt * 4 + j] = x; mx = fmaxf(mx, x); }
            mx = xmax_16_32(mx);
            const float mnew = fmaxf(mrow[qs], mx * scale_log2), alpha = fexp2(mrow[qs] - mnew); mrow[qs] = mnew;
            if (__builtin_amdgcn_ballot_w64(alpha < 1.f) != 0ull) {
#pragma unroll
                for (int n = 0; n < 8; ++n) O[qs][n] *= alpha;
            }
            float ps = 0.f;
#pragma unroll
            for (int i = 0; i < 16; ++i) { sv[i] = fexp2(__builtin_fmaf(sv[i], scale_log2, -mnew)); ps += sv[i]; }
            lrow[qs] = lrow[qs] * alpha + ps;
#pragma unroll
            for (int s = 0; s < 2; ++s) { u32x4 w; w.x = pk_bf16(sv[8 * s + 0], sv[8 * s + 1]); w.y = pk_bf16(sv[8 * s + 2], sv[8 * s + 3]); w.z = pk_bf16(sv[8 * s + 4], sv[8 * s + 5]); w.w = pk_bf16(sv[8 * s + 6], sv[8 * s + 7]); Pf[qs][s] = as_bf16x8(w); }
        }
#pragma unroll
        for (int s = 0; s < 2; ++s)
#pragma unroll
            for (int n = 0; n < 8; ++n) {
                const LDSP unsigned char* vp = Vb + (16 * n + fr) * VROW + (32 * s + 4 * fq) * 2;
                const u32x2 lo = *(const LDSP u32x2*)vp, hi = *(const LDSP u32x2*)(vp + 32);
                const bf16x8 vf = as_bf16x8((u32x4){lo.x, lo.y, hi.x, hi.y});
                O[0][n] = __builtin_amdgcn_mfma_f32_16x16x32_bf16(vf, Pf[0][s], O[0][n], 0, 0, 0);
                O[1][n] = __builtin_amdgcn_mfma_f32_16x16x32_bf16(vf, Pf[1][s], O[1][n], 0, 0, 0);
            }
        if (t + 1 < nt) ATT_STOREV(b ^ 1);
        __syncthreads();
    }
#undef ATT_KB
#undef ATT_LOADK
#undef ATT_STOREK
#undef ATT_LOADV
#undef ATT_STOREV
#pragma unroll
    for (int qs = 0; qs < 2; ++qs) {
        float lt = lrow[qs]; lt += __shfl_xor(lt, 16); lt += __shfl_xor(lt, 32);
        const float mf = has_sink ? fmaxf(mrow[qs], sink_log2) : mrow[qs], a = fexp2(mrow[qs] - mf);
        const float denom = lt * a + (has_sink ? fexp2(sink_log2 - mf) : 0.f), inv = a / denom;
        bf16_t* orow = Op + (size_t)(qrow0 + 32 * wave + 16 * qs + fr) * o_ld + 4 * fq;
#pragma unroll
        for (int n = 0; n < 8; ++n) { const f32x4 o = O[qs][n] * inv; u32x2 w; w.x = pk_bf16(o[0], o[1]); w.y = pk_bf16(o[2], o[3]); *(u32x2*)(orow + 16 * n) = w; }
    }
}

template <int KIND>
__device__ __forceinline__ void attn_phase(LDSP unsigned char* lds, const bf16_t* Q, const bf16_t* K1, const bf16_t* K2, const bf16_t* VT, bf16_t* O, const float* sink) {
    const float LOG2E = 1.4426950408889634f;
    for (int u0 = blockIdx.x; u0 < 1280; u0 += gridDim.x) {
        int u = u0;
        if (gridDim.x == 256 && u0 < 1024) {
            const int j = u0 >> 8, x = u0 & 255, vx = x & 7, r = x >> 3;
            u = ((32 * j + 4 * vx + (r >> 3)) << 3) | (r & 7);
        }
        int b, head, qb, qrow0, kb0, nt0, kb1 = 0, nt1 = 0, qpos0 = 0, kpos0 = 0; bool band = false;
        if (u < 1024) { b = u >> 7; head = (u >> 3) & 15; qb = u & 7; qrow0 = TC + b * 2048 + qb * 256; const int kbase = TC + b * 2304;
            if (KIND == 0) { kb0 = kbase; nt0 = 36; }
            else { const int lo = qb * 256 - 128 < 0 ? 0 : qb * 256 - 128, hi = qb * 256 + 384 > 2048 ? 2048 : qb * 256 + 384; kb0 = kbase + lo; nt0 = (hi - lo) >> 6; kb1 = kbase + 2048; nt1 = 4; band = true; qpos0 = qb * 256; kpos0 = lo; }
        } else { const int v = u - 1024; b = v >> 4; head = v & 15; qb = 0; qrow0 = b * 256; kb0 = b * 256; nt0 = 4; }
        if (KIND == 0)
            attn_unit<64>(lds, Q + head * 192, 3072, qrow0, K1 + head * 128, 2048, K2, 64, VT + (size_t)(head * 128) * NKEY, NKEY, O + head * 128, D,
                          0.07216878364870322f * LOG2E, false, 0.f, kb0, nt0, kb1, nt1, false, 0, 0);
        else
            attn_unit<0>(lds, Q + head * 128, D, qrow0, K1 + (head >> 2) * 128, 512, nullptr, 0, VT + (size_t)((head >> 2) * 128) * NKEY, NKEY, O + head * 128, D,
                         0.08838834764831845f * LOG2E, true, sink[head] * LOG2E, kb0, nt0, kb1, nt1, band, qpos0, kpos0);
    }
}

__device__ __forceinline__ void s5_chain(LDSP unsigned char* wl, const bf16_t* __restrict__ U, bf16_t* __restrict__ Y, int rowbase, int L, int b, int g, int dir,
        const float* __restrict__ lam_re, const float* __restrict__ lam_im, const float* __restrict__ log_dt, const float* __restrict__ b_re, const float* __restrict__ b_im,
        const float* __restrict__ c_re, const float* __restrict__ c_im, const float* __restrict__ h0re, const float* __restrict__ h0im, float* __restrict__ fin_re, float* __restrict__ fin_im) {
    const int lane = threadIdx.x & 63, fr = lane & 15, fq = lane >> 4, p = lane;
    const int pg = dir * 128 + g;
    float a_re, a_im, cf_re, cf_im;
    { const float lr = lam_re[pg * 64 + p], li = lam_im[pg * 64 + p], dt = __expf(log_dt[pg]);
      const float ea = __expf(lr * dt); float sn, cs; sincosf(li * dt, &sn, &cs); a_re = ea * cs; a_im = ea * sn;
      const float den = 1.f / (lr * lr + li * li), nr = a_re - 1.f, ni = a_im; cf_re = (nr * lr + ni * li) * den; cf_im = (ni * lr - nr * li) * den; }
    bf16x8 Bf[8];
#pragma unroll
    for (int k = 0; k < 4; ++k) {
        const int pk = 16 * k + fr; const float cr = __shfl(cf_re, pk), cim = __shfl(cf_im, pk);
        u32x4 wre = (u32x4){0u, 0u, 0u, 0u}, wim = (u32x4){0u, 0u, 0u, 0u};
        if (fq < 2) {
            const float* br = b_re + ((size_t)pg * 64 + pk) * 16 + 8 * fq; const float* bi = b_im + ((size_t)pg * 64 + pk) * 16 + 8 * fq;
            const f32x4 r0 = *(const f32x4*)br, r1 = *(const f32x4*)(br + 4), i0 = *(const f32x4*)bi, i1 = *(const f32x4*)(bi + 4);
            const f32x4 xr0 = r0 * cr - i0 * cim, xr1 = r1 * cr - i1 * cim, xi0 = i0 * cr + r0 * cim, xi1 = i1 * cr + r1 * cim;
            wre.x = pk_bf16(xr0[0], xr0[1]); wre.y = pk_bf16(xr0[2], xr0[3]); wre.z = pk_bf16(xr1[0], xr1[1]); wre.w = pk_bf16(xr1[2], xr1[3]);
            wim.x = pk_bf16(xi0[0], xi0[1]); wim.y = pk_bf16(xi0[2], xi0[3]); wim.z = pk_bf16(xi1[0], xi1[1]); wim.w = pk_bf16(xi1[2], xi1[3]);
        }
        Bf[k] = as_bf16x8(wre); Bf[4 + k] = as_bf16x8(wim);
    }
    bf16x8 Cf[4];
#pragma unroll
    for (int ks = 0; ks < 4; ++ks) {
        const float* src = (ks < 2 ? c_re : c_im) + ((size_t)pg * 16 + fr) * 64 + (ks & 1) * 32 + 8 * fq;
        f32x4 v0 = *(const f32x4*)src, v1 = *(const f32x4*)(src + 4);
        if (ks >= 2) { v0 = -v0; v1 = -v1; }
        u32x4 w; w.x = pk_bf16(v0[0], v0[1]); w.y = pk_bf16(v0[2], v0[3]); w.z = pk_bf16(v1[0], v1[1]); w.w = pk_bf16(v1[2], v1[3]); Cf[ks] = as_bf16x8(w);
    }
    float h_re = 0.f, h_im = 0.f;
    if (h0re) { const size_t hi = (((size_t)b * 2 + dir) * 128 + g) * 64 + p; h_re = h0re[hi]; h_im = h0im[hi]; }
    LDSP float* BUl = (LDSP float*)wl;
    LDSP unsigned char* Hl = wl + 16 * 132 * 4;
    const int nch = L >> 4;
    const bf16_t* ubase = U + (size_t)rowbase * D + 16 * g + 8 * fq;
    u32x4 uf = (u32x4){0u, 0u, 0u, 0u};
    if (fq < 2) { const int tt = dir ? L - 1 - fr : fr; uf = *(const u32x4*)(ubase + (size_t)tt * D); }
    for (int ci = 0; ci < nch; ++ci) {
        u32x4 ufn = (u32x4){0u, 0u, 0u, 0u};
        if (fq < 2 && ci + 1 < nch) { const int r = 16 * (ci + 1) + fr, tt = dir ? L - 1 - r : r; ufn = *(const u32x4*)(ubase + (size_t)tt * D); }
        const bf16x8 ua = as_bf16x8(uf);
#pragma unroll
        for (int nt = 0; nt < 8; ++nt) {
            const f32x4 bu = __builtin_amdgcn_mfma_f32_16x16x32_bf16(ua, Bf[nt], (f32x4){0.f, 0.f, 0.f, 0.f}, 0, 0, 0);
#pragma unroll
            for (int j = 0; j < 4; ++j) BUl[(4 * fq + j) * 132 + 16 * nt + fr] = bu[j];
        }
        WAVE_SYNC();
#pragma unroll
        for (int r = 0; r < 16; ++r) {
            const float br = BUl[r * 132 + p], bi = BUl[r * 132 + 64 + p];
            const float nre = a_re * h_re - a_im * h_im + br, nim = a_re * h_im + a_im * h_re + bi;
            h_re = nre; h_im = nim;
            *(LDSP bf16_t*)(Hl + r * 272 + p * 2) = f2bf(h_re); *(LDSP bf16_t*)(Hl + r * 272 + 128 + p * 2) = f2bf(h_im);
        }
        WAVE_SYNC();
        f32x4 y = (f32x4){0.f, 0.f, 0.f, 0.f};
#pragma unroll
        for (int ks = 0; ks < 4; ++ks) { const bf16x8 hf = *(const LDSP bf16x8*)(Hl + fr * 272 + (32 * ks + 8 * fq) * 2); y = __builtin_amdgcn_mfma_f32_16x16x32_bf16(hf, Cf[ks], y, 0, 0, 0); }
#pragma unroll
        for (int j = 0; j < 4; ++j) { const int r = 16 * ci + 4 * fq + j, tt = dir ? L - 1 - r : r; Y[(size_t)(rowbase + tt) * D + 16 * g + fr] = f2bf(y[j]); }
        WAVE_SYNC();
        uf = ufn;
    }
    if (fin_re) { const size_t fi = (((size_t)b * 2 + dir) * 128 + g) * 64 + p; fin_re[fi] = h_re; fin_im[fi] = h_im; }
}
__device__ __forceinline__ void s5_scan_phase(LDSP unsigned char* lds, const bf16_t* U, bf16_t* YF, bf16_t* YB, const float* const* in, float* out) {
    const int wave = threadIdx.x >> 6, gw = blockIdx.x * 8 + wave, nw = gridDim.x * 8;
    LDSP unsigned char* wl = lds + wave * 12800;
    for (int c = gw; c < 2048; c += nw) {
        const int b = c >> 8, g = (c >> 1) & 127, dir = c & 1;
        s5_chain(wl, U, dir ? YB : YF, TC + b * 2048, 2048, b, g, dir, in[I_S5LRE], in[I_S5LIM], in[I_S5LDT], in[I_S5BRE], in[I_S5BIM], in[I_S5CRE], in[I_S5CIM], in[I_S5RE], in[I_S5IM], nullptr, nullptr);
    }
    for (int c = gw; c < 4096; c += nw) {
        const int b = c >> 8, g = (c >> 1) & 127, dir = c & 1;
        s5_chain(wl, U, dir ? YB : YF, b * 256, 256, b, g, dir, in[I_S5LRE], in[I_S5LIM], in[I_S5LDT], in[I_S5BRE], in[I_S5BIM], in[I_S5CRE], in[I_S5CIM], nullptr, nullptr, out + OUT_S5RE, out + OUT_S5IM);
    }
}
__device__ __forceinline__ void s5_combine_phase(const bf16_t* __restrict__ U, const bf16_t* __restrict__ YF, const bf16_t* __restrict__ YB, const float* __restrict__ dvec, bf16_t* __restrict__ Z) {
    const size_t ng = (size_t)T * D / 8, stride = (size_t)gridDim.x * NTH;
    constexpr int NU = 4;
    size_t gi = (size_t)blockIdx.x * NTH + threadIdx.x;
    const int col = (int)((gi * 8) & 2047); const f32x4 d0 = *(const f32x4*)(dvec + col), d1 = *(const f32x4*)(dvec + col + 4);
#define S5C_ONE(u_, yf_, yb_, g_) do { u32x4 w; \
        w.x = pk_bf16(gelu_tanh(d0[0] * bf_lo(u_.x) + bf_lo(yf_.x) + bf_lo(yb_.x)), gelu_tanh(d0[1] * bf_hi(u_.x) + bf_hi(yf_.x) + bf_hi(yb_.x))); \
        w.y = pk_bf16(gelu_tanh(d0[2] * bf_lo(u_.y) + bf_lo(yf_.y) + bf_lo(yb_.y)), gelu_tanh(d0[3] * bf_hi(u_.y) + bf_hi(yf_.y) + bf_hi(yb_.y))); \
        w.z = pk_bf16(gelu_tanh(d1[0] * bf_lo(u_.z) + bf_lo(yf_.z) + bf_lo(yb_.z)), gelu_tanh(d1[1] * bf_hi(u_.z) + bf_hi(yf_.z) + bf_hi(yb_.z))); \
        w.w = pk_bf16(gelu_tanh(d1[2] * bf_lo(u_.w) + bf_lo(yf_.w) + bf_lo(yb_.w)), gelu_tanh(d1[3] * bf_hi(u_.w) + bf_hi(yf_.w) + bf_hi(yb_.w))); \
        *(u32x4*)(Z + (g_) * 8) = w; } while (0)
    for (; gi + (NU - 1) * stride < ng; gi += NU * stride) {
        u32x4 u[NU], yf[NU], yb[NU];
#pragma unroll
        for (int k = 0; k < NU; ++k) { const size_t g = gi + k * stride; u[k] = *(const u32x4*)(U + g * 8); yf[k] = *(const u32x4*)(YF + g * 8); yb[k] = *(const u32x4*)(YB + g * 8); }
        asm volatile("" ::: "memory"); __builtin_amdgcn_sched_barrier(0);
#pragma unroll
        for (int k = 0; k < NU; ++k) { const size_t g = gi + k * stride; S5C_ONE(u[k], yf[k], yb[k], g); }
    }
    for (; gi < ng; gi += stride) { const u32x4 u = *(const u32x4*)(U + gi * 8), yf = *(const u32x4*)(YF + gi * 8), yb = *(const u32x4*)(YB + gi * 8); S5C_ONE(u, yf, yb, gi); }
#undef S5C_ONE
}

__device__ __forceinline__ u32x4 shl_elems(u32x4 lo, u32x4 hi, int s) {
    const unsigned d[8] = {lo.x, lo.y, lo.z, lo.w, hi.x, hi.y, hi.z, hi.w};
    const int dw = s >> 1; u32x4 r;
    if (s & 1) { r.x = __builtin_amdgcn_alignbyte(d[dw + 1], d[dw], 2); r.y = __builtin_amdgcn_alignbyte(d[dw + 2], d[dw + 1], 2); r.z = __builtin_amdgcn_alignbyte(d[dw + 3], d[dw + 2], 2); r.w = __builtin_amdgcn_alignbyte(d[(dw + 4) & 7], d[dw + 3], 2); }
    else { r.x = d[dw]; r.y = d[dw + 1]; r.z = d[dw + 2]; r.w = d[dw + 3]; }
    return r;
}
template <int NB, int L, bool ROLL, int GW>
__device__ __forceinline__ void hy_conv_unit(LDSP unsigned char* lds0, int d0, int tokbase, const bf16_t* __restrict__ ZT, const bf16_t* __restrict__ Fg,
        const float* __restrict__ short_w, const float* __restrict__ short_b, const float* __restrict__ bias, bf16_t* __restrict__ VOT, int dnext, unsigned& sink) {
    constexpr int VSROW = L * 2 + 16, FCROW = 4 * L + 32, NT = L / 16, TPW = NT / GW, NTHG = 64 * GW, GSZ = 2 * NB * VSROW + 8 * FCROW;
    static_assert(!ROLL || (TPW == 16 && GW == 8), "rolling window is written for 16 tiles per wave");
    static_assert((8 / GW) * GSZ <= LDS_BYTES, "LDS");
    const int tid = threadIdx.x, lane = tid & 63, wv = __builtin_amdgcn_readfirstlane(tid >> 6), grp = GW == 8 ? 0 : wv / GW, wave = GW == 8 ? wv : wv % GW, gtid = tid % NTHG, d = d0 + grp, fr = lane & 15, fq = lane >> 4;
    LDSP unsigned char* lds = lds0 + grp * GSZ;
    LDSP unsigned char* VS = lds; LDSP unsigned char* XS = lds + NB * VSROW; LDSP unsigned char* FC = lds + 2 * NB * VSROW;
#define HY_T0(i_) (ROLL ? 16 * (16 * wave + (i_)) : 16 * (wave + GW * (i_)))
    constexpr int NCH = NB * L / 8 / NTHG;
#define HY_FENCE() do { asm volatile("" ::: "memory"); __builtin_amdgcn_sched_barrier(0); } while (0)
#define HY_PINW(cw_) asm volatile("" : "+v"(cw_[0]), "+v"(cw_[1]), "+v"(cw_[2]), "+v"(cw_[3]))
#define HY_PINF(a_, b_, c_) asm volatile("" : "+v"(a_), "+v"(b_), "+v"(c_))
#define HY_LD(zq_, zl_, zr_, ch_) do { const bf16_t* base_ = ZT + (size_t)(ch_) * T + tokbase; \
        _Pragma("unroll") for (int k_ = 0; k_ < NCH; ++k_) { const int c_ = gtid + k_ * NTHG, b_ = c_ / (L / 8), t8_ = (c_ % (L / 8)) * 8; const bf16_t* src_ = base_ + b_ * L; \
            zq_[k_] = *(const u32x4*)(src_ + t8_); zl_[k_] = src_[t8_ > 0 ? t8_ - 1 : 0]; zr_[k_] = src_[t8_ + 8 < L ? t8_ + 8 : L - 1]; } } while (0)
#define HY_LDW(cw_, ch_) do { const int chv_ = (ch_); cw_[0] = short_w[chv_]; cw_[1] = short_w[6144 + chv_]; cw_[2] = short_w[2 * 6144 + chv_]; cw_[3] = short_b[chv_]; } while (0)
#define HY_ST(dst_, zq_, zl_, zr_, cw_) do { const float w0_ = cw_[0], w1_ = cw_[1], w2_ = cw_[2], sb_ = cw_[3]; \
        _Pragma("unroll") for (int k_ = 0; k_ < NCH; ++k_) { const int c_ = gtid + k_ * NTHG, b_ = c_ / (L / 8), t8_ = (c_ % (L / 8)) * 8; \
            const u32x4 z_ = zq_[k_]; float zz_[10]; zz_[0] = t8_ > 0 ? bf2f(zl_[k_]) : 0.f; zz_[9] = t8_ + 8 < L ? bf2f(zr_[k_]) : 0.f; \
            zz_[1] = bf_lo(z_.x); zz_[2] = bf_hi(z_.x); zz_[3] = bf_lo(z_.y); zz_[4] = bf_hi(z_.y); zz_[5] = bf_lo(z_.z); zz_[6] = bf_hi(z_.z); zz_[7] = bf_lo(z_.w); zz_[8] = bf_hi(z_.w); \
            float o_[8]; _Pragma("unroll") for (int j_ = 0; j_ < 8; ++j_) o_[j_] = w0_ * zz_[j_] + w1_ * zz_[j_ + 1] + w2_ * zz_[j_ + 2] + sb_; \
            u32x4 w_; w_.x = pk_bf16(o_[0], o_[1]); w_.y = pk_bf16(o_[2], o_[3]); w_.z = pk_bf16(o_[4], o_[5]); w_.w = pk_bf16(o_[6], o_[7]); \
            *(LDSP u32x4*)((dst_) + b_ * VSROW + t8_ * 2) = w_; } } while (0)
    constexpr int NQ = 2 * L / 8;
    static_assert(NQ <= NTHG, "filter groups");
#define HY_FLD(cm_, c0_, cp_, o_) do { const bf16_t* Fo_ = Fg + ((size_t)(o_) * 2048 + d) * (size_t)(2 * L); const int q_ = gtid < NQ ? gtid : 0; \
        cm_ = *(const u32x4*)(Fo_ + 8 * (q_ > 0 ? q_ - 1 : 0)); c0_ = *(const u32x4*)(Fo_ + 8 * q_); cp_ = *(const u32x4*)(Fo_ + 8 * (q_ + 1 < NQ ? q_ + 1 : q_)); } while (0)
#define HY_FST(cm_, c0_, cp_) do { if (gtid < NQ) { const int q_ = gtid; const u32x4 z0_ = (u32x4){0u, 0u, 0u, 0u}; const u32x4 cmv_ = q_ > 0 ? cm_ : z0_, cpv_ = q_ + 1 < NQ ? cp_ : z0_; \
            *(LDSP u32x4*)(FC + 0 * FCROW + q_ * 16) = shl_elems(cmv_, c0_, 7); \
            _Pragma("unroll") for (int c_ = 1; c_ < 8; ++c_) *(LDSP u32x4*)(FC + c_ * FCROW + q_ * 16) = shl_elems(c0_, cpv_, c_ - 1); } } while (0)
#define HY_AFRAG(phi_) (*(const LDSP bf16x8*)(FC + cc_ * FCROW + ((8 * fq - 16 * (phi_) - fr + L) - cc_) * 2))
#define HY_CONV(Bsrc_) do { _Pragma("unroll") for (int i_ = 0; i_ < TPW; ++i_) acc[i_] = (f32x4){0.f, 0.f, 0.f, 0.f}; \
        const int bsel_ = fr & (NB - 1), cc_ = (16 - fr) & 7; \
        if constexpr (ROLL) { \
            bf16x8 W_[16]; \
            _Pragma("unroll") for (int j_ = 0; j_ < 16; ++j_) W_[j_] = HY_AFRAG(16 * wave + j_); \
            bf16x8 bfn_ = *(const LDSP bf16x8*)((Bsrc_) + bsel_ * VSROW + (8 * fq) * 2); \
            _Pragma("unroll 1") for (int mb_ = 0; mb_ < L / 32; mb_ += 8) { \
                _Pragma("unroll") for (int mm_ = 0; mm_ < 8; ++mm_) { const int m_ = mb_ + mm_; \
                    const bf16x8 bf_ = bfn_; bfn_ = *(const LDSP bf16x8*)((Bsrc_) + bsel_ * VSROW + (32 * (m_ + 1 < L / 32 ? m_ + 1 : m_) + 8 * fq) * 2); \
                    _Pragma("unroll") for (int jj_ = 2; jj_ < 18; ++jj_) { const int j_ = jj_ & 15; acc[j_] = __builtin_amdgcn_mfma_f32_16x16x32_bf16(W_[(j_ - 2 * mm_) & 15], bf_, acc[j_], 0, 0, 0); }   \
                    if (m_ + 1 < L / 32) { W_[(0 - 2 * (mm_ + 1)) & 15] = HY_AFRAG(16 * wave - 2 * (m_ + 1)); W_[(1 - 2 * (mm_ + 1)) & 15] = HY_AFRAG(16 * wave + 1 - 2 * (m_ + 1)); } } } \
        } else { \
            for (int s0_ = 0; s0_ < L; s0_ += 32) { const bf16x8 bf_ = *(const LDSP bf16x8*)((Bsrc_) + bsel_ * VSROW + (s0_ + 8 * fq) * 2); \
                _Pragma("unroll") for (int i_ = 0; i_ < TPW; ++i_) { const int t0_ = HY_T0(i_), idx_ = 8 * fq - (t0_ - s0_) - fr + L, x0_ = idx_ - cc_; \
                    const bf16x8 af_ = *(const LDSP bf16x8*)(FC + cc_ * FCROW + x0_ * 2); acc[i_] = __builtin_amdgcn_mfma_f32_16x16x32_bf16(af_, bf_, acc[i_], 0, 0, 0); } } } } while (0)
    f32x4 acc[TPW];
#define HY_TOUCH(dst_, ptr_, nlines_, off_) do { const int li_ = tid - (off_); if (li_ >= 0 && li_ < (nlines_)) dst_ = *(const unsigned*)((const char*)(ptr_) + (size_t)li_ * 128); } while (0)
    constexpr bool HY_USE_TOUCH = false;
    unsigned tc0 = 0u, tc1 = 0u, tc2 = 0u;
    { u32x4 za[NCH], zb[NCH], fm, f0, fp; bf16_t zal[NCH], zar[NCH], zbl[NCH], zbr[NCH]; float cwa[4], cwb[4];
      HY_LD(za, zal, zar, 4096 + d); HY_LD(zb, zbl, zbr, d); HY_FLD(fm, f0, fp, 0); HY_LDW(cwa, 4096 + d); HY_LDW(cwb, d); HY_PINW(cwa); HY_PINW(cwb); HY_PINF(fm, f0, fp); HY_FENCE();
      HY_ST(VS, za, zal, zar, cwa); HY_ST(XS, zb, zbl, zbr, cwb); HY_FST(fm, f0, fp); }
    __syncthreads();
    if constexpr (ROLL && HY_USE_TOUCH) { HY_TOUCH(tc0, ZT + (size_t)(2048 + d) * T + tokbase, NB * L * 2 / 128, 0); HY_TOUCH(tc0, Fg + ((size_t)2048 + d) * (size_t)(2 * L), 2 * L * 2 / 128, NB * L * 2 / 128); }
    HY_CONV(VS);
    sink ^= tc0;
    { const float bias0 = bias[d];
      if (fr < NB) {
#pragma unroll
        for (int i = 0; i < TPW; ++i) { const int t0 = HY_T0(i) + 4 * fq;
            const u32x2 vs = *(const LDSP u32x2*)(VS + fr * VSROW + t0 * 2), x1 = *(const LDSP u32x2*)(XS + fr * VSROW + t0 * 2);
            u32x2 w; w.x = pk_bf16(bf_lo(x1.x) * (acc[i][0] + bias0 * bf_lo(vs.x)), bf_hi(x1.x) * (acc[i][1] + bias0 * bf_hi(vs.x)));
            w.y = pk_bf16(bf_lo(x1.y) * (acc[i][2] + bias0 * bf_lo(vs.y)), bf_hi(x1.y) * (acc[i][3] + bias0 * bf_hi(vs.y)));
            *(LDSP u32x2*)(XS + fr * VSROW + t0 * 2) = w; } } }
    __syncthreads();
    { u32x4 za[NCH], fm, f0, fp; bf16_t zal[NCH], zar[NCH]; float cwa[4];
      HY_LD(za, zal, zar, 2048 + d); HY_FLD(fm, f0, fp, 1); HY_LDW(cwa, 2048 + d); HY_PINW(cwa); HY_PINF(fm, f0, fp); HY_FENCE();
      HY_ST(VS, za, zal, zar, cwa); HY_FST(fm, f0, fp); }
    __syncthreads();
    if constexpr (ROLL && HY_USE_TOUCH) { if (dnext >= 0) { HY_TOUCH(tc1, ZT + (size_t)(4096 + dnext) * T + tokbase, NB * L * 2 / 128, 0); HY_TOUCH(tc1, ZT + (size_t)dnext * T + tokbase, NB * L * 2 / 128, NB * L * 2 / 128);
        HY_TOUCH(tc2, Fg + (size_t)dnext * (size_t)(2 * L), 2 * L * 2 / 128, 0); } }
    HY_CONV(XS);
    sink ^= tc1 ^ tc2;
    { const float bias1 = bias[2048 + d];
      if (fr < NB) {
#pragma unroll
        for (int i = 0; i < TPW; ++i) { const int t0 = HY_T0(i) + 4 * fq;
            const u32x2 x2 = *(const LDSP u32x2*)(VS + fr * VSROW + t0 * 2), v1 = *(const LDSP u32x2*)(XS + fr * VSROW + t0 * 2);
            u32x2 w; w.x = pk_bf16(bf_lo(x2.x) * (acc[i][0] + bias1 * bf_lo(v1.x)), bf_hi(x2.x) * (acc[i][1] + bias1 * bf_hi(v1.x)));
            w.y = pk_bf16(bf_lo(x2.y) * (acc[i][2] + bias1 * bf_lo(v1.y)), bf_hi(x2.y) * (acc[i][3] + bias1 * bf_hi(v1.y)));
            *(u32x2*)(VOT + (size_t)d * T + tokbase + fr * L + t0) = w; } } }
    __syncthreads();
#undef HY_TOUCH
#undef HY_LD
#undef HY_LDW
#undef HY_ST
#undef HY_FLD
#undef HY_FST
#undef HY_FENCE
#undef HY_PINW
#undef HY_PINF
#undef HY_CONV
#undef HY_AFRAG
#undef HY_T0
}
__device__ __forceinline__ void hy_conv_phase(LDSP unsigned char* lds, const bf16_t* ZT, const bf16_t* F, const float* short_w, const float* short_b, const float* bias, bf16_t* VOT, unsigned* sinkp) {
    unsigned sink = 0u;
    for (int u = blockIdx.x; u < 2048 + 512; u += gridDim.x) {
        if (u < 2048) hy_conv_unit<8, 2048, true, 8>(lds, u, TC, ZT, F + (size_t)2 * 2048 * 512, short_w, short_b, bias, VOT, u + (int)gridDim.x < 2048 ? u + (int)gridDim.x : -1, sink);
        else hy_conv_unit<16, 256, false, 2>(lds, 4 * (u - 2048), 0, ZT, F, short_w, short_b, bias, VOT, -1, sink);
    }
    if (sink == 0x9e3779b9u) *sinkp = sink;
}
__device__ __forceinline__ void transpose_phase(LDSP unsigned char* lds, const bf16_t* __restrict__ VOT, bf16_t* __restrict__ VO) {
    constexpr int NTB = 8, TSZ = 64 * 66;
    LDSP bf16_t* tiles = (LDSP bf16_t*)lds;
    const int tid = threadIdx.x;
    for (int t0 = blockIdx.x * NTB; t0 < 32 * 320; t0 += gridDim.x * NTB) {
        u32x4 v[NTB];
        { const int r = tid >> 3, part = tid & 7;
#pragma unroll
          for (int i = 0; i < NTB; ++i) { const int t = t0 + i, d0 = (t & 31) * 64, k0 = (t >> 5) * 64; v[i] = *(const u32x4*)(VOT + (size_t)(d0 + r) * T + k0 + part * 8); }
#pragma unroll
          for (int i = 0; i < NTB; ++i) { LDSP bf16_t* dst = tiles + i * TSZ + r * 66 + part * 8;
            dst[0] = (bf16_t)(v[i].x & 0xffff); dst[1] = (bf16_t)(v[i].x >> 16); dst[2] = (bf16_t)(v[i].y & 0xffff); dst[3] = (bf16_t)(v[i].y >> 16);
            dst[4] = (bf16_t)(v[i].z & 0xffff); dst[5] = (bf16_t)(v[i].z >> 16); dst[6] = (bf16_t)(v[i].w & 0xffff); dst[7] = (bf16_t)(v[i].w >> 16); } }
        __syncthreads();
        { const int tok = tid >> 3, part = tid & 7;
#pragma unroll
          for (int i = 0; i < NTB; ++i) { const int t = t0 + i, d0 = (t & 31) * 64, k0 = (t >> 5) * 64; unsigned e[8];
#pragma unroll
            for (int j = 0; j < 8; ++j) e[j] = tiles[i * TSZ + (part * 8 + j) * 66 + tok];
            u32x4 w; w.x = e[0] | (e[1] << 16); w.y = e[2] | (e[3] << 16); w.z = e[4] | (e[5] << 16); w.w = e[6] | (e[7] << 16);
            *(u32x4*)(VO + (size_t)(k0 + tok) * D + d0 + part * 8) = w; } }
        __syncthreads();
    }
}

__device__ __forceinline__ unsigned f2sort(float f) { const unsigned u = __float_as_uint(f); return u ^ ((u >> 31) ? 0xffffffffu : 0x80000000u); }
__device__ __forceinline__ float sort2f(unsigned s) { return __uint_as_float((s & 0x80000000u) ? (s ^ 0x80000000u) : ~s); }
__device__ __forceinline__ unsigned umax4(unsigned v) { const unsigned a = __shfl_xor(v, 16); v = v > a ? v : a; const unsigned b = __shfl_xor(v, 32); return v > b ? v : b; }

template <int N> __device__ __forceinline__ void bitonic_sort_desc(unsigned (&v)[N]) {
#pragma unroll
    for (int k = 2; k <= N; k <<= 1)
#pragma unroll
        for (int j = k >> 1; j > 0; j >>= 1)
#pragma unroll
            for (int i = 0; i < N; ++i) { const int l = i ^ j;
                if (l > i) { const unsigned x = v[i], y = v[l], mx = x > y ? x : y, mn = x > y ? y : x; if ((i & k) == 0) { v[i] = mx; v[l] = mn; } else { v[i] = mn; v[l] = mx; } } }
}
__device__ __forceinline__ void merge_top16(unsigned (&v)[16], int xr) {
    unsigned c[16];
#pragma unroll
    for (int i = 0; i < 16; ++i) { const unsigned p = (unsigned)__shfl_xor((int)v[15 - i], xr); c[i] = v[i] > p ? v[i] : p; }
#pragma unroll
    for (int j = 8; j > 0; j >>= 1)
#pragma unroll
        for (int i = 0; i < 16; ++i) { const int l = i ^ j; if (l > i) { const unsigned x = c[i], y = c[l]; c[i] = x > y ? x : y; c[l] = x > y ? y : x; } }
#pragma unroll
    for (int i = 0; i < 16; ++i) v[i] = c[i];
}
__device__ __forceinline__ void cvt_table_i4(const float* __restrict__ src, unsigned char* __restrict__ dst, float* __restrict__ scale_inv, int row_lo, int nrows, int bofs, int nblk);
__device__ __forceinline__ void cvt_table_fp4(const float* __restrict__ src, unsigned char* __restrict__ dst, float* __restrict__ scale_inv, int row_lo, int nrows, int bofs, int nblk);
__device__ __forceinline__ void peer_select_phase(LDSP unsigned char* lds, const bf16_t* __restrict__ PQ, const bf16_t* __restrict__ KEYS  , int* __restrict__ EID, float* __restrict__ GATE,
        int next_layer = -1, const float* __restrict__ cu = nullptr, const float* __restrict__ cv = nullptr, unsigned char* __restrict__ tu = nullptr, unsigned char* __restrict__ tv = nullptr, float* __restrict__ tsc = nullptr) {
    constexpr int KR = 272;
    const int tid = threadIdx.x, lane = tid & 63, wave = tid >> 6, fr = lane & 15, fq = lane >> 4;
    const int h = blockIdx.x & 7, rk = blockIdx.x >> 3, nblk = ((int)gridDim.x - h + 7) >> 3, tstride = nblk * 8;
    for (int c = tid; c < 256 * 16; c += NTH) { const int row = c >> 4, part = c & 15; *(LDSP u32x4*)(lds + row * KR + part * 16) = *(const u32x4*)(KEYS + ((size_t)(h * 2) * 128 + row) * 128 + part * 8); }
    __syncthreads();
#define PS_CONVERT() do { if (next_layer >= 0) { const int G_ = (int)gridDim.x; const bool part_ = next_layer == 1 && G_ == 256;     \
        if (!part_) cvt_table_i4(cu, tu, tsc, next_layer * 16384, (next_layer + 1) * 16384, 0, G_); \
        cvt_table_fp4(cv, tv, tsc + 4 * 16384, next_layer * 16384 + (part_ ? 8192 : 0), (next_layer + 1) * 16384, 0, G_); } } while (0)
    if (wave >= 4) PS_CONVERT();
    LDSP int* wsc = (LDSP int*)(lds + 69632 + wave * 2048) + fr * 32;
    int tg = rk * 8 + wave;
    bf16x8 qf[2][4];
    if (tg < T / 16) {
#pragma unroll
        for (int pp = 0; pp < 2; ++pp)
#pragma unroll
            for (int ks = 0; ks < 4; ++ks) qf[pp][ks] = *(const bf16x8*)(PQ + (size_t)(tg * 16 + fr) * D + h * 256 + pp * 128 + 32 * ks + 8 * fq);
    }
    for (; tg < T / 16; tg += tstride) {
        const int tok = tg * 16 + fr;
        f32x4 acc[2][8];
#pragma unroll
        for (int pp = 0; pp < 2; ++pp) {
#pragma unroll
            for (int nt = 0; nt < 8; ++nt) acc[pp][nt] = (f32x4){0.f, 0.f, 0.f, 0.f};
#pragma unroll
            for (int ks = 0; ks < 4; ++ks)
#pragma unroll
                for (int nt = 0; nt < 8; ++nt) { const bf16x8 kf = *(const LDSP bf16x8*)(lds + (pp * 128 + 16 * nt + fr) * KR + (32 * ks + 8 * fq) * 2);
                    acc[pp][nt] = __builtin_amdgcn_mfma_f32_16x16x32_bf16(kf, qf[pp][ks], acc[pp][nt], 0, 0, 0); }
        }
        { const int tgn = tg + tstride < T / 16 ? tg + tstride : tg;
#pragma unroll
          for (int pp = 0; pp < 2; ++pp)
#pragma unroll
              for (int ks = 0; ks < 4; ++ks) qf[pp][ks] = *(const bf16x8*)(PQ + (size_t)(tgn * 16 + fr) * D + h * 256 + pp * 128 + 32 * ks + 8 * fq); }
        unsigned top[2][16];
#pragma unroll
        for (int pp = 0; pp < 2; ++pp) {
            unsigned key[32];
#pragma unroll
            for (int nt = 0; nt < 8; ++nt)
#pragma unroll
                for (int j = 0; j < 4; ++j) key[nt * 4 + j] = (f2sort(acc[pp][nt][j]) & ~127u) | (unsigned)(16 * nt + 4 * fq + j);
            bitonic_sort_desc<32>(key);
#pragma unroll
            for (int i = 0; i < 16; ++i) top[pp][i] = key[i];
            merge_top16(top[pp], 16); merge_top16(top[pp], 32);
        }
        if (fq == 0) {
#pragma unroll
            for (int i = 0; i < 16; ++i) { wsc[i] = (int)(top[0][i] & 127u); wsc[16 + i] = (int)(top[1][i] & 127u); }
        }
        float sA[4];
#pragma unroll
        for (int i = 0; i < 4; ++i) { const unsigned t0 = top[0][4 * i], t1 = top[0][4 * i + 1], t2 = top[0][4 * i + 2], t3 = top[0][4 * i + 3];
            sA[i] = sort2f((fq == 0 ? t0 : fq == 1 ? t1 : fq == 2 ? t2 : t3) & ~127u); }
        unsigned cand[16];
#pragma unroll
        for (int bb = 0; bb < 16; ++bb) cand[bb] = (f2sort(sA[0] + sort2f(top[1][bb] & ~127u)) & ~255u) | (unsigned)(fq << 4) | (unsigned)(15 - bb);
#pragma unroll
        for (int k = 0; k < 5; ++k) {
            const int i = k < 3 ? 1 : k == 3 ? 2 : 3, bb = k < 3 ? k : 0;
            unsigned x = (f2sort(sA[i] + sort2f(top[1][bb] & ~127u)) & ~255u) | (unsigned)((fq + 4 * i) << 4) | (unsigned)(15 - bb);
#pragma unroll
            for (int j = 0; j < 16; ++j) { const unsigned c0 = cand[j], mx = c0 > x ? c0 : x, mn = c0 > x ? x : c0; cand[j] = mx; x = mn; }
        }
        merge_top16(cand, 16); merge_top16(cand, 32);
        WAVE_SYNC();
        float es[16], sum = 0.f; int ids[16];
        const float v0 = sort2f(cand[0] & ~255u);
#pragma unroll
        for (int r = 0; r < 16; ++r) { const unsigned w = cand[r]; es[r] = __expf(sort2f(w & ~255u) - v0); sum += es[r];
            ids[r] = wsc[(w >> 4) & 15u] * 128 + wsc[16 + 15 - (int)(w & 15u)]; }
        const float inv = 1.f / sum;
        if (fq == 0) {
            int* ep = EID + (size_t)tok * 128 + 2 * h; float* gp = GATE + (size_t)tok * 128 + 2 * h;
#pragma unroll
            for (int r = 0; r < 16; ++r) { ep[(r & 7) * 16 + (r >> 3)] = ids[r]; gp[(r & 7) * 16 + (r >> 3)] = es[r] * inv; }
        }
        WAVE_SYNC();
    }
    if (wave < 4) PS_CONVERT();
#undef PS_CONVERT
}

#define PG_FENCE() do { asm volatile("" ::: "memory"); __builtin_amdgcn_sched_barrier(0); } while (0)
#define PE_ISSUE(buf_, tab_, ev_) do { _Pragma("unroll") for (int li_ = 0; li_ < 16; ++li_) { \
        const unsigned e_ = (unsigned)ev_[li_ >> 2][li_ & 3]; buf_[li_] = *(const u32x4*)((tab_) + (size_t)(e_ * 128u + sub16)); } } while (0)
#define PE_LOADE(ev_, n_) do { const int t_ = PE_TOK(n_); const u32x4* ep_ = (const u32x4*)(EID + (size_t)t_ * 128 + grp * 16); ev_[0] = ep_[0]; ev_[1] = ep_[1]; ev_[2] = ep_[2]; ev_[3] = ep_[3]; } while (0)
#define PE_TOK(n_) (((n_) < ntok ? t0 + (n_) * tstride : t0))

__device__ __forceinline__ void peer_u_phase(const unsigned* __restrict__ X8, const float* __restrict__ SX, const unsigned char* __restrict__ TU, const int* __restrict__ EID, bf16_t* __restrict__ PA) {
    const int lane = threadIdx.x & 63, wave = threadIdx.x >> 6, grp = lane >> 3, sub = lane & 7;
    const int vx = blockIdx.x & 7, rk = blockIdx.x >> 3, nblk = ((int)gridDim.x - vx + 7) >> 3, tstride = nblk * 8, t0 = rk * 8 + wave;
    const int ntok = t0 < T ? (T - t0 + tstride - 1) / tstride : 0, npair = (ntok + 1) >> 1;
    {
        const int s = vx;
        const unsigned char* tab = TU + (size_t)s * 16384 * 128 + 16 * sub;
        const unsigned* xb8 = X8 + 64 * s + 8 * sub;
        bf16_t* pab = PA + (size_t)s * T * 128 + grp * 16;
        u32x4 b0[16], b1[16], xa0, xb0, xa1, xb1, ev[4], evn[4];
        float sx0, sx1;
        int p_[16], xs_;
#define PU_ISSUE_Q(buf_, ev_, q_) do { _Pragma("unroll") for (int li_ = 4 * (q_); li_ < 4 * (q_) + 4; ++li_) { \
        const unsigned e_ = (unsigned)ev_[li_ >> 2][li_ & 3]; buf_[li_] = *(const u32x4*)(tab + (size_t)(e_ * 128u)); } } while (0)
#define PU_ISSUE(buf_, ev_) do { PU_ISSUE_Q(buf_, ev_, 0); PU_ISSUE_Q(buf_, ev_, 1); PU_ISSUE_Q(buf_, ev_, 2); PU_ISSUE_Q(buf_, ev_, 3); } while (0)
#define PU_LOADX(xa_, xb_, sx_, n_) do { const int t_ = PE_TOK(n_); xa_ = *(const u32x4*)(xb8 + (size_t)t_ * 512); xb_ = *(const u32x4*)(xb8 + (size_t)t_ * 512 + 4); sx_ = SX[t_]; } while (0)
#define PU_D4(w_, xlo_, xhi_, a_) do { a_ = __builtin_amdgcn_sdot4((int)((w_) & 0x0f0f0f0fu), (int)(xlo_), a_, false); a_ = __builtin_amdgcn_sdot4((int)(((w_) >> 4) & 0x0f0f0f0fu), (int)(xhi_), a_, false); } while (0)
#define PU_BEGIN(xa_, xb_) do { \
            xs_ = __builtin_amdgcn_sdot4(0x01010101, (int)xa_.x, 0, false); xs_ = __builtin_amdgcn_sdot4(0x01010101, (int)xa_.y, xs_, false); \
            xs_ = __builtin_amdgcn_sdot4(0x01010101, (int)xa_.z, xs_, false); xs_ = __builtin_amdgcn_sdot4(0x01010101, (int)xa_.w, xs_, false); \
            xs_ = __builtin_amdgcn_sdot4(0x01010101, (int)xb_.x, xs_, false); xs_ = __builtin_amdgcn_sdot4(0x01010101, (int)xb_.y, xs_, false); \
            xs_ = __builtin_amdgcn_sdot4(0x01010101, (int)xb_.z, xs_, false); xs_ = __builtin_amdgcn_sdot4(0x01010101, (int)xb_.w, xs_, false); xs_ *= -8; } while (0)
#define PU_ROWS(buf_, xa_, xb_, q_) do { _Pragma("unroll") for (int li_ = 4 * (q_); li_ < 4 * (q_) + 4; ++li_) { const u32x4 q4_ = buf_[li_]; int a_ = xs_; \
                PU_D4(q4_.x, xa_.x, xa_.y, a_); PU_D4(q4_.y, xa_.z, xa_.w, a_); PU_D4(q4_.z, xb_.x, xb_.y, a_); PU_D4(q4_.w, xb_.z, xb_.w, a_); p_[li_] = a_; } } while (0)
#define PU_END(sx_, n_) do { \
            int v8_[8], v4_[4], v2_[2]; \
            _Pragma("unroll") for (int i_ = 0; i_ < 8; ++i_) { const bool up_ = sub & 4; const int keep_ = up_ ? p_[i_ + 8] : p_[i_], send_ = up_ ? p_[i_] : p_[i_ + 8]; v8_[i_] = keep_ + dpp_i<0x141>(send_); } \
            _Pragma("unroll") for (int i_ = 0; i_ < 4; ++i_) { const bool up_ = sub & 2; const int keep_ = up_ ? v8_[i_ + 4] : v8_[i_], send_ = up_ ? v8_[i_] : v8_[i_ + 4]; v4_[i_] = keep_ + dpp_i<0x4E>(send_); } \
            _Pragma("unroll") for (int i_ = 0; i_ < 2; ++i_) { const bool up_ = sub & 1; const int keep_ = up_ ? v4_[i_ + 2] : v4_[i_], send_ = up_ ? v4_[i_] : v4_[i_ + 2]; v2_[i_] = keep_ + dpp_i<0xB1>(send_); } \
            f32x2 r_ = {(float)v2_[0] * sx_, (float)v2_[1] * sx_}; \
            if ((n_) < ntok) { const int lb_ = 2 * (sub & 1) + 4 * ((sub >> 1) & 1) + 8 * ((sub >> 2) & 1); *(unsigned*)(pab + (size_t)(t0 + (n_) * tstride) * 128 + lb_) = pk_bf16(r_.x, r_.y); } \
            asm volatile("" : "+v"(r_) :: "memory"); } while (0)
#define PU_KEEP(dst_, src_) do { dst_[0] = src_[0]; dst_[1] = src_[1]; dst_[2] = src_[2]; dst_[3] = src_[3]; } while (0)
#define PU_STEP(bc_, xac_, xbc_, sxc_, bn_, xan_, xbn_, sxn_, n_) do { \
            PU_BEGIN(xac_, xbc_); \
            PE_LOADE(evn, (n_) + 2); PU_ISSUE_Q(bn_, ev, 0); PG_FENCE(); PU_ROWS(bc_, xac_, xbc_, 0); PG_FENCE(); \
            PU_ISSUE_Q(bn_, ev, 1); PG_FENCE(); PU_ROWS(bc_, xac_, xbc_, 1); PG_FENCE(); \
            PU_ISSUE_Q(bn_, ev, 2); PG_FENCE(); PU_ROWS(bc_, xac_, xbc_, 2); PG_FENCE(); \
            PU_ISSUE_Q(bn_, ev, 3); PU_LOADX(xan_, xbn_, sxn_, (n_) + 1); PG_FENCE(); PU_ROWS(bc_, xac_, xbc_, 3); PU_END(sxc_, n_); PU_KEEP(ev, evn); PG_FENCE(); } while (0)
        if (ntok > 0) {
            PE_LOADE(ev, 0); PU_ISSUE(b0, ev); PU_LOADX(xa0, xb0, sx0, 0); PE_LOADE(ev, 1);
#pragma unroll 1
            for (int pr = 0; pr < npair; ++pr) {
                const int n = 2 * pr;
                PU_STEP(b0, xa0, xb0, sx0, b1, xa1, xb1, sx1, n);
                PU_STEP(b1, xa1, xb1, sx1, b0, xa0, xb0, sx0, n + 1);
            }
        }
#undef PU_STEP
#undef PU_KEEP
#undef PU_END
#undef PU_ROWS
#undef PU_BEGIN
#undef PU_ISSUE_Q
#undef PU_D4
#undef PU_LOADX
#undef PU_ISSUE
    }
}

__device__ __forceinline__ void peer_act_phase(const bf16_t* __restrict__ PA, const int* __restrict__ EID, const float* __restrict__ USC, const float* __restrict__ VSC, float* GATE, float* __restrict__ ISC) {
    const int n4 = T * 128 / 4, stride = gridDim.x * NTH;
    for (int i = blockIdx.x * NTH + threadIdx.x; i < n4; i += stride) {
        f32x4 acc = (f32x4){0.f, 0.f, 0.f, 0.f};
#pragma unroll
        for (int s = 0; s < 8; ++s) { const u32x2 p = *(const u32x2*)(PA + (size_t)s * T * 128 + (size_t)i * 4); acc += (f32x4){bf_lo(p.x), bf_hi(p.x), bf_lo(p.y), bf_hi(p.y)}; }
        const u32x4 e = *(const u32x4*)(EID + (size_t)i * 4); const f32x4 g = *(const f32x4*)(GATE + (size_t)i * 4);
        f32x4 w;
        w[0] = gelu_tanh(acc[0] * USC[e.x]) * g[0] * VSC[e.x]; w[1] = gelu_tanh(acc[1] * USC[e.y]) * g[1] * VSC[e.y];
        w[2] = gelu_tanh(acc[2] * USC[e.z]) * g[2] * VSC[e.z]; w[3] = gelu_tanh(acc[3] * USC[e.w]) * g[3] * VSC[e.w];
        float mx = fmaxf(fmaxf(fabsf(w[0]), fabsf(w[1])), fmaxf(fabsf(w[2]), fabsf(w[3])));
        mx = fmaxf(mx, __shfl_xor(mx, 1)); mx = fmaxf(mx, __shfl_xor(mx, 2)); mx = fmaxf(mx, __shfl_xor(mx, 4)); mx = fmaxf(mx, __shfl_xor(mx, 8)); mx = fmaxf(mx, __shfl_xor(mx, 16));
        const unsigned ex = __float_as_uint(mx) >> 23; const float sc = __uint_as_float((254u - ex) << 23);
        u32x4 o;
#pragma unroll
        for (int j = 0; j < 4; ++j) o[j] = (e[j] & 0xffffu) | ((unsigned)__builtin_bit_cast(unsigned short, (_Float16)(w[j] * sc)) << 16);
        *(u32x4*)(GATE + (size_t)i * 4) = o;
        if ((threadIdx.x & 31) == 0) ISC[i >> 5] = __uint_as_float(ex << 23);
    }
}

__device__ __forceinline__ void peer_v_phase(const unsigned char* __restrict__ TV, const int* __restrict__ EID  , const float* __restrict__ ISC, const float* __restrict__ g2  , const bf16_t* X, bf16_t* Xw) {
    const int lane = threadIdx.x & 63, wave = threadIdx.x >> 6, grp = lane >> 3, sub = lane & 7; const unsigned sub16 = 16u * sub;
    const int vx = blockIdx.x & 7, rk = blockIdx.x >> 3, nblk = ((int)gridDim.x - vx + 7) >> 3, tstride = nblk * 8, t0 = rk * 8 + wave;
    const int ntok = t0 < T ? (T - t0 + tstride - 1) / tstride : 0, npair = (ntok + 1) >> 1;
    {
        const int s = vx;
        const unsigned char* tab = TV + (size_t)s * 16384 * 128;
        const int colb = 256 * s + 32 * sub + 4 * grp;
        u32x4 b0[16], b1[16], ev[4], evn[4];
        u32x4 e0[4], e1[4]; u32x2 xo0, xo1; float is0, is1; f32x4 gg0, gg1;
#define PV_ISSUE_Q(buf_, ev_, q_) do { _Pragma("unroll") for (int li_ = 4 * (q_); li_ < 4 * (q_) + 4; ++li_) { \
            const unsigned e_ = (unsigned)ev_[li_ >> 2][li_ & 3] & 0xffffu; buf_[li_] = *(const u32x4*)(tab + (size_t)(e_ * 128u + sub16)); } } while (0)
#define PV_KEEP(keep_, ev_) do { keep_[0] = ev_[0]; keep_[1] = ev_[1]; keep_[2] = ev_[2]; keep_[3] = ev_[3]; } while (0)
#define PV_ISSUE(buf_, keep_, ev_) do { PV_ISSUE_Q(buf_, ev_, 0); PV_ISSUE_Q(buf_, ev_, 1); PV_ISSUE_Q(buf_, ev_, 2); PV_ISSUE_Q(buf_, ev_, 3); PV_KEEP(keep_, ev_); } while (0)
#define PV_LOADX(xo_, is_, gg_, n_) do { const int t_ = PE_TOK(n_); xo_ = *(const u32x2*)(X + (size_t)t_ * D + colb); is_ = ISC[t_]; gg_ = *(const f32x4*)(g2 + (size_t)cond_of(t_) * 4 * 12288 + colb); } while (0)
#define PV_CVT(w_, s_) __builtin_bit_cast(h2_t, __builtin_amdgcn_cvt_scalef32_pk_f16_fp4((w_), 1.0f, s_))
#define PV_DW(w_, o0_, o1_, o2_, o3_) do { o0_ = __builtin_elementwise_fma(PV_CVT(w_, 0), w2_, o0_); o1_ = __builtin_elementwise_fma(PV_CVT(w_, 1), w2_, o1_); \
            o2_ = __builtin_elementwise_fma(PV_CVT(w_, 2), w2_, o2_); o3_ = __builtin_elementwise_fma(PV_CVT(w_, 3), w2_, o3_); } while (0)
        h2_t o_[16];
#define PV_BEGIN() do { _Pragma("unroll") for (int j_ = 0; j_ < 16; ++j_) o_[j_] = (h2_t){(_Float16)0.f, (_Float16)0.f}; } while (0)
#define PV_ROWS(buf_, wv_, q_) do { _Pragma("unroll") for (int li_ = 4 * (q_); li_ < 4 * (q_) + 4; ++li_) { const u32x4 q4_ = buf_[li_]; unsigned ww_ = wv_[li_ >> 2][li_ & 3]; asm volatile("" : "+v"(ww_));   \
                const _Float16 wk_ = __builtin_bit_cast(h2_t, ww_).y; const h2_t w2_ = {wk_, wk_}; \
                PV_DW(q4_.x, o_[0], o_[1], o_[2], o_[3]); PV_DW(q4_.y, o_[4], o_[5], o_[6], o_[7]); PV_DW(q4_.z, o_[8], o_[9], o_[10], o_[11]); PV_DW(q4_.w, o_[12], o_[13], o_[14], o_[15]); } } while (0)
#define PV_END(xo_, isc_, gg_, n_) do { \
            h2_t v8_[8], v4_[4], v2_[2]; \
            _Pragma("unroll") for (int i_ = 0; i_ < 8; ++i_) v8_[i_] = xsum32h(o_[i_], o_[i_ + 8]); \
            _Pragma("unroll") for (int i_ = 0; i_ < 4; ++i_) v4_[i_] = xsum16h(v8_[i_], v8_[i_ + 4]); \
            _Pragma("unroll") for (int i_ = 0; i_ < 2; ++i_) { const bool up_ = grp & 1; const h2_t keep_ = up_ ? v4_[i_ + 2] : v4_[i_], send_ = up_ ? v4_[i_] : v4_[i_ + 2]; \
                v2_[i_] = keep_ + __builtin_bit_cast(h2_t, dpp_i<0x128>(__builtin_bit_cast(int, send_))); } \
            f32x4 r_ = {(float)v2_[0].x, (float)v2_[0].y, (float)v2_[1].x, (float)v2_[1].y}; r_ = r_ * isc_; \
            if ((n_) < ntok) { const int t_ = t0 + (n_) * tstride; const f32x4 g_ = gg_; \
                const f32x4 xf_ = {bf_lo(xo_.x), bf_hi(xo_.x), bf_lo(xo_.y), bf_hi(xo_.y)}; const f32x4 y_ = xf_ + g_ * r_; u32x2 yo_; yo_.x = pk_bf16(y_[0], y_[1]); yo_.y = pk_bf16(y_[2], y_[3]); *(u32x2*)(Xw + (size_t)t_ * D + colb) = yo_; } \
            asm volatile("" : "+v"(r_) :: "memory"); } while (0)
#define PV_STEP(bc_, ec_, xoc_, isc_, ggc_, bn_, en_, xon_, isn_, ggn_, n_) do { \
            PV_BEGIN(); \
            PE_LOADE(evn, (n_) + 2); PV_ISSUE_Q(bn_, ev, 0); PG_FENCE(); PV_ROWS(bc_, ec_, 0); PG_FENCE(); \
            PV_ISSUE_Q(bn_, ev, 1); PG_FENCE(); PV_ROWS(bc_, ec_, 1); PG_FENCE(); \
            PV_ISSUE_Q(bn_, ev, 2); PG_FENCE(); PV_ROWS(bc_, ec_, 2); PG_FENCE(); \
            PV_ISSUE_Q(bn_, ev, 3); PV_KEEP(en_, ev); PV_LOADX(xon_, isn_, ggn_, (n_) + 1); PG_FENCE(); PV_ROWS(bc_, ec_, 3); PV_END(xoc_, isc_, ggc_, n_); PV_KEEP(ev, evn); PG_FENCE(); } while (0)
        if (ntok > 0) {
            PE_LOADE(ev, 0); PV_ISSUE(b0, e0, ev); PV_LOADX(xo0, is0, gg0, 0); PE_LOADE(ev, 1);
#pragma unroll 1
            for (int pr = 0; pr < npair; ++pr) {
                const int n = 2 * pr;
                PV_STEP(b0, e0, xo0, is0, gg0, b1, e1, xo1, is1, gg1, n);
                PV_STEP(b1, e1, xo1, is1, gg1, b0, e0, xo0, is0, gg0, n + 1);
            }
        }
#undef PV_STEP
#undef PV_END
#undef PV_ROWS
#undef PV_BEGIN
#undef PV_KEEP
#undef PV_ISSUE_Q
#undef PV_DW
#undef PV_CVT
#undef PV_LOADX
#undef PV_ISSUE
    }
}
#undef PE_TOK
#undef PE_LOADE
#undef PE_ISSUE


__device__ __forceinline__ void cvt_table_i4(const float* __restrict__ src, unsigned char* __restrict__ dst, float* __restrict__ scale_inv, int row_lo, int nrows  , int bofs, int nblk  ) {
    const int lane = threadIdx.x & 63, gw = row_lo + ((int)blockIdx.x - bofs) * 8 + (threadIdx.x >> 6), nw = nblk * 8;
    f32x4 vn[8];
    if (gw < nrows) {
#pragma unroll
        for (int q = 0; q < 8; ++q) vn[q] = __builtin_nontemporal_load((const f32x4*)(src + (size_t)gw * 2048 + 256 * q + 4 * lane)); }
    for (int row = gw; row < nrows; row += nw) {
        f32x4 v[8]; float mx = 0.f, ss = 0.f;
#pragma unroll
        for (int q = 0; q < 8; ++q) v[q] = vn[q];
        { const int rn = row + nw < nrows ? row + nw : row;
#pragma unroll
          for (int q = 0; q < 8; ++q) vn[q] = __builtin_nontemporal_load((const f32x4*)(src + (size_t)rn * 2048 + 256 * q + 4 * lane)); }
        asm volatile("" ::: "memory"); __builtin_amdgcn_sched_barrier(0);
#pragma unroll
        for (int q = 0; q < 8; ++q) { mx = fmaxf(mx, fmaxf(fmaxf(fabsf(v[q][0]), fabsf(v[q][1])), fmaxf(fabsf(v[q][2]), fabsf(v[q][3])))); ss += v[q][0] * v[q][0] + v[q][1] * v[q][1] + v[q][2] * v[q][2] + v[q][3] * v[q][3]; }
        mx = fmaxf(mx, __shfl_xor(mx, 32)); mx = fmaxf(mx, __shfl_xor(mx, 16)); mx = fmaxf(mx, __shfl_xor(mx, 8)); mx = fmaxf(mx, __shfl_xor(mx, 4)); mx = fmaxf(mx, __shfl_xor(mx, 2)); mx = fmaxf(mx, __shfl_xor(mx, 1));
        ss = wave_sum(ss);
        float step = fminf(0.36f * sqrtf(ss * (1.f / 2048.f)), mx * (1.f / 7.f)); if (!(step > 0.f)) step = 1.f;
        const float sc = 1.f / step;
        const int layer = row >> 14, e = row & 16383;
#pragma unroll
        for (int q = 0; q < 8; ++q) {
            unsigned nib = 0u;
#pragma unroll
            for (int j = 0; j < 4; ++j) { int qi = (int)rintf(v[q][j] * sc); qi = qi < -7 ? -7 : qi > 7 ? 7 : qi; nib |= (unsigned)(qi + 8) << (8 * j); }
            const unsigned other = (unsigned)__shfl_xor((int)nib, 1);
            if ((lane & 1) == 0) *(unsigned*)(dst + (((size_t)layer * 8 + q) * 16384 + e) * 128 + 4 * (lane >> 1)) = nib | (other << 4); }
        if (lane == 0) scale_inv[row] = step;
    }
}

__device__ __forceinline__ void cvt_table_fp4(const float* __restrict__ src, unsigned char* __restrict__ dst, float* __restrict__ scale_inv, int row_lo, int nrows  , int bofs, int nblk  ) {
    const int lane = threadIdx.x & 63, gw = row_lo + ((int)blockIdx.x - bofs) * 8 + (threadIdx.x >> 6), nw = nblk * 8;
    f32x4 vn[8];
    if (gw < nrows) {
#pragma unroll
        for (int q = 0; q < 8; ++q) vn[q] = __builtin_nontemporal_load((const f32x4*)(src + (size_t)gw * 2048 + 256 * q + 4 * lane)); }
    for (int row = gw; row < nrows; row += nw) {
        f32x4 v[8]; float mx = 0.f, ss = 0.f;
#pragma unroll
        for (int q = 0; q < 8; ++q) v[q] = vn[q];
        { const int rn = row + nw < nrows ? row + nw : row;
#pragma unroll
          for (int q = 0; q < 8; ++q) vn[q] = __builtin_nontemporal_load((const f32x4*)(src + (size_t)rn * 2048 + 256 * q + 4 * lane)); }
        asm volatile("" ::: "memory"); __builtin_amdgcn_sched_barrier(0);
#pragma unroll
        for (int q = 0; q < 8; ++q) { mx = fmaxf(mx, fmaxf(fmaxf(fabsf(v[q][0]), fabsf(v[q][1])), fmaxf(fabsf(v[q][2]), fabsf(v[q][3])))); ss += v[q][0] * v[q][0] + v[q][1] * v[q][1] + v[q][2] * v[q][2] + v[q][3] * v[q][3]; }
        mx = fmaxf(mx, __shfl_xor(mx, 32)); mx = fmaxf(mx, __shfl_xor(mx, 16)); mx = fmaxf(mx, __shfl_xor(mx, 8)); mx = fmaxf(mx, __shfl_xor(mx, 4)); mx = fmaxf(mx, __shfl_xor(mx, 2)); mx = fmaxf(mx, __shfl_xor(mx, 1));
        ss = wave_sum(ss);
        float unit = fminf(0.48f * sqrtf(ss * (1.f / 2048.f)), mx * (1.f / 6.f)); if (!(unit > 0.f)) unit = 1.f;
        const float sc = 1.f / unit;
        const int layer = row >> 14, e = row & 16383;
#pragma unroll
        for (int q = 0; q < 8; ++q) {
            const float c0 = fminf(fmaxf(v[q][0] * sc, -6.f), 6.f), c1 = fminf(fmaxf(v[q][1] * sc, -6.f), 6.f), c2 = fminf(fmaxf(v[q][2] * sc, -6.f), 6.f), c3 = fminf(fmaxf(v[q][3] * sc, -6.f), 6.f);
            unsigned p = 0u;
            p = __builtin_amdgcn_cvt_scalef32_pk_fp4_f32(p, c0, c1, 1.0f, 0); p = __builtin_amdgcn_cvt_scalef32_pk_fp4_f32(p, c2, c3, 1.0f, 1);
            const unsigned other = (unsigned)__shfl_xor((int)p, 1);
            if ((lane & 1) == 0) *(unsigned*)(dst + (((size_t)layer * 8 + q) * 16384 + e) * 128 + 4 * (lane >> 1)) = (p & 0xffffu) | (other << 16); }
        if (lane == 0) scale_inv[row] = unit;
    }
}

#ifndef MK_PER_PHASE
#define MK_PER_PHASE 0
#endif
constexpr int N_PHASES = 47;
#ifndef DUP
#define DUP 0
#endif
struct Args { const float* in[N_IN]; float* out; unsigned char* ws; int lo, hi; };
static_assert(sizeof(Args) == (N_IN + 2) * 8 + 8, "Args has padding");

template <int LAYER>
__device__ __forceinline__ void peer_phases(int sub, LDSP unsigned char* lds, const Args& a, float* mod) {
    unsigned char* ws = a.ws; unsigned char* scr = ws + WS_SCR;
    bf16_t* X = (bf16_t*)(ws + WS_X); bf16_t* H = (bf16_t*)(ws + WS_H);
    const unsigned char* TU = ws + WS_UT + (size_t)LAYER * 16384 * (D / 2); const unsigned char* TV = ws + WS_VTAB + (size_t)LAYER * 16384 * (D / 2);
    const float* USC = (const float*)(ws + WS_TSC) + LAYER * 16384; const float* VSC = (const float*)(ws + WS_TSC) + (4 + LAYER) * 16384;
    int* EID = (int*)(ws + WS_EID); float* GATE = (float*)(ws + WS_GATE); bf16_t* PA = (bf16_t*)(scr + SC_PA);
    if (sub == 0) norm_phase<true>(nullptr, nullptr, X, a.in[I_N2G] + LAYER * D, mod + LAYER * 12288 + 6144, nullptr, (unsigned*)(scr + SC_X8), (float*)(scr + SC_SX));
    else if (sub == 1) run_gemm_i8_tok(lds, scr + SC_X8, ws + WS_PEERQ + (size_t)LAYER * D * D, 2048,
                                    FStoreBf16Scaled{(bf16_t*)(scr + SC_PQ), D, (const float*)(scr + SC_SX), (const float*)(ws + WS_PEERQ + 4 * (size_t)2048 * 2048) + LAYER * 2048});
    else if (sub == 2) peer_select_phase(lds, (const bf16_t*)(scr + SC_PQ), (const bf16_t*)(ws + WS_PKEYS) + (size_t)LAYER * 16 * 128 * 128, EID, GATE,
                                            LAYER < 3 ? LAYER + 1 : -1, a.in[I_PU], a.in[I_PV], ws + WS_UT, ws + WS_VTAB, (float*)(ws + WS_TSC));
    else if (sub == 3) { if (DUP & 1) peer_u_phase((const unsigned*)(scr + SC_X8), (const float*)(scr + SC_SX), TU, EID, PA); peer_u_phase((const unsigned*)(scr + SC_X8), (const float*)(scr + SC_SX), TU, EID, PA); }
    else if (sub == 4) peer_act_phase(PA, EID, USC, VSC, GATE, (float*)(scr + SC_ISC));
    else { if (DUP & 1) peer_v_phase(TV, (const int*)GATE, (const float*)(scr + SC_ISC), mod + LAYER * 12288 + 10240, X, (bf16_t*)(scr + 300 * MB)); peer_v_phase(TV, (const int*)GATE, (const float*)(scr + SC_ISC), mod + LAYER * 12288 + 10240, X, X); }
}

template <int PH>
__global__ void __launch_bounds__(NTH, 2) mk_fwd(Args a) {
    extern __shared__ __attribute__((aligned(16))) unsigned char lds_raw[];
    LDSP unsigned char* lds = (LDSP unsigned char*)lds_raw;
    unsigned char* ws = a.ws; unsigned char* scr = ws + WS_SCR;
    float* mod = (float*)(ws + WS_MOD); float* rope = (float*)(ws + WS_ROPE);
    bf16_t* X = (bf16_t*)(ws + WS_X); bf16_t* H = (bf16_t*)(ws + WS_H);
    const float* xp = a.in[I_XP]; const float* xs = a.in[I_XS];
    volatile LAS unsigned* xbw = (volatile LAS unsigned*)(lds + LDS_BYTES - 16);
    if (threadIdx.x == 0) { xbw[0] = 0u; xbw[1] = 0u; xbw[2] = 0u; xbw[3] = 0u; }
    __syncthreads();
    XcdBarrier bar; bar.bar = (unsigned*)(ws + WS_CTL); bar.x = 0; bar.st = xbw;
    if (!MK_PER_PHASE) bar = xcd_barrier_post((unsigned*)(ws + WS_CTL), xbw);
    const int lo = a.lo, hi = a.hi;
#ifndef ONLY
#define ONLY -1
#endif
#ifndef STOP_AFTER
#define STOP_AFTER 46
#endif
#define IN(k) ((PH < 0 || PH == (k)) && (ONLY < 0 || ONLY == (k)) && ((k) <= STOP_AFTER || (k) == 46) && lo <= (k) && (k) < hi)
#ifndef SEAMX
#define SEAMX 1
#endif
#define SEAM(k) do { if (!MK_PER_PHASE && IN((k) + 1)) { xcd_barrier(bar); if (SEAMX > 1) xcd_barrier(bar); } } while (0)

    if (IN(0)) {
#ifndef P0REP
#define P0REP 0
#endif
#define P0R(i) for (int rep_ = 0; rep_ < (((P0REP) >> (i)) & 1 ? 2 : 1); ++rep_)
        P0R(0) mod_phase(lds, a.in[I_CCTX], a.in[I_C], a.in[I_MODW], a.in[I_MODB], mod);
        rope_tables(rope);
        P0R(1) hy_filter_phase(lds, a.in[I_HFW1], a.in[I_HFB1], a.in[I_HFFREQ], a.in[I_HFW2], a.in[I_HFB2], a.in[I_HFW3], a.in[I_HLD], (bf16_t*)(ws + WS_HYF));
        P0R(2) cvt_transpose_all((LDSP float*)lds, a.in, ws);
        P0R(3) cvt_transpose_i8(lds, a.in[I_PWQ], ws + WS_PEERQ, (float*)(ws + WS_PEERQ + 4 * (size_t)2048 * 2048), 4);
        cvt_direct(a.in[I_PKEYS], (bf16_t*)(ws + WS_PKEYS), (size_t)4 * 16 * 128 * 128);
        P0R(4) { cvt_table_i4(a.in[I_PU], ws + WS_UT, (float*)(ws + WS_TSC), 0, 16384, 0, (int)gridDim.x);
                 cvt_table_fp4(a.in[I_PV], ws + WS_VTAB, (float*)(ws + WS_TSC) + 4 * 16384, 0, 16384, 0, (int)gridDim.x); }
        SEAM(0);
    }
    if (IN(1)) { norm_phase<false>(xp, xs, nullptr, a.in[I_N1G], mod, H); SEAM(1); }
    if (IN(2)) { run_gemm(lds, H, (const bf16_t*)(ws + WS_WDOWN), T, 1280, D, FStoreBf16{(bf16_t*)(scr + SC_DOWN), 1280});
        if (gridDim.x == 256 && blockIdx.x >= 144) cvt_table_i4(a.in[I_PU], ws + WS_UT, (float*)(ws + WS_TSC), 16384, 32768, 144, 112);
        SEAM(2); }
    if (IN(3)) { mla_rows_phase((const bf16_t*)(scr + SC_DOWN), a.in[I_MGQ], a.in[I_MGKV], a.in[I_CCKV], a.in[I_CKPE], rope, (bf16_t*)(scr + SC_CQ), (bf16_t*)(scr + SC_CKV), (bf16_t*)(scr + SC_KPE),
                                a.out + OUT_CKV, a.out + OUT_KPE); SEAM(3); }
    if (IN(4)) {
        run_gemm(lds, (const bf16_t*)(scr + SC_CQ), (const bf16_t*)(ws + WS_WUQ), T, 3072, 512, FMlaQ{(bf16_t*)(scr + SC_MQ), rope});
        run_gemm(lds, (const bf16_t*)(scr + SC_CKV), (const bf16_t*)(ws + WS_WUK), NKEY, 2048, 512, FStoreBf16{(bf16_t*)(scr + SC_KN), 2048});
        run_gemm(lds, (const bf16_t*)(ws + WS_WUV), (const bf16_t*)(scr + SC_CKV), 2048, NKEY, 512, FStoreBf16{(bf16_t*)(scr + SC_MVT), NKEY});
        if (gridDim.x == 256 && blockIdx.x >= 192) cvt_table_fp4(a.in[I_PV], ws + WS_VTAB, (float*)(ws + WS_TSC) + 4 * 16384, 16384, 16384 + 8192, 192, 64);
        SEAM(4); }
    if (IN(5)) { if (DUP & 4) attn_phase<0>(lds, (const bf16_t*)(scr + SC_MQ), (const bf16_t*)(scr + SC_KN), (const bf16_t*)(scr + SC_KPE), (const bf16_t*)(scr + SC_MVT), (bf16_t*)(scr + SC_MO), nullptr);
        attn_phase<0>(lds, (const bf16_t*)(scr + SC_MQ), (const bf16_t*)(scr + SC_KN), (const bf16_t*)(scr + SC_KPE), (const bf16_t*)(scr + SC_MVT), (bf16_t*)(scr + SC_MO), nullptr); SEAM(5); }
    if (IN(6)) { run_gemm_tok(lds, (const bf16_t*)(scr + SC_MO), (const bf16_t*)(ws + WS_WOMLA), D, FResidIn{xp, xs, X, mod + 0 * 12288 + 4096}); SEAM(6); }
    if (IN(7)) { peer_phases<0>(0, lds, a, mod); SEAM(7); }
    if (IN(8)) { peer_phases<0>(1, lds, a, mod); SEAM(8); }
    if (IN(9)) { peer_phases<0>(2, lds, a, mod); SEAM(9); }
    if (IN(10)) { peer_phases<0>(3, lds, a, mod); SEAM(10); }
    if (IN(11)) { peer_phases<0>(4, lds, a, mod); SEAM(11); }
    if (IN(12)) { peer_phases<0>(5, lds, a, mod); SEAM(12); }
    if (IN(13)) { norm_phase<true>(nullptr, nullptr, X, a.in[I_N1G] + 1 * D, mod + 1 * 12288, H); SEAM(13); }
    if (IN(14)) { run_gemm_tok(lds, H, (const bf16_t*)(ws + WS_S5IN), D, FStoreBf16{(bf16_t*)(scr + SC_U), D}); SEAM(14); }
    if (IN(15)) { if (DUP & 8) s5_scan_phase(lds, (const bf16_t*)(scr + SC_U), (bf16_t*)(scr + SC_YF), (bf16_t*)(scr + SC_YB), a.in, a.out);
        s5_scan_phase(lds, (const bf16_t*)(scr + SC_U), (bf16_t*)(scr + SC_YF), (bf16_t*)(scr + SC_YB), a.in, a.out); SEAM(15); }
    if (IN(16)) { s5_combine_phase((const bf16_t*)(scr + SC_U), (const bf16_t*)(scr + SC_YF), (const bf16_t*)(scr + SC_YB), a.in[I_S5D], (bf16_t*)(scr + SC_Z)); SEAM(16); }
    if (IN(17)) { run_gemm_tok(lds, (const bf16_t*)(scr + SC_Z), (const bf16_t*)(ws + WS_S5GATE), D, FS5Gate{(const bf16_t*)(scr + SC_Z), (bf16_t*)(scr + SC_ZZ)}); SEAM(17); }
    if (IN(18)) { run_gemm_tok(lds, (const bf16_t*)(scr + SC_ZZ), (const bf16_t*)(ws + WS_S5OUT), D, FResid{X, mod + 1 * 12288 + 4096}); SEAM(18); }
    if (IN(19)) { peer_phases<1>(0, lds, a, mod); SEAM(19); }
    if (IN(20)) { peer_phases<1>(1, lds, a, mod); SEAM(20); }
    if (IN(21)) { peer_phases<1>(2, lds, a, mod); SEAM(21); }
    if (IN(22)) { peer_phases<1>(3, lds, a, mod); SEAM(22); }
    if (IN(23)) { peer_phases<1>(4, lds, a, mod); SEAM(23); }
    if (IN(24)) { peer_phases<1>(5, lds, a, mod); SEAM(24); }
    if (IN(25)) { norm_phase<true>(nullptr, nullptr, X, a.in[I_N1G] + 2 * D, mod + 2 * 12288, H); SEAM(25); }
    if (IN(26)) { run_gemm_tailhalf(lds, (const bf16_t*)(ws + WS_HYIN), H, 6144, T, D, FStoreBf16RowBias{(bf16_t*)(scr + SC_ZT), T, a.in[I_HBIN]}); SEAM(26); }
    if (IN(27)) { if (DUP & 16) hy_conv_phase(lds, (const bf16_t*)(scr + SC_ZT), (const bf16_t*)(ws + WS_HYF), a.in[I_HSW], a.in[I_HSB], a.in[I_HBIAS], (bf16_t*)(scr + SC_VOT), (unsigned*)(ws + WS_CTL + 32768));
        hy_conv_phase(lds, (const bf16_t*)(scr + SC_ZT), (const bf16_t*)(ws + WS_HYF), a.in[I_HSW], a.in[I_HSB], a.in[I_HBIAS], (bf16_t*)(scr + SC_VOT), (unsigned*)(ws + WS_CTL + 32768)); SEAM(27); }
    if (IN(28)) { transpose_phase(lds, (const bf16_t*)(scr + SC_VOT), (bf16_t*)(scr + SC_VO)); SEAM(28); }
    if (IN(29)) { run_gemm_tok(lds, (const bf16_t*)(scr + SC_VO), (const bf16_t*)(ws + WS_HYOUT), D, FResid{X, mod + 2 * 12288 + 4096}); SEAM(29); }
    if (IN(30)) { peer_phases<2>(0, lds, a, mod); SEAM(30); }
    if (IN(31)) { peer_phases<2>(1, lds, a, mod); SEAM(31); }
    if (IN(32)) { peer_phases<2>(2, lds, a, mod); SEAM(32); }
    if (IN(33)) { peer_phases<2>(3, lds, a, mod); SEAM(33); }
    if (IN(34)) { peer_phases<2>(4, lds, a, mod); SEAM(34); }
    if (IN(35)) { peer_phases<2>(5, lds, a, mod); SEAM(35); }
    if (IN(36)) {
        norm_phase<true>(nullptr, nullptr, X, a.in[I_N1G] + 3 * D, mod + 3 * 12288, H);
        {
            bf16_t* KALL = (bf16_t*)(scr + SC_SK); bf16_t* VTs = (bf16_t*)(scr + SC_SVT);
            const float* ck = a.in[I_CSK]; const float* cv = a.in[I_CSV];
            for (int i = blockIdx.x * NTH + threadIdx.x; i < 8 * 256 * 512; i += gridDim.x * NTH) {
                const int c = i & 511, pos = (i >> 9) & 255, b = i >> 17, krow = TC + b * 2304 + 2048 + pos;
                { const int hh = c >> 7, p = c & 127, pi = p >> 1, aa = pi >> 5, f = pi & 31, orig = hh * 128 + 64 * aa + f + 32 * (p & 1); KALL[(size_t)krow * 512 + c] = f2bf(ck[(size_t)(b * 256 + pos) * 512 + orig]); }
                VTs[(size_t)c * NKEY + krow] = f2bf(cv[(size_t)(b * 256 + pos) * 512 + c]);
            }
        }
        SEAM(36); }
    if (IN(37)) {
        run_gemm(lds, H, (const bf16_t*)(ws + WS_SWAQKV), T, 2560, D, FSwaQK{(bf16_t*)(scr + SC_SQ), (bf16_t*)(scr + SC_SK), a.out + OUT_SWAK, rope + 2048});
        run_gemm(lds, (const bf16_t*)(ws + WS_SWAQKV) + (size_t)2560 * D, H, 512, T, D, FSwaVT{(bf16_t*)(scr + SC_SVT), a.out + OUT_SWAV}, gridDim.x == 256 ? 32 : 0);
        SEAM(37); }
    if (IN(38)) { if (DUP & 4) attn_phase<1>(lds, (const bf16_t*)(scr + SC_SQ), (const bf16_t*)(scr + SC_SK), nullptr, (const bf16_t*)(scr + SC_SVT), (bf16_t*)(scr + SC_SO), a.in[I_SSINK]);
        attn_phase<1>(lds, (const bf16_t*)(scr + SC_SQ), (const bf16_t*)(scr + SC_SK), nullptr, (const bf16_t*)(scr + SC_SVT), (bf16_t*)(scr + SC_SO), a.in[I_SSINK]); SEAM(38); }
    if (IN(39)) { run_gemm_tok(lds, (const bf16_t*)(scr + SC_SO), (const bf16_t*)(ws + WS_SWAO), D, FResid{X, mod + 3 * 12288 + 4096}); SEAM(39); }
    if (IN(40)) { peer_phases<3>(0, lds, a, mod); SEAM(40); }
    if (IN(41)) { peer_phases<3>(1, lds, a, mod); SEAM(41); }
    if (IN(42)) { peer_phases<3>(2, lds, a, mod); SEAM(42); }
    if (IN(43)) { peer_phases<3>(3, lds, a, mod); SEAM(43); }
    if (IN(44)) { peer_phases<3>(4, lds, a, mod); SEAM(44); }
    if (IN(45)) { peer_phases<3>(5, lds, a, mod); SEAM(45); }
    if (IN(46)) { final_norm_phase(X, a.in[I_FING], a.out + OUT_Y); }
#undef IN
#undef SEAM
}

#ifndef REP_LO
#define REP_LO 0ull
#endif
template <int P> static void launch_phase(const Args& a, int grid, hipStream_t stream) {
    static bool attr = false;
    if (!attr) { (void)hipFuncSetAttribute((const void*)mk_fwd<P>, hipFuncAttributeMaxDynamicSharedMemorySize, LDS_BYTES); attr = true; }
    hipLaunchKernelGGL(mk_fwd<P>, dim3(grid), dim3(NTH), LDS_BYTES, stream, a);
}
#if MK_PER_PHASE
template <int P> static void launch_all(Args a, int grid, hipStream_t stream) {
    if constexpr (P < N_PHASES) {
        a.lo = P; a.hi = P + 1;
        launch_phase<P>(a, grid, stream);
        if ((REP_LO >> P) & 1ull) launch_phase<P>(a, grid, stream);
        launch_all<P + 1>(a, grid, stream);
    }
}
#endif
extern "C" void kernel_launch(void* const* d_in, const int* in_sizes, int n_in, void* d_out, int out_size, void* d_ws, size_t ws_size, hipStream_t stream) {
    static int grid = 0;
    if (grid == 0) {
        if (n_in != N_IN || (size_t)out_size != OUT_END || ws_size < WS_END) { fprintf(stderr, "kernel_launch: unexpected shapes: n_in %d out %d ws %zu (need %zu)\n", n_in, out_size, ws_size, (size_t)WS_END); grid = -1; return; }
        int dev = 0, cus = 0;
        if (hipGetDevice(&dev) != hipSuccess || hipDeviceGetAttribute(&cus, hipDeviceAttributeMultiprocessorCount, dev) != hipSuccess) { grid = -1; return; }
        grid = cus;
    }
    if (grid < 0) return;
    (void)hipMemsetAsync((char*)d_ws + WS_CTL, 0, 65536, stream);
    Args a{};
    for (int i = 0; i < N_IN; ++i) a.in[i] = (const float*)d_in[i];
    a.out = (float*)d_out; a.ws = (unsigned char*)d_ws;
#if MK_PER_PHASE
    launch_all<0>(a, grid, stream);
#else
    a.lo = 0; a.hi = N_PHASES;
    launch_phase<-1>(a, grid, stream);
#endif
    const hipError_t le = hipPeekAtLastError();
    if (le != hipSuccess) fprintf(stderr, "kernel_launch: launch failed: %s\n", hipGetErrorName(le));
}
```
